# Optimizing an MI355X kernel written in HIP

```python
import jax, jax.numpy as jnp
from jax import lax
import numpy as np

D_MODEL = 1024
BATCH = 8
SEQ = 4096
DEPTH = 1

HEAD_DIM = 64
MOBA_HEADS = D_MODEL // 128
NSA_HEADS = D_MODEL // 128
NSA_KV_GROUPS = 2
NSA_HPG = NSA_HEADS // NSA_KV_GROUPS
MOBA_BLOCK = 256
MOBA_TOPK = 3
CMP_LEN = 32
CMP_STRIDE = 16
CMP_HIDDEN = 128
SLC_BLOCK = 64
SLC_TOPN = 16
WINDOW = 512
GATHER_Q_CHUNK = 16
BAND_Q_CHUNK = 128
RMS_EPS = 1e-6
NEG_INF = -1e30
FORCED_SCORE = 1e9

MOBA_W = MOBA_HEADS * HEAD_DIM
NSA_W = NSA_HEADS * HEAD_DIM
NSA_KV_W = NSA_KV_GROUPS * HEAD_DIM
MIX_W = MOBA_W + NSA_W
IN_SPLITS = [MOBA_W, MOBA_W, MOBA_W, MOBA_W, NSA_W,
             NSA_KV_W, NSA_KV_W, NSA_KV_W, NSA_KV_W, NSA_KV_W, NSA_KV_W,
             3 * NSA_HEADS, NSA_W]
D_IN = sum(IN_SPLITS)

kernel_name = "hymba_moba_nsa_sandwich_alibi"


def _rmsnorm(x, g):
    xf = x.astype(jnp.float32)
    r = lax.rsqrt(jnp.mean(xf * xf, axis=-1, keepdims=True) + RMS_EPS)
    return (xf * r * g.astype(jnp.float32)).astype(x.dtype)


def _alibi_slopes(n):
    return jnp.asarray(2.0 ** (-8.0 * np.arange(1, n + 1) / n), dtype=jnp.float32)


def _masked_softmax(s, mask):
    s = jnp.where(mask, s.astype(jnp.float32), NEG_INF)
    m = jnp.max(s, axis=-1, keepdims=True)
    p = jnp.where(mask, jnp.exp(s - m), 0.0)
    return p / jnp.maximum(jnp.sum(p, axis=-1, keepdims=True), 1e-30)


def _moba(q, k, v, slopes):
    B, H, S, dh = q.shape
    nb = -(-S // MOBA_BLOCK)
    pad = nb * MOBA_BLOCK - S
    kb = jnp.pad(k, ((0, 0), (0, 0), (0, pad), (0, 0))).reshape(B, H, nb, MOBA_BLOCK, dh)
    vb = jnp.pad(v, ((0, 0), (0, 0), (0, pad), (0, 0))).reshape(B, H, nb, MOBA_BLOCK, dh)
    kmean = jnp.mean(kb, axis=3)
    pos = jnp.arange(S)
    own = pos // MOBA_BLOCK
    gate = jnp.einsum('bhsd,bhnd->bhsn', q, kmean).astype(jnp.float32)
    past = jnp.arange(nb)[None, :] < own[:, None]
    gate = jnp.where(past, gate, NEG_INF)
    _, top_idx = lax.top_k(gate, min(MOBA_TOPK, nb))
    top_valid = top_idx < own[:, None]
    own_b = jnp.broadcast_to(own[:, None], (B, H, S, 1)).astype(top_idx.dtype)
    idx = jnp.concatenate([top_idx, own_b], axis=-1)
    valid = jnp.concatenate([top_valid, jnp.ones((B, H, S, 1), bool)], axis=-1)
    scale = dh ** -0.5
    bi = jnp.arange(B)[:, None, None, None]
    hi = jnp.arange(H)[None, :, None, None]
    offs = jnp.arange(MOBA_BLOCK)
    n_chunks = S // GATHER_Q_CHUNK

    def chunk(q0):
        qc = lax.dynamic_slice_in_dim(q, q0, GATHER_Q_CHUNK, axis=2)
        ic = lax.dynamic_slice_in_dim(idx, q0, GATHER_Q_CHUNK, axis=2)
        vm = lax.dynamic_slice_in_dim(valid, q0, GATHER_Q_CHUNK, axis=2)
        kg = kb[bi, hi, ic]
        vg = vb[bi, hi, ic]
        s = jnp.einsum('bhqd,bhqjkd->bhqjk', qc, kg).astype(jnp.float32) * scale
        tq = q0 + jnp.arange(GATHER_Q_CHUNK)
        dist = tq[:, None, None] - (ic[..., None] * MOBA_BLOCK + offs)
        mask = vm[..., None] & (dist >= 0)
        s = s - slopes[None, :, None, None, None] * dist.astype(jnp.float32)
        shp = s.shape
        p = _masked_softmax(s.reshape(B, H, GATHER_Q_CHUNK, -1),
                            mask.reshape(B, H, GATHER_Q_CHUNK, -1)).reshape(shp)
        return jnp.einsum('bhqjk,bhqjkd->bhqd', p.astype(v.dtype), vg)

    outs = lax.map(chunk, jnp.arange(n_chunks, dtype=jnp.int32) * GATHER_Q_CHUNK)
    return outs.transpose(1, 2, 0, 3, 4).reshape(B, H, S, dh)


def _compress(x, pe, w1, w2):
    B, G, S, dh = x.shape
    n_cmp = (S - CMP_LEN) // CMP_STRIDE + 1
    cidx = jnp.arange(n_cmp)[:, None] * CMP_STRIDE + jnp.arange(CMP_LEN)[None, :]
    blocks = x[:, :, cidx] + pe
    flat = blocks.reshape(B, G, n_cmp, CMP_LEN * dh)
    return jax.nn.silu(flat @ w1) @ w2


def _nsa(q, k_cmp, v_cmp, k_slc, v_slc, k_win, v_win, gates, slopes,
         pos_k, pos_v, w_ck1, w_ck2, w_cv1, w_cv2):
    B, G, HPG, S, dh = q.shape
    scale = dh ** -0.5
    t = jnp.arange(S)
    sl = slopes.reshape(G, HPG)

    kc = _compress(k_cmp, pos_k, w_ck1, w_ck2)
    vc = _compress(v_cmp, pos_v, w_cv1, w_cv2)
    n_cmp = kc.shape[2]
    cstart = jnp.arange(n_cmp) * CMP_STRIDE
    cmask = (cstart + CMP_LEN - 1)[None, :] <= t[:, None]
    sc = jnp.einsum('bghtd,bgcd->bghtc', q, kc).astype(jnp.float32) * scale
    p_cmp = _masked_softmax(sc, cmask)
    o_cmp = jnp.einsum('bghtc,bgcd->bghtd', p_cmp.astype(vc.dtype), vc)

    n_slc = S // SLC_BLOCK
    jstart = jnp.arange(n_slc) * SLC_BLOCK
    overlap = ((cstart[:, None] < jstart[None, :] + SLC_BLOCK) &
               (cstart[:, None] + CMP_LEN > jstart[None, :])).astype(jnp.float32)
    imp = jnp.einsum('bghtc,cj->bgtj', p_cmp, overlap)
    own = t // SLC_BLOCK
    jb = jnp.arange(n_slc)
    forced = (jb[None, :] == 0) | (jb[None, :] == own[:, None]) | (jb[None, :] == own[:, None] - 1)
    causal_blk = jb[None, :] <= own[:, None]
    imp = jnp.where(forced, FORCED_SCORE, jnp.where(causal_blk, imp, NEG_INF))
    _, sidx = lax.top_k(imp, min(SLC_TOPN, n_slc))
    svalid = sidx <= own[:, None]

    ksb = k_slc.reshape(B, G, n_slc, SLC_BLOCK, dh)
    vsb = v_slc.reshape(B, G, n_slc, SLC_BLOCK, dh)
    bi = jnp.arange(B)[:, None, None, None]
    gi = jnp.arange(G)[None, :, None, None]
    offs = jnp.arange(SLC_BLOCK)

    def slc_chunk(q0):
        qc = lax.dynamic_slice_in_dim(q, q0, GATHER_Q_CHUNK, axis=3)
        ic = lax.dynamic_slice_in_dim(sidx, q0, GATHER_Q_CHUNK, axis=2)
        vm = lax.dynamic_slice_in_dim(svalid, q0, GATHER_Q_CHUNK, axis=2)
        kg = ksb[bi, gi, ic]
        vg = vsb[bi, gi, ic]
        s = jnp.einsum('bghqd,bgqnkd->bghqnk', qc, kg).astype(jnp.float32) * scale
        tq = q0 + jnp.arange(GATHER_Q_CHUNK)
        dist = tq[:, None, None] - (ic[..., None] * SLC_BLOCK + offs)
        mask = (vm[..., None] & (dist >= 0))[:, :, None]
        s = s - sl[None, :, :, None, None, None] * dist[:, :, None].astype(jnp.float32)
        shp = s.shape
        mask = jnp.broadcast_to(mask, shp)
        p = _masked_softmax(s.reshape(B, G, HPG, GATHER_Q_CHUNK, -1),
                            mask.reshape(B, G, HPG, GATHER_Q_CHUNK, -1)).reshape(shp)
        return jnp.einsum('bghqnk,bgqnkd->bghqd', p.astype(v_slc.dtype), vg)

    o_slc = lax.map(slc_chunk, jnp.arange(S // GATHER_Q_CHUNK, dtype=jnp.int32) * GATHER_Q_CHUNK)
    o_slc = o_slc.transpose(1, 2, 3, 0, 4, 5).reshape(B, G, HPG, S, dh)

    kwp = jnp.pad(k_win, ((0, 0), (0, 0), (WINDOW, 0), (0, 0)))
    vwp = jnp.pad(v_win, ((0, 0), (0, 0), (WINDOW, 0), (0, 0)))
    span = WINDOW + BAND_Q_CHUNK

    def win_chunk(q0):
        qc = lax.dynamic_slice_in_dim(q, q0, BAND_Q_CHUNK, axis=3)
        kw = lax.dynamic_slice_in_dim(kwp, q0, span, axis=2)
        vw = lax.dynamic_slice_in_dim(vwp, q0, span, axis=2)
        s = jnp.einsum('bghqd,bgkd->bghqk', qc, kw).astype(jnp.float32) * scale
        tq = q0 + jnp.arange(BAND_Q_CHUNK)
        sp = q0 - WINDOW + jnp.arange(span)
        dist = tq[:, None] - sp[None, :]
        mask = (dist >= 0) & (dist < WINDOW) & (sp[None, :] >= 0)
        s = s - sl[None, :, :, None, None] * dist.astype(jnp.float32)
        p = _masked_softmax(s, mask)
        return jnp.einsum('bghqk,bgkd->bghqd', p.astype(v_win.dtype), vw)

    o_win = lax.map(win_chunk, jnp.arange(S // BAND_Q_CHUNK, dtype=jnp.int32) * BAND_Q_CHUNK)
    o_win = o_win.transpose(1, 2, 3, 0, 4, 5).reshape(B, G, HPG, S, dh)

    return gates[..., 0:1] * o_cmp + gates[..., 1:2] * o_slc + gates[..., 2:3] * o_win


def setup_inputs(seed: int = 0) -> dict:
    key = jax.random.key(seed)
    ks = jax.random.split(key, 12)
    f32 = jnp.float32
    x = jax.random.normal(ks[0], (BATCH, SEQ, D_MODEL), f32)
    pre_norm_g = 1.0 + 0.05 * jax.random.normal(ks[1], (DEPTH, D_MODEL), f32)
    post_norm_g = 1.0 + 0.05 * jax.random.normal(ks[2], (DEPTH, D_MODEL), f32)
    w_in = jax.random.normal(ks[3], (DEPTH, D_MODEL, D_IN), f32) * D_MODEL ** -0.5
    cmp_pos_k = 0.1 * jax.random.normal(ks[4], (DEPTH, CMP_LEN, HEAD_DIM), f32)
    cmp_pos_v = 0.1 * jax.random.normal(ks[5], (DEPTH, CMP_LEN, HEAD_DIM), f32)
    w_cmp_k1 = jax.random.normal(ks[6], (DEPTH, CMP_LEN * HEAD_DIM, CMP_HIDDEN), f32) * (CMP_LEN * HEAD_DIM) ** -0.5
    w_cmp_k2 = jax.random.normal(ks[7], (DEPTH, CMP_HIDDEN, HEAD_DIM), f32) * CMP_HIDDEN ** -0.5
    w_cmp_v1 = jax.random.normal(ks[8], (DEPTH, CMP_LEN * HEAD_DIM, CMP_HIDDEN), f32) * (CMP_LEN * HEAD_DIM) ** -0.5
    w_cmp_v2 = jax.random.normal(ks[9], (DEPTH, CMP_HIDDEN, HEAD_DIM), f32) * CMP_HIDDEN ** -0.5
    w_out = jax.random.normal(ks[10], (DEPTH, MIX_W, D_MODEL), f32) * MIX_W ** -0.5
    return {"x": x, "pre_norm_g": pre_norm_g, "post_norm_g": post_norm_g, "w_in": w_in,
            "cmp_pos_k": cmp_pos_k, "cmp_pos_v": cmp_pos_v,
            "w_cmp_k1": w_cmp_k1, "w_cmp_k2": w_cmp_k2,
            "w_cmp_v1": w_cmp_v1, "w_cmp_v2": w_cmp_v2, "w_out": w_out}


def reference(x, pre_norm_g, post_norm_g, w_in, cmp_pos_k, cmp_pos_v,
              w_cmp_k1, w_cmp_k2, w_cmp_v1, w_cmp_v2, w_out):
    B, S, _ = x.shape
    split_points = np.cumsum(IN_SPLITS)[:-1].tolist()
    slopes_a = _alibi_slopes(MOBA_HEADS)
    slopes_b = _alibi_slopes(NSA_HEADS)
    for l in range(DEPTH):
        h = _rmsnorm(x, pre_norm_g[l])
        proj = h @ w_in[l]
        (qa, ka, va, za, qb, kcm, vcm, ksl, vsl, kwi, vwi, g_logit, zb) = jnp.split(proj, split_points, axis=-1)

        def heads_a(t):
            return t.reshape(B, S, MOBA_HEADS, HEAD_DIM).transpose(0, 2, 1, 3)
        oa = _moba(heads_a(qa), heads_a(ka), heads_a(va), slopes_a)
        oa = oa.transpose(0, 2, 1, 3).reshape(B, S, MOBA_W) * jax.nn.silu(za)

        def heads_kv(t):
            return t.reshape(B, S, NSA_KV_GROUPS, HEAD_DIM).transpose(0, 2, 1, 3)
        qn = qb.reshape(B, S, NSA_KV_GROUPS, NSA_HPG, HEAD_DIM).transpose(0, 2, 3, 1, 4)
        gates = jax.nn.sigmoid(g_logit.astype(jnp.float32)).astype(qb.dtype)
        gates = gates.reshape(B, S, NSA_KV_GROUPS, NSA_HPG, 3).transpose(0, 2, 3, 1, 4)
        ob = _nsa(qn, heads_kv(kcm), heads_kv(vcm), heads_kv(ksl), heads_kv(vsl),
                  heads_kv(kwi), heads_kv(vwi), gates, slopes_b,
                  cmp_pos_k[l], cmp_pos_v[l], w_cmp_k1[l], w_cmp_k2[l], w_cmp_v1[l], w_cmp_v2[l])
        ob = ob.transpose(0, 3, 1, 2, 4).reshape(B, S, NSA_W) * jax.nn.silu(zb)

        y = jnp.concatenate([oa, ob], axis=-1) @ w_out[l]
        x = x + _rmsnorm(y.astype(x.dtype), post_norm_g[l])
    return x
```

```cpp
#include <hip/hip_runtime.h>
#include <hip/hip_fp16.h>
#include <hip/hip_cooperative_groups.h>
#include <cstdio>
#include <stdint.h>

#define PROBE 0
namespace {

#define LAS __attribute__((address_space(3)))
typedef _Float16 h8 __attribute__((ext_vector_type(8)));
typedef _Float16 h4 __attribute__((ext_vector_type(4)));
typedef float f32x4 __attribute__((ext_vector_type(4)));
typedef float f32x16 __attribute__((ext_vector_type(16)));
typedef unsigned u32x4 __attribute__((ext_vector_type(4)));

__device__ __forceinline__ int otid() { int t = threadIdx.x; asm volatile("" : "+v"(t)); return t; }

constexpr int B_ = 8, S_ = 4096, DM = 1024, DIN = 3864, T_ = B_ * S_;
constexpr int NP = 3840;
constexpr float EPS = 1e-6f;
constexpr int SL_QA = 0, SL_KA = 8, SL_VA = 16, SL_ZA = 24, SL_QB = 32, SL_KV6 = 40, SL_ZB = 52;

constexpr size_t al256(size_t x) { return (x + 255) & ~(size_t)255; }
constexpr size_t OFF_XH = 0;
constexpr size_t OFF_WT = OFF_XH + al256((size_t)T_ * 1024 * 2);
constexpr size_t OFF_WOT = OFF_WT + al256((size_t)NP * 1024 * 2);
constexpr size_t OFF_RSTD = OFF_WOT + al256((size_t)1024 * 1024 * 2);
constexpr size_t OFF_GATE = OFF_RSTD + al256((size_t)T_ * 4);
constexpr size_t OFF_KMP = OFF_GATE + al256((size_t)T_ * 24 * 4);
constexpr size_t OFF_KN2 = OFF_KMP + al256((size_t)8 * 8 * 16 * 2 * 64 * 4);
constexpr size_t OFF_QCTR = OFF_KN2 + al256((size_t)8 * 60 * 2 * 4);
constexpr size_t OFF_XBAR = OFF_QCTR + 256;
constexpr size_t OFF_SSQ = OFF_XBAR + al256((size_t)3456 * 4);
constexpr size_t OFF_PCNT = OFF_SSQ + al256((size_t)T_ * 4);
constexpr size_t OFF_SSQ2 = OFF_PCNT + al256(256 * 4);
constexpr size_t OFF_PCNT2 = OFF_SSQ2 + al256((size_t)T_ * 4);
constexpr size_t OFF_SEL = OFF_PCNT2 + al256(256 * 4);
constexpr size_t OFF_KCH = OFF_SEL + al256((size_t)8 * 2 * 4096 * 8);
constexpr size_t OFF_VCH = OFF_KCH + al256((size_t)8 * 2 * 256 * 64 * 2);
constexpr size_t OFF_W1T = OFF_VCH + al256((size_t)8 * 2 * 256 * 64 * 2);
constexpr size_t OFF_W2T = OFF_W1T + al256((size_t)2 * 128 * 2048 * 2);
constexpr size_t OFF_PEH = OFF_W2T + al256((size_t)2 * 64 * 128 * 2);
constexpr size_t OFF_OCMPH = OFF_PEH + al256((size_t)2 * 2048 * 2);
constexpr size_t OFF_HM = OFF_OCMPH + al256((size_t)T_ * 512 * 2);
constexpr size_t OFF_CAT = OFF_HM + al256((size_t)60 * T_ * 64 * 2);
constexpr size_t WS_END = OFF_CAT + al256((size_t)T_ * 1024 * 2);

struct P {
  const float* x; const float* g_pre; const float* g_post; const float* w_in;
  const float* pe_k; const float* pe_v; const float* wk1; const float* wk2; const float* wv1; const float* wv2;
  const float* w_out; float* out;
  char* ws;
  __device__ __forceinline__ __half* xh() const { return (__half*)(ws + OFF_XH); }
  __device__ __forceinline__ __half* cat() const { return (__half*)(ws + OFF_CAT); }
  __device__ __forceinline__ __half* wt() const { return (__half*)(ws + OFF_WT); }
  __device__ __forceinline__ __half* wot() const { return (__half*)(ws + OFF_WOT); }
  __device__ __forceinline__ float* rstd() const { return (float*)(ws + OFF_RSTD); }
  __device__ __forceinline__ float* gate() const { return (float*)(ws + OFF_GATE); }
  __device__ __forceinline__ float* kmp() const { return (float*)(ws + OFF_KMP); }
  __device__ __forceinline__ unsigned* kn2() const { return (unsigned*)(ws + OFF_KN2); }
  __device__ __forceinline__ unsigned* qctr() const { return (unsigned*)(ws + OFF_QCTR); }
  __device__ __forceinline__ unsigned* xbar() const { return (unsigned*)(ws + OFF_XBAR); }
  __device__ __forceinline__ float* ssq() const { return (float*)(ws + OFF_SSQ); }
  __device__ __forceinline__ unsigned* pcnt() const { return (unsigned*)(ws + OFF_PCNT); }
  __device__ __forceinline__ unsigned long long* sel() const { return (unsigned long long*)(ws + OFF_SEL); }
  __device__ __forceinline__ __half* kch() const { return (__half*)(ws + OFF_KCH); }
  __device__ __forceinline__ __half* vch() const { return (__half*)(ws + OFF_VCH); }
  __device__ __forceinline__ __half* w1t() const { return (__half*)(ws + OFF_W1T); }
  __device__ __forceinline__ __half* w2t() const { return (__half*)(ws + OFF_W2T); }
  __device__ __forceinline__ __half* peh() const { return (__half*)(ws + OFF_PEH); }
  __device__ __forceinline__ __half* ocmph() const { return (__half*)(ws + OFF_OCMPH); }
  __device__ __forceinline__ __half* hm() const { return (__half*)(ws + OFF_HM); }
};

__device__ __forceinline__ const __half* hmp(const P& p, int slot, int b, int t) {
  return p.hm() + (((size_t)slot * T_) + (size_t)b * S_ + t) * 64;
}

__device__ __forceinline__ float wave_sum(float v) {
#pragma unroll
  for (int o = 32; o > 0; o >>= 1) v += __shfl_xor(v, o, 64);
  return v;
}
__device__ __forceinline__ float silu(float v) { return v / (1.f + __expf(-v)); }

constexpr int PREP_WG_OFF = 0;
constexpr int PREP_TILE_OFF = 65536;
constexpr int PREP_LDS = 65536 + 64 * 65 * 4;

__device__ __forceinline__ void tr_tile(const float* src, int ldS, int k0, int n0s, __half* dst, int ldD, int n0d,
                                        const float* scale, LAS float* tile, int tid) {
  {
    const int i = tid >> 4, jj = (tid & 15) * 4;
#pragma unroll
    for (int h = 0; h < 2; ++h) {
      const int k = i + 32 * h;
      float4 v = *reinterpret_cast<const float4*>(src + (size_t)(k0 + k) * ldS + n0s + jj);
      const float sc = scale ? scale[k0 + k] : 1.f;
      tile[k * 65 + jj + 0] = v.x * sc; tile[k * 65 + jj + 1] = v.y * sc; tile[k * 65 + jj + 2] = v.z * sc; tile[k * 65 + jj + 3] = v.w * sc;
    }
  }
  __syncthreads();
  {
    const int n = tid >> 3, kc = (tid & 7) * 8;
    h8 o;
#pragma unroll
    for (int u = 0; u < 8; ++u) o[u] = (_Float16)tile[(kc + u) * 65 + n];
    *reinterpret_cast<h8*>(dst + (size_t)(n0d + n) * ldD + k0 + kc) = o;
  }
  __syncthreads();
}

__device__ __forceinline__ void phase_prep(const P& p, LAS unsigned char* lds, int bid, int nblk) {
  const int tid = otid(), lane = tid & 63, wid = tid >> 6;
  LAS _Float16* wgl = (LAS _Float16*)(lds + PREP_WG_OFF);
  for (int e = tid; e < 1024 * 24; e += 512) {
    const int k = e / 24, n = e - k * 24;
    const float v = p.w_in[(size_t)k * DIN + 3328 + n] * p.g_pre[k];
    const int s = k >> 5, q = (k >> 3) & 3, j = k & 7;
    wgl[((s * 4 + q) * 32 + n) * 8 + j] = (_Float16)v;
  }
  for (int e = tid; e < 1024 * 8; e += 512) {
    const int k = e >> 3, n = 24 + (e & 7);
    const int s = k >> 5, q = (k >> 3) & 3, j = k & 7;
    wgl[((s * 4 + q) * 32 + n) * 8 + j] = (_Float16)0.f;
  }
  __syncthreads();
  for (int u = bid; u < T_ / 128; u += nblk) {
    const int row0 = u * 128 + wid * 16;
    const int r = lane & 15, q = lane >> 4;
    const float* xr = p.x + (size_t)(row0 + r) * DM + q * 8;
    __half* xo = p.xh() + (size_t)(row0 + r) * DM + q * 8;
    f32x4 acc0 = {0.f, 0.f, 0.f, 0.f}, acc1 = {0.f, 0.f, 0.f, 0.f};
    float ss = 0.f;
#pragma unroll 4
    for (int s = 0; s < 32; ++s) {
      const f32x4 v0 = __builtin_nontemporal_load(reinterpret_cast<const f32x4*>(xr + s * 32));
      const f32x4 v1 = __builtin_nontemporal_load(reinterpret_cast<const f32x4*>(xr + s * 32 + 4));
      ss += v0.x * v0.x + v0.y * v0.y + v0.z * v0.z + v0.w * v0.w + v1.x * v1.x + v1.y * v1.y + v1.z * v1.z + v1.w * v1.w;
      h8 a;
      a[0] = (_Float16)v0.x; a[1] = (_Float16)v0.y; a[2] = (_Float16)v0.z; a[3] = (_Float16)v0.w;
      a[4] = (_Float16)v1.x; a[5] = (_Float16)v1.y; a[6] = (_Float16)v1.z; a[7] = (_Float16)v1.w;
      *reinterpret_cast<h8*>(xo + s * 32) = a;
      const h8 b0 = *(const LAS h8*)(lds + PREP_WG_OFF + ((s * 4 + q) * 32 + r) * 16);
      const h8 b1 = *(const LAS h8*)(lds + PREP_WG_OFF + ((s * 4 + q) * 32 + 16 + r) * 16);
      acc0 = __builtin_amdgcn_mfma_f32_16x16x32_f16(a, b0, acc0, 0, 0, 0);
      acc1 = __builtin_amdgcn_mfma_f32_16x16x32_f16(a, b1, acc1, 0, 0, 0);
    }
    ss += __shfl_xor(ss, 16, 64);
    ss += __shfl_xor(ss, 32, 64);
    const float rs = rsqrtf(ss * (1.f / DM) + EPS);
    if (q == 0) p.rstd()[row0 + r] = rs;
#pragma unroll
    for (int reg = 0; reg < 4; ++reg) {
      const int row = q * 4 + reg;
      const float rr = __shfl(rs, row, 64);
      float* gp = p.gate() + (size_t)(row0 + row) * 24;
      gp[r] = 1.f / (1.f + __expf(-acc0[reg] * rr));
      if (r < 8) gp[16 + r] = 1.f / (1.f + __expf(-acc1[reg] * rr));
    }
  }
  __syncthreads();
  LAS float* tile = (LAS float*)(lds + PREP_TILE_OFF);
  constexpr int N_WIN = 16 * 60, N_WOUT = 16 * 16;
  constexpr int N_W1 = 2 * 64, N_W2 = 2 * 2;
  for (int it = bid; it < N_WIN + N_WOUT + N_W1 + N_W2; it += nblk) {
    if (it < N_WIN) {
      const int kb = it / 60, nb = it - kb * 60;
      const int n0d = nb * 64, n0s = n0d < 3328 ? n0d : n0d + 24;
      tr_tile(p.w_in, DIN, kb * 64, n0s, p.wt(), DM, n0d, p.g_pre, tile, tid);
    } else if (it < N_WIN + N_WOUT) {
      const int r = it - N_WIN, kb = r >> 4, nb = r & 15;
      tr_tile(p.w_out, DM, kb * 64, nb * 64, p.wot(), DM, nb * 64, nullptr, tile, tid);
    } else if (it < N_WIN + N_WOUT + N_W1) {
      const int r = it - N_WIN - N_WOUT, which = r >> 6, kb = (r & 63) >> 1, nb = r & 1;
      tr_tile(which ? p.wv1 : p.wk1, 128, kb * 64, nb * 64, p.w1t() + (size_t)which * 128 * 2048, 2048, nb * 64, nullptr, tile, tid);
    } else {
      const int r = it - N_WIN - N_WOUT - N_W1, which = r >> 1, kb = r & 1;
      tr_tile(which ? p.wv2 : p.wk2, 64, kb * 64, 0, p.w2t() + (size_t)which * 64 * 128, 128, 0, nullptr, tile, tid);
    }
  }
  for (int e = bid * 512 + tid; e < 8 * 60 * 2; e += nblk * 512) p.kn2()[e] = 0u;
  if (bid == 0 && tid < 8) p.qctr()[tid] = 0u;
  for (int e = bid * 512 + tid; e < T_; e += nblk * 512) p.ssq()[e] = 0.f;
  if (bid == 1 && tid < 256) p.pcnt()[tid] = 0u;
  if (PROBE == 6) { for (int e = bid * 512 + tid; e < T_; e += nblk * 512) ((float*)(p.ws + OFF_SSQ2))[e] = 0.f; if (bid == 3 && tid < 256) ((unsigned*)(p.ws + OFF_PCNT2))[tid] = 0u; }
  for (int e = bid * 512 + tid; e < 2 * 2048; e += nblk * 512) p.peh()[e] = __float2half(e < 2048 ? p.pe_k[e] : p.pe_v[e - 2048]);
}

constexpr int BM = 256, BK = 64, HALF = 128, HTB = HALF * BK * 2, STAGE_BYTES = 8 * HTB, NXCD = 8, WGM = 8;

__device__ __forceinline__ int lds_byte(int r, int c) { const int st = (r >> 4) * 2 + (c >> 5), rr = r & 15, cc = c & 31, ob = rr * 64 + cc * 2; return st * 1024 + (ob ^ (((ob >> 9) & 1) << 5)); }
__device__ __forceinline__ void stage_rc(int b, int& R, int& C) { const int st = b / 1024, sb = b % 1024, swz = sb ^ (((sb >> 9) & 1) << 5); R = (st >> 1) * 16 + swz / 64; C = (st & 1) * 32 + (swz % 64) / 2; }
__device__ __forceinline__ int perm32(int rho) { const int n = rho >> 4, i = rho & 15; return 8 * (i >> 2) + 4 * n + (i & 3); }

struct Unit { int pm, pn; };
struct StaticOrder {
  int nM, nN, nwg, G, c, rep;
  __device__ void init(int M, int N, int G_, int c_, int rep_ = 1) { nM = M / BM; nN = N / BM; nwg = nM * nN; G = G_; c = c_; rep = rep_; }
  __device__ bool next(int i, Unit& u) const {
    const long L = (long)i * G + c; if (L >= (long)nwg * rep) return false;
    int wgid = (int)(L % nwg); { const int q = nwg / NXCD, r = nwg % NXCD, xcd = wgid % NXCD, off = wgid / NXCD; wgid = (xcd < r ? xcd * (q + 1) : r * (q + 1) + (xcd - r) * q) + off; }
    const int nig = WGM * nN, gid = wgid / nig, fm = gid * WGM, gsz = (nM - fm) < WGM ? (nM - fm) : WGM;
    u.pm = fm + ((wgid % nig) % gsz); u.pn = (wgid % nig) / gsz; return true;
  }
};

struct EpiProj {
  static constexpr bool PERM = true;
  __half* hm; const float* rstd; float* kmp; unsigned* kn2;
  __device__ __forceinline__ void operator()(const f32x4 (&acc)[2][2][4][2], const Unit& u, int wr, int wc, int fr, int fq) const {
    const int row0 = u.pm * BM + wr * 64 + fr;
    const int colb = u.pn * BM + wc * 32 + 8 * fq;
    const bool isK = (u.pn == 2) || (u.pn == 3);
    const bool hasK = isK || (u.pn == 11) || (u.pn == 12);
    float cs[2][8];
    float nmax[2] = {0.f, 0.f};
#pragma unroll
    for (int bj = 0; bj < 2; ++bj)
#pragma unroll
      for (int j = 0; j < 8; ++j) cs[bj][j] = 0.f;
#pragma unroll
    for (int ai = 0; ai < 2; ++ai)
#pragma unroll
      for (int m = 0; m < 4; ++m) {
        const int row = row0 + ai * HALF + m * 16;
        const float rs = rstd[row];
#pragma unroll
        for (int bj = 0; bj < 2; ++bj) {
          const int c = colb + bj * HALF;
          const f32x4 v0 = acc[ai][bj][m][0] * rs, v1 = acc[ai][bj][m][1] * rs;
          h8 o;
          o[0] = (_Float16)v0[0]; o[1] = (_Float16)v0[1]; o[2] = (_Float16)v0[2]; o[3] = (_Float16)v0[3];
          o[4] = (_Float16)v1[0]; o[5] = (_Float16)v1[1]; o[6] = (_Float16)v1[2]; o[7] = (_Float16)v1[3];
          *reinterpret_cast<h8*>(hm + ((size_t)(c >> 6) * T_ + row) * 64 + (c & 63)) = o;
          if (hasK) {
            float ss = (v0[0] * v0[0] + v0[1] * v0[1]) + (v0[2] * v0[2] + v0[3] * v0[3]) + (v1[0] * v1[0] + v1[1] * v1[1]) + (v1[2] * v1[2] + v1[3] * v1[3]);
            ss += __shfl_xor(ss, 16, 64); ss += __shfl_xor(ss, 32, 64);
            nmax[bj] = fmaxf(nmax[bj], ss);
          }
          if (isK) {
#pragma unroll
            for (int j = 0; j < 4; ++j) { cs[bj][j] += v0[j]; cs[bj][4 + j] += v1[j]; }
          }
        }
      }
    if (hasK)
#pragma unroll
    for (int bj = 0; bj < 2; ++bj) {
      float v = nmax[bj];
      v = fmaxf(v, __shfl_xor(v, 1, 64)); v = fmaxf(v, __shfl_xor(v, 2, 64)); v = fmaxf(v, __shfl_xor(v, 4, 64)); v = fmaxf(v, __shfl_xor(v, 8, 64));
      if ((fr | fq) == 0) {
        const int c = u.pn * BM + wc * 32 + bj * HALF;
        atomicMax(kn2 + ((size_t)(u.pm >> 4) * 60 + (c >> 6)) * 2 + (wc & 1), __float_as_uint(v));
      }
    }
    if (isK) {
#pragma unroll
      for (int bj = 0; bj < 2; ++bj)
#pragma unroll
        for (int j = 0; j < 8; ++j) {
          float v = cs[bj][j];
          v += __shfl_xor(v, 1, 64); v += __shfl_xor(v, 2, 64); v += __shfl_xor(v, 4, 64); v += __shfl_xor(v, 8, 64);
          cs[bj][j] = v;
        }
      if (fr == 0) {
        const int b = u.pm >> 4, blk = u.pm & 15;
#pragma unroll
        for (int bj = 0; bj < 2; ++bj) {
          const int c = colb + bj * HALF, h = (c >> 6) - SL_KA, d0 = c & 63;
          float* dst = kmp + ((((size_t)b * 8 + h) * 16 + blk) * 2 + wr) * 64 + d0;
          *reinterpret_cast<f32x4*>(dst) = (f32x4){cs[bj][0], cs[bj][1], cs[bj][2], cs[bj][3]};
          *reinterpret_cast<f32x4*>(dst + 4) = (f32x4){cs[bj][4], cs[bj][5], cs[bj][6], cs[bj][7]};
        }
      }
    }
  }
};
struct EpiY {
  static constexpr bool PERM = true;
  __half* y; float* ssq;
  __device__ __forceinline__ void operator()(const f32x4 (&acc)[2][2][4][2], const Unit& u, int wr, int wc, int fr, int fq) const {
    const int row0 = u.pm * BM + wr * 64 + fr;
    const int colb = u.pn * BM + wc * 32 + 8 * fq;
#pragma unroll
    for (int ai = 0; ai < 2; ++ai)
#pragma unroll
      for (int m = 0; m < 4; ++m) {
        const int row = row0 + ai * HALF + m * 16;
        float s = 0.f;
#pragma unroll
        for (int bj = 0; bj < 2; ++bj) {
          const f32x4 v0 = acc[ai][bj][m][0], v1 = acc[ai][bj][m][1];
          s += (v0[0] * v0[0] + v0[1] * v0[1]) + (v0[2] * v0[2] + v0[3] * v0[3]) + (v1[0] * v1[0] + v1[1] * v1[1]) + (v1[2] * v1[2] + v1[3] * v1[3]);
          h8 o;
          o[0] = (_Float16)(v0[0] * 64.f); o[1] = (_Float16)(v0[1] * 64.f); o[2] = (_Float16)(v0[2] * 64.f); o[3] = (_Float16)(v0[3] * 64.f);
          o[4] = (_Float16)(v1[0] * 64.f); o[5] = (_Float16)(v1[1] * 64.f); o[6] = (_Float16)(v1[2] * 64.f); o[7] = (_Float16)(v1[3] * 64.f);
          *reinterpret_cast<h8*>(y + (size_t)row * DM + colb + bj * HALF) = o;
        }
        s += __shfl_xor(s, 16, 64); s += __shfl_xor(s, 32, 64);
        if (fq == 0) atomicAdd(ssq + row, s);
      }
  }
};

__device__ __forceinline__ void phase_post(const P& p, int bid, int nblk) {
  const int tid = otid(), lane = tid & 63, wid = tid >> 6;
  const __half* y = p.hm();
  f32x4 gv[2][2];
#pragma unroll
  for (int j = 0; j < 2; ++j) {
    gv[j][0] = *reinterpret_cast<const f32x4*>(p.g_post + j * 512 + lane * 8);
    gv[j][1] = *reinterpret_cast<const f32x4*>(p.g_post + j * 512 + lane * 8 + 4);
  }
  const int stride = nblk * 8;
  for (int t = bid * 8 + wid; t < T_; t += 2 * stride) {
    const int t1 = t + stride;
    const bool has1 = t1 < T_;
    const float tot0 = __hip_atomic_load(p.ssq() + t, __ATOMIC_RELAXED, __HIP_MEMORY_SCOPE_AGENT);
    const float tot1 = has1 ? __hip_atomic_load(p.ssq() + t1, __ATOMIC_RELAXED, __HIP_MEMORY_SCOPE_AGENT) : 1.f;
    h8 xv[2][2], yv[2][2];
#pragma unroll
    for (int j = 0; j < 2; ++j) {
      const size_t off0 = (size_t)t * DM + j * 512 + lane * 8, off1 = (size_t)(has1 ? t1 : t) * DM + j * 512 + lane * 8;
      xv[0][j] = __builtin_nontemporal_load(reinterpret_cast<const h8*>(p.xh() + off0));
      yv[0][j] = __builtin_nontemporal_load(reinterpret_cast<const h8*>(y + off0));
      xv[1][j] = __builtin_nontemporal_load(reinterpret_cast<const h8*>(p.xh() + off1));
      yv[1][j] = __builtin_nontemporal_load(reinterpret_cast<const h8*>(y + off1));
    }
    const float r0 = rsqrtf(tot0 * (1.f / DM) + EPS) * (1.f / 64.f), r1 = rsqrtf(tot1 * (1.f / DM) + EPS) * (1.f / 64.f);
#pragma unroll
    for (int i = 0; i < 2; ++i) {
      if (i == 1 && !has1) break;
      const float r = i ? r1 : r0;
      const int tt = i ? t1 : t;
#pragma unroll
      for (int j = 0; j < 2; ++j) {
        const size_t off = (size_t)tt * DM + j * 512 + lane * 8;
        f32x4 o0, o1;
#pragma unroll
        for (int k = 0; k < 4; ++k) { o0[k] = (float)xv[i][j][k] + (float)yv[i][j][k] * r * gv[j][0][k]; o1[k] = (float)xv[i][j][4 + k] + (float)yv[i][j][4 + k] * r * gv[j][1][k]; }
        __builtin_nontemporal_store(o0, reinterpret_cast<f32x4*>(p.out + off));
        __builtin_nontemporal_store(o1, reinterpret_cast<f32x4*>(p.out + off + 4));
      }
    }
  }
}

template <class Epi>
__device__ __forceinline__ void gemm_phase(LAS unsigned char* lds, const __half* gA, const __half* gBt, int M, int N, int K, const StaticOrder& S, const Epi& E) {
  const int tid = otid(), wid = __builtin_amdgcn_readfirstlane(tid >> 6), lane = tid & 63, wr = wid >> 2, wc = wid & 3, fr = lane & 15, fq = lane >> 4;
  const int nt = K / BK;
  unsigned voffA[2], voffB[2];
#pragma unroll
  for (int i = 0; i < 2; ++i) { int R, C; stage_rc(tid * 16 + i * 8192, R, C); const int Rb = Epi::PERM ? ((R & ~31) + perm32(R & 31)) : R;
    voffA[i] = (unsigned)(R * K + C) * 2u; voffB[i] = (unsigned)(Rb * K + C) * 2u; }
  const size_t kstep = (size_t)(BK * 2);
  const size_t hstep = (size_t)HALF * K * 2;
  const size_t tstep = 2 * hstep;
  const unsigned ldsw = (unsigned)wid * 1024u;
  const int aoff = lds_byte(wr * 64 + fr, fq * 8), boff = lds_byte(wc * 32 + fr, fq * 8);
#define PG8_SA(b, h) (((b) * 2 + (h)) * HTB)
#define PG8_SB(b, h) ((4 + (b) * 2 + (h)) * HTB)
#define PG8_STAGE(bufoff, gbase, voff) do { _Pragma("unroll") for (int _i = 0; _i < 2; ++_i) \
    __builtin_amdgcn_global_load_lds((const unsigned*)((const char*)(gbase) + (voff)[_i]), (LAS unsigned*)(lds + (bufoff) + ldsw + _i * 8192), 16, 0, 0); } while (0)
#define PG8_LDA(dst, b, h) do { _Pragma("unroll") for (int m = 0; m < 4; ++m) _Pragma("unroll") for (int k = 0; k < 2; ++k) dst[m][k] = *(const LAS h8*)(lds + PG8_SA(b, h) + aoff + m * 2048 + k * 1024); } while (0)
#define PG8_LDB(dst, b, h) do { _Pragma("unroll") for (int n = 0; n < 2; ++n) _Pragma("unroll") for (int k = 0; k < 2; ++k) dst[n][k] = *(const LAS h8*)(lds + PG8_SB(b, h) + boff + n * 2048 + k * 1024); } while (0)
#define PG8_MMA(ai, bj, At, Bt) do { __builtin_amdgcn_s_setprio(1); _Pragma("unroll") for (int m = 0; m < 4; ++m) _Pragma("unroll") for (int n = 0; n < 2; ++n) _Pragma("unroll") for (int k = 0; k < 2; ++k) \
    acc[ai][bj][m][n] = __builtin_amdgcn_mfma_f32_16x16x32_f16(Bt[n][k], At[m][k], acc[ai][bj][m][n], 0, 0, 0); __builtin_amdgcn_s_setprio(0); } while (0)
#define PG8_WAIT_V(n) asm volatile("s_waitcnt vmcnt(" #n ")" ::: "memory")
#define PG8_WAIT_L(n) asm volatile("s_waitcnt lgkmcnt(" #n ")" ::: "memory")
#define PG8_BAR __builtin_amdgcn_s_barrier()
#define PG8_SCHED __builtin_amdgcn_sched_barrier(0)
  Unit cur, nxt; int ui = 0;
  if (!S.next(0, cur)) return;
  f32x4 acc[2][2][4][2];
#pragma unroll
  for (int a = 0; a < 2; ++a)
#pragma unroll
    for (int b = 0; b < 2; ++b)
#pragma unroll
      for (int m = 0; m < 4; ++m)
#pragma unroll
        for (int n = 0; n < 2; ++n) acc[a][b][m][n] = (f32x4){0.f, 0.f, 0.f, 0.f};
  h8 At[4][2], B0[2][2], B1[2][2];
  const char* cA = (const char*)gA + (size_t)cur.pm * tstep; const char* cB = (const char*)gBt + (size_t)cur.pn * tstep;
  PG8_STAGE(PG8_SB(0, 0), cB, voffB); PG8_STAGE(PG8_SA(0, 0), cA, voffA); PG8_STAGE(PG8_SB(0, 1), cB + hstep, voffB); PG8_STAGE(PG8_SA(0, 1), cA + hstep, voffA);
  if (wr == 1) PG8_BAR;
  PG8_WAIT_V(4); PG8_BAR;
  PG8_STAGE(PG8_SB(1, 0), cB + kstep, voffB); PG8_STAGE(PG8_SA(1, 0), cA + kstep, voffA); PG8_STAGE(PG8_SB(1, 1), cB + hstep + kstep, voffB);
  PG8_WAIT_V(6); PG8_BAR;
  for (;;) {
    const bool has_next = S.next(ui + 1, nxt);
    const char* nA = has_next ? (const char*)gA + (size_t)nxt.pm * tstep : cA; const char* nB = has_next ? (const char*)gBt + (size_t)nxt.pn * tstep : cB;
    for (int t = 0; t < nt; t += 2) {
      const bool last = (t == nt - 2);
      const char* a1 = cA + (size_t)(t + 1) * kstep;
      const char* a2 = last ? nA : cA + (size_t)(t + 2) * kstep; const char* b2 = last ? nB : cB + (size_t)(t + 2) * kstep;
      const char* a3 = a2 + kstep; const char* b3 = b2 + kstep;
      PG8_LDB(B0, 0, 0); PG8_SCHED; PG8_LDA(At, 0, 0); PG8_STAGE(PG8_SA(1, 1), a1 + hstep, voffA);
      PG8_WAIT_L(8); PG8_BAR; PG8_WAIT_L(0); PG8_MMA(0, 0, At, B0); PG8_BAR; PG8_SCHED;
      PG8_LDB(B1, 0, 1); PG8_STAGE(PG8_SB(0, 0), b2, voffB);
      PG8_BAR; PG8_WAIT_L(0); PG8_MMA(0, 1, At, B1); PG8_BAR;
      PG8_LDA(At, 0, 1); PG8_STAGE(PG8_SA(0, 0), a2, voffA);
      PG8_BAR; PG8_WAIT_L(0); PG8_MMA(1, 0, At, B0); PG8_BAR; PG8_SCHED;
      PG8_STAGE(PG8_SB(0, 1), b2 + hstep, voffB);
      PG8_WAIT_V(6); PG8_BAR; PG8_MMA(1, 1, At, B1); PG8_BAR;
      PG8_LDB(B0, 1, 0); PG8_SCHED; PG8_LDA(At, 1, 0); PG8_STAGE(PG8_SA(0, 1), a2 + hstep, voffA);
      PG8_WAIT_L(8); PG8_BAR; PG8_WAIT_L(0); PG8_MMA(0, 0, At, B0); PG8_BAR; PG8_SCHED;
      PG8_LDB(B1, 1, 1); PG8_STAGE(PG8_SB(1, 0), b3, voffB);
      PG8_BAR; PG8_WAIT_L(0); PG8_MMA(0, 1, At, B1); PG8_BAR;
      PG8_LDA(At, 1, 1); PG8_STAGE(PG8_SA(1, 0), a3, voffA);
      PG8_BAR; PG8_WAIT_L(0); PG8_MMA(1, 0, At, B0); PG8_BAR; PG8_SCHED;
      PG8_STAGE(PG8_SB(1, 1), b3 + hstep, voffB);
      PG8_WAIT_V(6); PG8_BAR; PG8_MMA(1, 1, At, B1); PG8_BAR;
    }
    E(acc, cur, wr, wc, fr, fq);
    if (!has_next) break;
#pragma unroll
    for (int a = 0; a < 2; ++a)
#pragma unroll
      for (int b = 0; b < 2; ++b)
#pragma unroll
        for (int m = 0; m < 4; ++m)
#pragma unroll
          for (int n = 0; n < 2; ++n) acc[a][b][m][n] = (f32x4){0.f, 0.f, 0.f, 0.f};
    cur = nxt; cA = nA; cB = nB; ++ui;
  }
  PG8_WAIT_V(0);
  if (wr == 0) PG8_BAR;
  PG8_BAR;
#undef PG8_SA
#undef PG8_SB
#undef PG8_STAGE
#undef PG8_LDA
#undef PG8_LDB
#undef PG8_MMA
#undef PG8_WAIT_V
#undef PG8_WAIT_L
#undef PG8_BAR
#undef PG8_SCHED
}

constexpr int AT_K = 0, AT_V = 24576, AT_WS = 49152, AT_KM = 51200, AT_OST = 55296, AT_FLG = AT_OST + 8 * 8192, AT_ORD = AT_FLG + 64, AT_QS = AT_ORD + 256, AT_Q = AT_QS + 64, AT_LDS = AT_Q + 8 * 4096;
constexpr float PRUNE = (PROBE == 12 || PROBE == 13) ? 1e30f : 40.f;
constexpr float LOG2E = 1.4426950408889634f;
constexpr float C2 = 0.125f * LOG2E;
constexpr float THR = (PROBE == 30) ? 0.f : 8.f;
enum { M_MOBA = 0, M_SLC = 1, M_WIN = 2 };
typedef short v4i16_t __attribute__((ext_vector_type(4)));

__device__ __forceinline__ int crow(int r, int hi) { return (r & 3) + 8 * (r >> 2) + 4 * hi; }
__device__ __forceinline__ void glds16(const void* g, LAS unsigned char* l) {
  __builtin_amdgcn_global_load_lds((const unsigned*)g, (LAS unsigned*)l, 16, 0, 0);
}
__device__ __forceinline__ h4 vtr(const LAS unsigned char* p) {
  return __builtin_bit_cast(h4, __builtin_amdgcn_ds_read_tr16_b64_v4i16((LAS v4i16_t*)p));
}
__device__ __forceinline__ void scale_rows(f32x16 (&o)[2], float f, LAS float* wsf, int r32, int hi) {
  if (hi == 0) wsf[r32] = f;
#pragma unroll
  for (int r = 0; r < 16; ++r) { const float a = wsf[crow(r, hi)]; o[0][r] *= a; o[1][r] *= a; }
}

#define SBAR() __builtin_amdgcn_sched_barrier(0)
#define PINV(x) asm volatile("" : "+v"(x))
#define MFMA32(a, b, c) __builtin_amdgcn_mfma_f32_32x32x16_f16((a), (b), (c), 0, 0, 0)
__device__ __forceinline__ h8 kfrag(const LAS unsigned char* kp, int f) { return *(const LAS h8*)(kp + (f >> 1) * 2048 + (f & 1) * 512); }
__device__ __forceinline__ h8 vfrag(const LAS unsigned char* vp, int f) {
  const LAS unsigned char* a = vp + (f & 1) * 4096 + (f >> 1) * 1024;
  const h4 lo = vtr(a), hv = vtr(a + 512);
  return __builtin_shufflevector(lo, hv, 0, 1, 2, 3, 4, 5, 6, 7);
}

__device__ __forceinline__ void glds16_asm(const void* g, unsigned lds_base) {
  unsigned sv;
  asm volatile("s_mov_b32 %0, m0\n\ts_mov_b32 m0, %2\n\ts_nop 0\n\tglobal_load_lds_dwordx4 %1, off\n\ts_mov_b32 m0, %0" : "=&s"(sv) : "v"(g), "s"(lds_base) : "memory");
}
#define WAIT_BAR(N) asm volatile("s_waitcnt vmcnt(" #N ") lgkmcnt(0)\n\ts_barrier" ::: "memory")

template <int MODE, bool HASPREV>
__device__ __forceinline__ void fstep(h8 (&pw)[4], f32x16 (&o)[2], const f32x16& bfix, const h8 (&qf)[4],
                                      h8 (&kf)[8], float& m, float& l, const LAS unsigned char* kpn,
                                      const LAS unsigned char* vpp, LAS float* wsf, LAS int* flgw, int kt, int q0, int tq, int tq_min, int tq_max,
                                      int hi, int r32, int lane, float slope2, unsigned long long rowmask, float ubc) {
  f32x16 C0, C1;
  h8 vf[8];
#pragma unroll
  for (int i = 0; i < 8; ++i) {
    if (HASPREV) vf[i] = vfrag(vpp, i);
    const int d0 = i >> 1;
    if (i & 1) C1 = MFMA32(kf[i], qf[d0], d0 == 0 ? bfix : C1);
    else       C0 = MFMA32(kf[i], qf[d0], d0 == 0 ? bfix : C0);
    SBAR();
  }
  const int k0 = kt * 64;
  const float bnd = ubc - slope2 * (float)max(tq - k0 - 63, 0);
  bool need = (k0 <= tq) && (bnd >= m - PRUNE);
  if (MODE == M_MOBA) need = need && (((unsigned)rowmask >> (kt >> 2)) & 1u);
  if (MODE == M_SLC) need = need && ((rowmask >> kt) & 1ull);
  if (MODE == M_WIN) need = need && (k0 + 63 >= tq - 511);
  const bool edge = (k0 + 63 > tq_min) || (MODE == M_WIN && k0 < tq_max - 511);
  if (edge) {
    const int rel = tq - k0 - 4 * hi;
#pragma unroll
    for (int r = 0; r < 16; ++r) {
      const int e0 = (r & 3) + 8 * (r >> 2), e1 = e0 + 32;
      bool ok0 = e0 <= rel, ok1 = e1 <= rel;
      if (MODE == M_WIN) { ok0 = ok0 && (e0 >= rel - 511); ok1 = ok1 && (e1 >= rel - 511); }
      C0[r] = ok0 ? C0[r] : -1e30f; C1[r] = ok1 ? C1[r] : -1e30f;
    }
  }
  const float off1 = 32.f * slope2;
  const float base_t = slope2 * (float)(k0 - q0);
  bool resc = false;
  if (__any(need && (bnd > m + THR))) {
    float mx0 = C0[0], mx1 = C1[0];
#pragma unroll
    for (int r = 1; r < 16; ++r) { mx0 = fmaxf(mx0, C0[r]); mx1 = fmaxf(mx1, C1[r]); }
    float mxs = fmaxf(mx0 * C2, __builtin_fmaf(mx1, C2, off1));
    { const auto rr = __builtin_amdgcn_permlane32_swap(__float_as_uint(mxs), __float_as_uint(mxs), false, false);
      mxs = fmaxf(__uint_as_float(rr[0]), __uint_as_float(rr[1])); }
    const float mt2 = need ? (mxs + base_t) : -1e30f;
    resc = __any(mt2 - m > THR);
    if (resc) {
      const float mn = fmaxf(m, mt2);
      const float alpha = __builtin_amdgcn_exp2f(m - mn);
      l *= alpha; m = mn;
      if (hi == 0) wsf[r32] = alpha;
    }
  }
  const float nm0 = need ? (base_t - m) : -INFINITY;
  const float nm1 = nm0 + off1;
  {
    const bool live_next = (ubc - slope2 * (float)max(tq - k0 + 1, 0)) >= m - PRUNE;
    const int a = __any(live_next) ? 1 : 0;
    if (lane == 0) *flgw = a;
  }
  SBAR();
  float sacc = 0.f;
  h8 pn[4];
#pragma unroll
  for (int i = 0; i < 8; ++i) {
    kf[i] = kfrag(kpn, i);
    if (HASPREV) {
      if (i & 1) o[1] = MFMA32(pw[i >> 1], vf[i], o[1]);
      else       o[0] = MFMA32(pw[i >> 1], vf[i], o[0]);
    }
    float e[4];
#pragma unroll
    for (int j = 0; j < 4; ++j)
      e[j] = (i < 4) ? __builtin_amdgcn_exp2f(__builtin_fmaf(C0[4 * i + j], C2, nm0)) : __builtin_amdgcn_exp2f(__builtin_fmaf(C1[4 * (i - 4) + j], C2, nm1));
    sacc += (e[0] + e[1]) + (e[2] + e[3]);
    pn[i >> 1][(i & 1) * 4 + 0] = (_Float16)e[0]; pn[i >> 1][(i & 1) * 4 + 1] = (_Float16)e[1];
    pn[i >> 1][(i & 1) * 4 + 2] = (_Float16)e[2]; pn[i >> 1][(i & 1) * 4 + 3] = (_Float16)e[3];
    PINV(sacc); PINV(pn[i >> 1]);
    SBAR();
  }
  l += sacc;
#pragma unroll
  for (int s = 0; s < 4; ++s) pw[s] = pn[s];
  if (HASPREV && resc) {
#pragma unroll
    for (int r = 0; r < 16; ++r) { const float a = wsf[crow(r, hi)]; o[0][r] *= a; o[1][r] *= a; }
  }
}

__device__ __forceinline__ void fdrain(const h8 (&pw)[4], f32x16 (&o)[2], const LAS unsigned char* vp) {
#pragma unroll
  for (int f = 0; f < 8; ++f) {
    const h8 v = vfrag(vp, f);
    if (f & 1) o[1] = MFMA32(pw[f >> 1], v, o[1]); else o[0] = MFMA32(pw[f >> 1], v, o[0]);
  }
}

template <int MODE>
__device__ __forceinline__ void flash_pipe(LAS unsigned char* lds, const __half* Kg, const __half* Vg, int q0, int kt_lo, int kt_hi,
                                           const f32x16& bfix, float slope2, unsigned long long rowmask, float ubc,
                                           f32x16 (&o)[2], float& l_tot) {
  const int tid = otid(), lane = tid & 63, r32 = lane & 31, hi = lane >> 5;
  const int wid = __builtin_amdgcn_readfirstlane(tid >> 6);
  const int tq = q0 + wid * 32 + r32, tq_min = q0 + wid * 32, tq_max = tq_min + 31;
  LAS float* wsf = (LAS float*)(lds + AT_WS) + wid * 64;
  LAS int* flg = (LAS int*)(lds + AT_FLG);
  const __half* ksrc = Kg + (size_t)lane * 64 + wid * 8;
  const __half* vsrc = Vg + (size_t)(16 * (wid & 3) + (lane >> 2)) * 64 + (wid >> 2) * 32 + (lane & 3) * 8;
  const unsigned kdst = (unsigned)(unsigned long)(lds + AT_K) + wid * 1024;
  const unsigned vdst = (unsigned)(unsigned long)(lds + AT_V) + wid * 1024;
  const LAS unsigned char* kp0 = lds + AT_K + hi * 1024 + r32 * 16;
  const LAS unsigned char* vp0 = lds + AT_V + ((lane >> 4) & 1) * 32 + (lane & 3) * 8 + (4 * hi + ((lane & 15) >> 2)) * 64;
  const LAS unsigned char* qp = lds + AT_Q + wid * 4096 + lane * 16;
  h8 qf[4];
#pragma unroll
  for (int d0 = 0; d0 < 4; ++d0) qf[d0] = *(const LAS h8*)(qp + d0 * 1024);
#pragma unroll
  for (int r = 0; r < 16; ++r) { o[0][r] = 0.f; o[1][r] = 0.f; }
  float m = -1e30f, l = 0.f;
  h8 kf[8], pw[4];
#define KT_(t) max(kt_hi - (t), kt_lo)
#define DMA_K(t, slot) glds16_asm(ksrc + (size_t)KT_(t) * 4096, (unsigned)__builtin_amdgcn_readfirstlane(kdst + (slot)))
#define DMA_V(t, slot) glds16_asm(vsrc + (size_t)KT_(t) * 4096, (unsigned)__builtin_amdgcn_readfirstlane(vdst + (slot)))
  asm volatile("s_waitcnt vmcnt(0)" ::: "memory");
  DMA_K(0, 0); DMA_K(1, 8192); DMA_K(2, 16384); DMA_V(0, 0);
  WAIT_BAR(2);
#pragma unroll
  for (int i = 0; i < 8; ++i) kf[i] = kfrag(kp0, i);
  WAIT_BAR(2);
  int t = 0, kt = kt_hi;
  int s0 = 0, s1 = 8192, s2 = 16384;
#define STEP_CLOSE(done) do { WAIT_BAR(2);     \
    { const LAS int* f_ = flg + (kt & 1) * 8; const int any_live = f_[0] | f_[1] | f_[2] | f_[3] | f_[4] | f_[5] | f_[6] | f_[7]; done = (!any_live) || (kt == kt_lo); } } while (0)
#define STEP_ROT() do { const int t_ = s0; s0 = s1; s1 = s2; s2 = t_; ++t; --kt; } while (0)
  bool done;
  DMA_K(3, s0); DMA_V(1, s1);
  fstep<MODE, false>(pw, o, bfix, qf, kf, m, l, kp0 + s1, vp0, wsf, flg + (kt & 1) * 8 + wid, kt, q0, tq, tq_min, tq_max, hi, r32, lane, slope2, rowmask, ubc);
  STEP_CLOSE(done);
  while (!done) {
    STEP_ROT();
    DMA_K(t + 3, s0); DMA_V(t + 1, s1);
    fstep<MODE, true>(pw, o, bfix, qf, kf, m, l, kp0 + s1, vp0 + s2  , wsf, flg + (kt & 1) * 8 + wid, kt, q0, tq, tq_min, tq_max, hi, r32, lane, slope2, rowmask, ubc);
    STEP_CLOSE(done);
  }
  fdrain(pw, o, vp0 + s0);
  WAIT_BAR(0);
#undef KT_
#undef DMA_K
#undef DMA_V
#undef STEP_CLOSE
#undef STEP_ROT
  l_tot = l + __shfl_xor(l, 32, 64);
}

__device__ __forceinline__ float score_bound(const P& p, const h8 (&qf)[4], int b, int slot) {
  float ss = 0.f;
#pragma unroll
  for (int d0 = 0; d0 < 4; ++d0)
#pragma unroll
    for (int j = 0; j < 8; ++j) { const float v = (float)qf[d0][j]; ss += v * v; }
  ss += __shfl_xor(ss, 32, 64);
  const unsigned* kn = p.kn2() + ((size_t)b * 60 + slot) * 2;
  const float kmax = sqrtf(__uint_as_float(kn[0]) + __uint_as_float(kn[1])) * 1.002f;
  return C2 * sqrtf(ss) * kmax * 1.001f;
}

__device__ __forceinline__ void put_q(LAS unsigned char* lds, const h8 (&qf)[4], int wid, int lane) {
  LAS unsigned char* qp = lds + AT_Q + wid * 4096 + lane * 16;
#pragma unroll
  for (int d0 = 0; d0 < 4; ++d0) *(LAS h8*)(qp + d0 * 1024) = qf[d0];
}

__device__ __forceinline__ void moba_unit(const P& p, LAS unsigned char* lds, int b, int h, int own) {
  const int tid = otid(), lane = tid & 63, r32 = lane & 31, hi = lane >> 5;
  const int wid = __builtin_amdgcn_readfirstlane(tid >> 6);
  const int q0 = own * 256;
  const size_t bh = (size_t)b * 8 + h;
  LAS float* km = (LAS float*)(lds + AT_KM);
  for (int e = tid; e < own * 64; e += 512) {
    const int n = e >> 6, d = e & 63;
    const float* kp = p.kmp() + ((bh * 16 + n) * 2) * 64 + d;
    km[e] = (kp[0] + kp[64]) * (1.f / 256.f);
  }
  h8 qf[4];
  const __half* qrow = hmp(p, SL_QA + h, b, q0 + wid * 32 + r32);
#pragma unroll
  for (int d0 = 0; d0 < 4; ++d0) qf[d0] = *reinterpret_cast<const h8*>(qrow + d0 * 16 + hi * 8);
  __syncthreads();
  float g0 = -3e38f, g1 = -3e38f, g2 = -3e38f; int i0 = -1, i1 = -1, i2 = -1;
  for (int n = 0; n < own; ++n) {
    float s = 0.f;
#pragma unroll
    for (int d0 = 0; d0 < 4; ++d0)
#pragma unroll
      for (int j = 0; j < 8; ++j) s += (float)qf[d0][j] * km[n * 64 + d0 * 16 + hi * 8 + j];
    s += __shfl_xor(s, 32, 64);
    if (s > g0) { g2 = g1; i2 = i1; g1 = g0; i1 = i0; g0 = s; i0 = n; }
    else if (s > g1) { g2 = g1; i2 = i1; g1 = s; i1 = n; }
    else if (s > g2) { g2 = s; i2 = n; }
  }
  unsigned long long rowmask = 1ull << own;
  if (i0 >= 0) rowmask |= 1ull << i0;
  if (i1 >= 0) rowmask |= 1ull << i1;
  if (i2 >= 0) rowmask |= 1ull << i2;
  const float slope = exp2f(-(float)(h + 1));
  const float slope2 = slope * LOG2E;
  f32x16 bfix;
  {
    const float sb = slope * 8.f;
    const int qrel = wid * 32 + r32;
#pragma unroll
    for (int r = 0; r < 16; ++r) bfix[r] = sb * (float)((r & 3) + 8 * (r >> 2) + 4 * hi - qrel);
  }
  f32x16 o[2]; float l_tot;
  const float ubc = score_bound(p, qf, b, SL_KA + h);
  put_q(lds, qf, wid, lane);
  flash_pipe<M_MOBA>(lds, hmp(p, SL_KA + h, b, 0), hmp(p, SL_VA + h, b, 0), q0, 0, 4 * own + 3, bfix, slope2, rowmask, ubc, o, l_tot);
  if (PROBE == 11 || PROBE == 13) flash_pipe<M_MOBA>(lds, hmp(p, SL_KA + h, b, 0), hmp(p, SL_VA + h, b, 0), q0, 0, 4 * own + 3, bfix, slope2, rowmask, ubc, o, l_tot);
  LAS float* wsf = (LAS float*)(lds + AT_WS) + wid * 64;
  scale_rows(o, 1.f / fmaxf(l_tot, 1e-30f), wsf, r32, hi);
  LAS _Float16* stg = (LAS _Float16*)(lds + AT_OST + wid * 4096);
#pragma unroll
  for (int r = 0; r < 16; ++r) {
    const int orow = crow(r, hi);
    stg[orow * 64 + r32] = (_Float16)o[0][r];
    stg[orow * 64 + 32 + r32] = (_Float16)o[1][r];
  }
  const int t3 = otid(), lane3 = t3 & 63, wid3 = t3 >> 6;
#pragma unroll
  for (int i = 0; i < 4; ++i) {
    const int row = i * 8 + (lane3 >> 3), ch = lane3 & 7;
    const h8 v = *(const LAS h8*)(stg + row * 64 + ch * 8);
    const int t = q0 + wid3 * 32 + row;
    const h8 z = *reinterpret_cast<const h8*>(hmp(p, SL_ZA + h, b, t) + ch * 8);
    h8 ov;
#pragma unroll
    for (int j = 0; j < 8; ++j) ov[j] = (_Float16)((float)v[j] * silu((float)z[j]));
    *reinterpret_cast<h8*>(p.cat() + ((size_t)b * S_ + t) * DM + h * 64 + ch * 8) = ov;
  }
  __syncthreads();
}

__device__ __forceinline__ void nsa_unit(const P& p, LAS unsigned char* lds, int b, int h, int qblk) {
  const int tid = otid(), lane = tid & 63, r32 = lane & 31, hi = lane >> 5;
  const int wid = __builtin_amdgcn_readfirstlane(tid >> 6);
  const int q0 = qblk * 256, g = h >> 2;
  const int tq = q0 + wid * 32 + r32;
  h8 qf[4];
  const __half* qrow = hmp(p, SL_QB + h, b, tq);
#pragma unroll
  for (int d0 = 0; d0 < 4; ++d0) qf[d0] = *reinterpret_cast<const h8*>(qrow + d0 * 16 + hi * 8);
  const unsigned long long rowmask = p.sel()[((size_t)b * 2 + g) * S_ + tq];
  const float slope = exp2f(-(float)(h + 1));
  const float slope2 = slope * LOG2E;
  f32x16 bfix;
  {
    const float sb = slope * 8.f;
    const int qrel = wid * 32 + r32;
#pragma unroll
    for (int r = 0; r < 16; ++r) bfix[r] = sb * (float)((r & 3) + 8 * (r >> 2) + 4 * hi - qrel);
  }
  LAS float* wsf = (LAS float*)(lds + AT_WS) + wid * 64;
  f32x16 o[2]; float l_tot;
  LAS float* st32 = (LAS float*)(lds + AT_OST + wid * 8192);
  const float ubc_s = score_bound(p, qf, b, SL_KV6 + 4 + g), ubc_w = score_bound(p, qf, b, SL_KV6 + 8 + g);
  put_q(lds, qf, wid, lane);
  flash_pipe<M_SLC>(lds, hmp(p, SL_KV6 + 4 + g, b, 0), hmp(p, SL_KV6 + 6 + g, b, 0), q0, 0, 4 * qblk + 3, bfix, slope2, rowmask, ubc_s, o, l_tot);
  if (PROBE == 11 || PROBE == 13) flash_pipe<M_SLC>(lds, hmp(p, SL_KV6 + 4 + g, b, 0), hmp(p, SL_KV6 + 6 + g, b, 0), q0, 0, 4 * qblk + 3, bfix, slope2, rowmask, ubc_s, o, l_tot);
  {
    const int t2 = otid(), tq2 = q0 + (t2 >> 6) * 32 + (t2 & 31);
    const float g1 = p.gate()[((size_t)b * S_ + tq2) * 24 + h * 3 + 1];
    scale_rows(o, g1 / fmaxf(l_tot, 1e-30f), wsf, r32, hi);
  }
#pragma unroll
  for (int r = 0; r < 16; ++r) { const int orow = crow(r, hi); st32[orow * 64 + r32] = o[0][r]; st32[orow * 64 + 32 + r32] = o[1][r]; }
  const int wlo = qblk >= 2 ? 4 * qblk - 8 : 0;
  flash_pipe<M_WIN>(lds, hmp(p, SL_KV6 + 8 + g, b, 0), hmp(p, SL_KV6 + 10 + g, b, 0), q0, wlo, 4 * qblk + 3, bfix, slope2, 0ull, ubc_w, o, l_tot);
  if (PROBE == 11 || PROBE == 13) flash_pipe<M_WIN>(lds, hmp(p, SL_KV6 + 8 + g, b, 0), hmp(p, SL_KV6 + 10 + g, b, 0), q0, wlo, 4 * qblk + 3, bfix, slope2, 0ull, ubc_w, o, l_tot);
  {
    const int t2 = otid(), tq2 = q0 + (t2 >> 6) * 32 + (t2 & 31);
    const float g2 = p.gate()[((size_t)b * S_ + tq2) * 24 + h * 3 + 2];
    scale_rows(o, g2 / fmaxf(l_tot, 1e-30f), wsf, r32, hi);
  }
  LAS _Float16* stg = (LAS _Float16*)(lds + AT_OST + wid * 8192);
  {
    float tmp0[16], tmp1[16];
#pragma unroll
    for (int r = 0; r < 16; ++r) { const int orow = crow(r, hi); tmp0[r] = st32[orow * 64 + r32] + o[0][r]; tmp1[r] = st32[orow * 64 + 32 + r32] + o[1][r]; }
    __builtin_amdgcn_wave_barrier();
#pragma unroll
    for (int r = 0; r < 16; ++r) { const int orow = crow(r, hi); stg[orow * 64 + r32] = (_Float16)tmp0[r]; stg[orow * 64 + 32 + r32] = (_Float16)tmp1[r]; }
  }
  const int t3 = otid(), lane3 = t3 & 63, wid3 = t3 >> 6;
#pragma unroll
  for (int i = 0; i < 4; ++i) {
    const int row = i * 8 + (lane3 >> 3), ch = lane3 & 7;
    const h8 v = *(const LAS h8*)(stg + row * 64 + ch * 8);
    const int t = q0 + wid3 * 32 + row;
    const h8 z = *reinterpret_cast<const h8*>(hmp(p, SL_ZB + h, b, t) + ch * 8);
    const float g0 = p.gate()[((size_t)b * S_ + t) * 24 + h * 3];
    const h8 oc = *reinterpret_cast<const h8*>(p.ocmph() + (((size_t)b * 8 + h) * S_ + t) * 64 + ch * 8);
    h8 ov;
#pragma unroll
    for (int j = 0; j < 8; ++j) ov[j] = (_Float16)(((float)v[j] + g0 * (float)oc[j]) * silu((float)z[j]));
    *reinterpret_cast<h8*>(p.cat() + ((size_t)b * S_ + t) * DM + 512 + h * 64 + ch * 8) = ov;
  }
  __syncthreads();
}


constexpr int CM_HID = 0;
constexpr int CM_X = 9216;
__device__ __forceinline__ void cm_unit(const P& p, LAS unsigned char* lds, int which, int b, int g, int mt) {
  const int tid = otid(), lane = tid & 63, r = lane & 15, q = lane >> 4;
  const int wid = __builtin_amdgcn_readfirstlane(tid >> 6);
  const int c0 = mt * 32;
  const __half* xs = hmp(p, SL_KV6 + 2 * which + g, b, 0) + (size_t)c0 * 1024;
  for (int pc = wid; pc < 66; pc += 8) glds16(xs + (size_t)pc * 512 + lane * 8, lds + CM_X + pc * 1040);
  const __half* bp = p.w1t() + ((size_t)which * 128 + wid * 16 + r) * 2048 + q * 8;
  const __half* pp = p.peh() + which * 2048 + q * 8;
  asm volatile("s_waitcnt vmcnt(0)" ::: "memory");
  __syncthreads();
  f32x4 acc0 = {0.f, 0.f, 0.f, 0.f}, acc1 = {0.f, 0.f, 0.f, 0.f};
  const LAS unsigned char* a0l = lds + CM_X + (2 * r) * 1040 + q * 16;
  const LAS unsigned char* a1l = lds + CM_X + (2 * (16 + r)) * 1040 + q * 16;
#pragma unroll 8
  for (int s = 0; s < 64; ++s) {
    const int off = (s >> 4) * 1040 + ((s >> 1) & 7) * 128 + (s & 1) * 64;
    const h8 pe = *reinterpret_cast<const h8*>(pp + s * 32);
    const h8 a0 = *(const LAS h8*)(a0l + off) + pe;
    const h8 a1 = *(const LAS h8*)(a1l + off) + pe;
    const h8 bf = *reinterpret_cast<const h8*>(bp + s * 32);
    acc0 = __builtin_amdgcn_mfma_f32_16x16x32_f16(a0, bf, acc0, 0, 0, 0);
    acc1 = __builtin_amdgcn_mfma_f32_16x16x32_f16(a1, bf, acc1, 0, 0, 0);
  }
  LAS _Float16* hid = (LAS _Float16*)(lds + CM_HID);
#pragma unroll
  for (int reg = 0; reg < 4; ++reg) {
    hid[(4 * q + reg) * 136 + wid * 16 + r] = (_Float16)silu(acc0[reg]);
    hid[(16 + 4 * q + reg) * 136 + wid * 16 + r] = (_Float16)silu(acc1[reg]);
  }
  __syncthreads();
  {
    const int mi = wid >> 2, ni = wid & 3;
    const __half* w2p = p.w2t() + ((size_t)which * 64 + ni * 16 + r) * 128 + q * 8;
    f32x4 acc = {0.f, 0.f, 0.f, 0.f};
#pragma unroll
    for (int s = 0; s < 4; ++s) {
      const h8 a = *(const LAS h8*)(hid + (mi * 16 + r) * 136 + s * 32 + q * 8);
      const h8 bf = *reinterpret_cast<const h8*>(w2p + s * 32);
      acc = __builtin_amdgcn_mfma_f32_16x16x32_f16(a, bf, acc, 0, 0, 0);
    }
    __half* dst = (which ? p.vch() : p.kch()) + ((size_t)b * 2 + g) * 256 * 64;
#pragma unroll
    for (int reg = 0; reg < 4; ++reg) {
      const int c = c0 + mi * 16 + 4 * q + reg;
      dst[(size_t)c * 64 + ni * 16 + r] = __float2half(c < 255 ? acc[reg] : 0.f);
    }
  }
  __syncthreads();
}

constexpr int CS_K = 0, CS_V = 32768, CS_SLAB = 65536, CS_SLAB_BYTES = 8 * 32 * 65 * 4, CS_WS = CS_SLAB + CS_SLAB_BYTES, CS_LDS = CS_WS + 2048;
__device__ __forceinline__ void cs_super(const P& p, LAS unsigned char* lds, int b, int g, int j) {
  const int tid = otid(), lane = tid & 63, r32 = lane & 31, hi = lane >> 5;
  const int wid = __builtin_amdgcn_readfirstlane(tid >> 6);
  const int hh = wid & 3, qi = wid >> 2, h = g * 4 + hh;
  const size_t bg = (size_t)b * 2 + g;
  {
    const __half* ksrc = p.kch() + bg * 256 * 64 + (size_t)lane * 64 + wid * 8;
    const __half* vsrc = p.vch() + bg * 256 * 64 + (size_t)(16 * (wid & 3) + (lane >> 2)) * 64 + (wid >> 2) * 32 + (lane & 3) * 8;
    for (int kt = 0; kt < 4; ++kt) {
      glds16(ksrc + (size_t)kt * 4096, lds + CS_K + kt * 8192 + wid * 1024);
      glds16(vsrc + (size_t)kt * 4096, lds + CS_V + kt * 8192 + wid * 1024);
    }
  }
  asm volatile("s_waitcnt vmcnt(0)" ::: "memory");
  __syncthreads();
  for (int oi = 0; oi < 4; ++oi) {
  const int own = oi == 0 ? j : oi == 1 ? 31 - j : oi == 2 ? 32 + j : 63 - j;
  const int q0 = own * 64;
  const int ntile = (4 * own + 66) >> 6;
  const int tq = q0 + qi * 32 + r32;
  const int ncv = tq >= 31 ? ((tq - 31) >> 4) + 1 : 0;
  h8 qf[4];
  const __half* qrow = hmp(p, SL_QB + h, b, tq);
#pragma unroll
  for (int d0 = 0; d0 < 4; ++d0) qf[d0] = *reinterpret_cast<const h8*>(qrow + d0 * 16 + hi * 8);
  const LAS unsigned char* kp0 = lds + CS_K + hi * 1024 + r32 * 16;
  const LAS unsigned char* vp0 = lds + CS_V + ((lane >> 4) & 1) * 32 + (lane & 3) * 8 + (4 * hi + ((lane & 15) >> 2)) * 64;
  const f32x16 zero16 = {0.f, 0.f, 0.f, 0.f, 0.f, 0.f, 0.f, 0.f, 0.f, 0.f, 0.f, 0.f, 0.f, 0.f, 0.f, 0.f};
  float m = -1e30f, l = 0.f;
  for (int kt = 0; kt < ntile; ++kt) {
    const LAS unsigned char* kp = kp0 + kt * 8192;
    f32x16 p0 = zero16, p1 = zero16;
#pragma unroll
    for (int d0 = 0; d0 < 4; ++d0) {
      const h8 k0f = *(const LAS h8*)(kp + d0 * 2048), k1f = *(const LAS h8*)(kp + d0 * 2048 + 512);
      p0 = __builtin_amdgcn_mfma_f32_32x32x16_f16(k0f, qf[d0], p0, 0, 0, 0);
      p1 = __builtin_amdgcn_mfma_f32_32x32x16_f16(k1f, qf[d0], p1, 0, 0, 0);
    }
    const int rel = ncv - 1 - 64 * kt - 4 * hi;
    float mx = -1e30f;
#pragma unroll
    for (int r = 0; r < 16; ++r) {
      const int e0 = (r & 3) + 8 * (r >> 2);
      p0[r] = e0 <= rel ? p0[r] : -1e30f; p1[r] = e0 + 32 <= rel ? p1[r] : -1e30f;
      mx = fmaxf(mx, fmaxf(p0[r], p1[r]));
    }
    mx = fmaxf(mx, __shfl_xor(mx, 32, 64));
    const float mn = fmaxf(m, mx * C2);
    float ls = 0.f;
#pragma unroll
    for (int r = 0; r < 16; ++r) ls += __builtin_amdgcn_exp2f(__builtin_fmaf(p0[r], C2, -mn)) + __builtin_amdgcn_exp2f(__builtin_fmaf(p1[r], C2, -mn));
    l = l * __builtin_amdgcn_exp2f(m - mn) + ls;
    m = mn;
  }
  float l_tot = l + __shfl_xor(l, 32, 64);
  const float inv = ncv > 0 ? 1.f / fmaxf(l_tot, 1e-30f) : 0.f;
  const float nm = ncv > 0 ? -m : -INFINITY;
  f32x16 o[2]; o[0] = zero16; o[1] = zero16;
  LAS float* slab = (LAS float*)(lds + CS_SLAB) + ((qi * 4 + hh) * 32 + r32) * 65;
  float carry = 0.f;
  for (int kt = 0; kt < ntile; ++kt) {
    const LAS unsigned char* kp = kp0 + kt * 8192;
    const LAS unsigned char* vp = vp0 + kt * 8192;
    f32x16 p0 = zero16, p1 = zero16;
#pragma unroll
    for (int d0 = 0; d0 < 4; ++d0) {
      const h8 k0f = *(const LAS h8*)(kp + d0 * 2048), k1f = *(const LAS h8*)(kp + d0 * 2048 + 512);
      p0 = __builtin_amdgcn_mfma_f32_32x32x16_f16(k0f, qf[d0], p0, 0, 0, 0);
      p1 = __builtin_amdgcn_mfma_f32_32x32x16_f16(k1f, qf[d0], p1, 0, 0, 0);
    }
    const int rel = ncv - 1 - 64 * kt - 4 * hi;
#pragma unroll
    for (int r = 0; r < 16; ++r) {
      const int e0 = (r & 3) + 8 * (r >> 2);
      const float a0 = e0 <= rel ? p0[r] : -1e30f, a1 = e0 + 32 <= rel ? p1[r] : -1e30f;
      p0[r] = __builtin_amdgcn_exp2f(__builtin_fmaf(a0, C2, nm)) * inv;
      p1[r] = __builtin_amdgcn_exp2f(__builtin_fmaf(a1, C2, nm)) * inv;
    }
#pragma unroll
    for (int n = 0; n < 2; ++n) {
#pragma unroll
      for (int rg = 0; rg < 4; ++rg) {
        const float t3 = n == 0 ? p0[4 * rg + 3] : p1[4 * rg + 3];
        const float gs = n == 0 ? (p0[4 * rg] + p0[4 * rg + 1]) + (p0[4 * rg + 2] + t3) : (p1[4 * rg] + p1[4 * rg + 1]) + (p1[4 * rg + 2] + t3);
        const float tp = __shfl_xor(t3, 32, 64);
        slab[2 * (8 * kt + 4 * n + rg) + hi] = gs + (hi ? tp : carry);
        carry = tp;
      }
    }
    h8 pa[4];
#pragma unroll
    for (int j = 0; j < 8; ++j) { pa[0][j] = (_Float16)p0[j]; pa[1][j] = (_Float16)p0[8 + j]; pa[2][j] = (_Float16)p1[j]; pa[3][j] = (_Float16)p1[8 + j]; }
#pragma unroll
    for (int s = 0; s < 4; ++s) {
#pragma unroll
      for (int dh = 0; dh < 2; ++dh) {
        const h4 lo = vtr(vp + dh * 4096 + s * 1024), hv = vtr(vp + dh * 4096 + s * 1024 + 512);
        const h8 vf = __builtin_shufflevector(lo, hv, 0, 1, 2, 3, 4, 5, 6, 7);
        o[dh] = __builtin_amdgcn_mfma_f32_32x32x16_f16(pa[s], vf, o[dh], 0, 0, 0);
      }
    }
  }
  __syncthreads();
  if (own < 16) {
    if (tid < 64) p.sel()[bg * S_ + q0 + tid] = (2ull << own) - 1ull;
  } else {
    const LAS float* sl = (const LAS float*)(lds + CS_SLAB);
    const int jj = lane;
    const bool cand = (jj >= 1) && (jj <= own - 2);
    const unsigned long long forced = 1ull | (1ull << own) | (1ull << (own - 1));
    for (int i = 0; i < 8; ++i) {
      const int qq = wid * 8 + i, q2 = qq >> 5, rr = qq & 31;
      float v = 0.f;
#pragma unroll
      for (int x = 0; x < 4; ++x) v += sl[((q2 * 4 + x) * 32 + rr) * 65 + jj];
      const unsigned key = cand ? (__float_as_uint(v) + 1u) : 0u;
      unsigned th = 0u;
#pragma unroll
      for (int bit = 30; bit >= 0; --bit) {
        const unsigned c = th | (1u << bit);
        const int cnt = __popcll(__ballot(key >= c));
        th = cnt >= 13 ? c : th;
      }
      const unsigned long long gt = __ballot(key > th), eq = __ballot(key == th);
      const int need = 13 - __popcll(gt);
      unsigned long long t = eq;
      for (int k = 0; k < need; ++k) t &= t - 1ull;
      const unsigned long long msk = gt | (eq ^ t) | forced;
      if (lane == 0) p.sel()[bg * S_ + q0 + qq] = msk;
    }
  }
  __syncthreads();
  {
    LAS _Float16* stg = (LAS _Float16*)(lds + CS_SLAB + wid * 4096);
#pragma unroll
    for (int r = 0; r < 16; ++r) {
      const int orow = crow(r, hi);
      stg[orow * 64 + r32] = (_Float16)o[0][r];
      stg[orow * 64 + 32 + r32] = (_Float16)o[1][r];
    }
#pragma unroll
    for (int i = 0; i < 4; ++i) {
      const int row = i * 8 + (lane >> 3), ch = lane & 7;
      const h8 v = *(const LAS h8*)(stg + row * 64 + ch * 8);
      const int t = q0 + qi * 32 + row;
      *reinterpret_cast<h8*>(p.ocmph() + (((size_t)b * 8 + h) * S_ + t) * 64 + ch * 8) = v;
    }
  }
  __syncthreads();
  }
}

#define XB_TMO      128
#define XB_XCNT(j)  (256  + 64 * (j))
#define XB_XSUB(j)  (1280 + 64 * (j))
#define XB_XGEN(j)  (2304 + 64 * (j))
#define XB_TOP      3328
#define XB_TOPGEN   3392
#define XCD_BAR_WORDS 3456
#define XB_SPIN_CAP (1u << 18)
__device__ __forceinline__ unsigned xb_ld(unsigned* p) { return __hip_atomic_load(p, __ATOMIC_RELAXED, __HIP_MEMORY_SCOPE_AGENT); }
__device__ __forceinline__ unsigned xb_add(unsigned* p, unsigned v) { return __hip_atomic_fetch_add(p, v, __ATOMIC_RELAXED, __HIP_MEMORY_SCOPE_AGENT); }
__device__ __forceinline__ unsigned xb_xcc_id() { return (unsigned)__builtin_amdgcn_s_getreg((3 << 11) | 20) & 0xFu; }
#define XB_SPIN(cond, bar) do { unsigned _sp = 0; while (cond) { __builtin_amdgcn_s_sleep(1); \
    if ((++_sp & 255u) == 0u) { if (xb_ld(&(bar)[XB_TMO])) break; if (_sp > XB_SPIN_CAP) { atomicAdd(&(bar)[XB_TMO], 1u); break; } } } } while (0)
struct XcdBarrier { unsigned* bar; unsigned x; volatile LAS unsigned* st; };
__device__ __forceinline__ XcdBarrier xcd_barrier_post(unsigned* bar, volatile LAS unsigned* st) {
  XcdBarrier b; b.bar = bar; b.x = xb_xcc_id(); b.st = st;
  if (threadIdx.x == 0) (void)xb_add(&bar[XB_XCNT(b.x)], 1u);
  return b;
}
__device__ __forceinline__ void xcd_barrier_complete(unsigned* bar, unsigned x, unsigned& nloc, unsigned& nx) {
  const unsigned G = gridDim.x * gridDim.y * gridDim.z;
  unsigned sum, cnt, mine, sp = 0u;
  for (;;) {
    sum = 0u; cnt = 0u; mine = 0u;
#pragma unroll
    for (unsigned j = 0; j < 16; ++j) { const unsigned c = xb_ld(&bar[XB_XCNT(j)]); sum += c; cnt += (c > 0u) ? 1u : 0u; mine = (j == x) ? c : mine; }
    if (sum == G) break;
    __builtin_amdgcn_s_sleep(1);
    if ((++sp & 255u) == 0u) { if (xb_ld(&bar[XB_TMO])) break; if (sp > XB_SPIN_CAP) { atomicAdd(&bar[XB_TMO], 1u); break; } }
  }
  nloc = mine > 0u ? mine : 1u; nx = cnt > 0u ? cnt : 1u;
}
__device__ __forceinline__ void xcd_barrier(const XcdBarrier& b) {
  asm volatile("s_waitcnt vmcnt(0)" ::: "memory");
  __syncthreads();
  if (threadIdx.x == 0) {
    unsigned* bar = b.bar;
    __builtin_amdgcn_s_waitcnt(0);
    unsigned nloc = b.st[0], nx = b.st[1];
    if (nloc == 0u) { xcd_barrier_complete(bar, b.x, nloc, nx); b.st[0] = nloc; b.st[1] = nx; }
    const unsigned old = xb_add(&bar[XB_XSUB(b.x)], 1u);
    const unsigned gen = old / nloc;
    if (old + 1u == (gen + 1u) * nloc) {
      __builtin_amdgcn_fence(__ATOMIC_RELEASE, "agent");
      asm volatile("s_waitcnt vmcnt(0)" ::: "memory");
      const unsigned og = xb_add(&bar[XB_TOP], 1u);
      const unsigned tg = og / nx;
      if (og + 1u == (tg + 1u) * nx) xb_add(&bar[XB_TOPGEN], 1u);
      else XB_SPIN(xb_ld(&bar[XB_TOPGEN]) == tg, bar);
      __builtin_amdgcn_fence(__ATOMIC_ACQUIRE, "agent");
      xb_add(&bar[XB_XGEN(b.x)], 1u);
      asm volatile("s_waitcnt vmcnt(0)" ::: "memory");
    } else {
      XB_SPIN(xb_ld(&bar[XB_XGEN(b.x)]) == gen, bar);
      __builtin_amdgcn_fence(__ATOMIC_ACQUIRE, "agent");
      asm volatile("s_waitcnt vmcnt(0)" ::: "memory");
    }
  }
  __syncthreads();
}

__device__ __forceinline__ int cap_tiles(int h) { return h == 0 ? 6 : h == 1 ? 7 : h == 2 ? 10 : h == 3 ? 15 : h == 4 ? 26 : h == 5 ? 48 : 64; }
__device__ __forceinline__ int unit_cost(int mode, int pi) {
  const int h = pi >> 4, blk = pi & 15, cap = cap_tiles(h);
  const int full = 4 * (blk + 1);
  if (mode == 0) return min(full, cap);
  return min(full, cap) + min(min(full, 12), cap) + 2;
}
__device__ __forceinline__ void build_order(LAS unsigned char* lds, int mode) {
  LAS short* ord = (LAS short*)(lds + AT_ORD);
  const int i = threadIdx.x;
  if (i < 128) {
    const int ci = unit_cost(mode, i);
    int rank = 0;
    for (int j = 0; j < 128; ++j) { const int cj = unit_cost(mode, j); rank += (cj > ci) || (cj == ci && j < i); }
    ord[rank] = (short)i;
  }
  __syncthreads();
}
__device__ __forceinline__ int queue_next(unsigned* ctr, LAS unsigned char* lds) {
  LAS int* slot = (LAS int*)(lds + AT_QS);
  if (threadIdx.x == 0) *slot = (int)atomicAdd(ctr, 1u);
  __syncthreads();
  const int v = *slot;
  __syncthreads();
  return v;
}
constexpr int XB_ST_OFF = (CS_LDS > STAGE_BYTES ? CS_LDS : STAGE_BYTES) > AT_LDS ? (CS_LDS > STAGE_BYTES ? CS_LDS : STAGE_BYTES) : AT_LDS;
constexpr int MEGA_LDS = XB_ST_OFF + 16;

__global__ __launch_bounds__(512, 2) void mega(P p) {
  extern __shared__ __attribute__((aligned(16))) unsigned char shm[];
  LAS unsigned char* lds = (LAS unsigned char*)shm;
  const int bid = blockIdx.x, nblk = gridDim.x;
  if (threadIdx.x < 4) ((LAS unsigned*)(lds + XB_ST_OFF))[threadIdx.x] = 0u;
  __syncthreads();
  const XcdBarrier xb = xcd_barrier_post(p.xbar(), (volatile LAS unsigned*)(lds + XB_ST_OFF));
  for (int rep = 0; rep < (PROBE == 10 ? 2 : 1); ++rep) phase_prep(p, lds, bid, nblk);
  xcd_barrier(xb);
  if (PROBE == 9) { for (int i = 0; i < 6; ++i) xcd_barrier(xb); }
  {
    StaticOrder S; S.init(T_, NP, nblk, bid, PROBE == 1 ? 2 : PROBE == 21 ? 3 : 1);
    EpiProj E{p.hm(), p.rstd(), p.kmp(), p.kn2()};
    gemm_phase<EpiProj>(lds, p.xh(), p.wt(), T_, NP, DM, S, E);
  }
  xcd_barrier(xb);
  for (int rep = 0; rep < (PROBE == 2 ? 2 : 1); ++rep)
    for (int u = bid; u < 2 * 8 * 2 * 8; u += nblk) cm_unit(p, lds, u >> 7, (u >> 4) & 7, (u >> 3) & 1, u & 7);
  for (int rep = 0; rep < (PROBE == 3 ? 2 : PROBE == 23 ? 3 : 1); ++rep) {
    build_order(lds, 0);
    for (;;) {
      const int u = queue_next(p.qctr() + 0 + 2 * rep, lds);
      if (u >= 8 * 8 * 16) break;
      const int pi = ((const LAS short*)(lds + AT_ORD))[u >> 3];
      moba_unit(p, lds, u & 7, pi >> 4, pi & 15);
    }
  }
  xcd_barrier(xb);
  for (int rep = 0; rep < (PROBE == 4 ? 2 : 1); ++rep)
    for (int su = bid; su < 256; su += nblk) cs_super(p, lds, (su & 15) >> 1, su & 1, su >> 4);
  xcd_barrier(xb);
  for (int rep = 0; rep < (PROBE == 5 ? 2 : PROBE == 25 ? 3 : 1); ++rep) {
    build_order(lds, 1);
    for (;;) {
      const int u = queue_next(p.qctr() + 1 + 2 * rep, lds);
      if (u >= 8 * 8 * 16) break;
      const int pi = ((const LAS short*)(lds + AT_ORD))[u >> 3];
      nsa_unit(p, lds, u & 7, pi >> 4, pi & 15);
    }
  }
  xcd_barrier(xb);
  {
    StaticOrder S; S.init(T_, DM, nblk, bid, PROBE == 6 ? 2 : 1);
    EpiY E{p.hm(), p.ssq()};
    gemm_phase<EpiY>(lds, p.cat(), p.wot(), T_, DM, DM, S, E);
  }
  xcd_barrier(xb);
  for (int rep = 0; rep < (PROBE == 7 ? 2 : 1); ++rep) phase_post(p, bid, nblk);
}

}


extern "C" void kernel_launch(void* const* d_in, const int* in_sizes, int n_in, void* d_out, int out_size, void* d_ws,
                              size_t ws_size, hipStream_t stream) {
  P p{};
  p.x = (const float*)d_in[0]; p.g_pre = (const float*)d_in[1]; p.g_post = (const float*)d_in[2];
  p.w_in = (const float*)d_in[3]; p.pe_k = (const float*)d_in[4]; p.pe_v = (const float*)d_in[5];
  p.wk1 = (const float*)d_in[6]; p.wk2 = (const float*)d_in[7]; p.wv1 = (const float*)d_in[8]; p.wv2 = (const float*)d_in[9];
  p.w_out = (const float*)d_in[10]; p.out = (float*)d_out;
  p.ws = (char*)d_ws;
  if (ws_size < WS_END) { fprintf(stderr, "workspace too small\n"); return; }

  static int grid_blocks = 0;
  if (!grid_blocks) {
    int dev = 0, cus = 0, per_cu = 0;
    (void)hipGetDevice(&dev);
    (void)hipDeviceGetAttribute(&cus, hipDeviceAttributeMultiprocessorCount, dev);
    (void)hipFuncSetAttribute((const void*)mega, hipFuncAttributeMaxDynamicSharedMemorySize, MEGA_LDS);
    (void)hipOccupancyMaxActiveBlocksPerMultiprocessor(&per_cu, (const void*)mega, 512, MEGA_LDS);
    if (per_cu < 1) per_cu = 1;
    if (per_cu > 1) per_cu = 1;
    grid_blocks = cus * per_cu;
  }
  (void)hipMemsetAsync((char*)d_ws + OFF_XBAR, 0, (size_t)3456 * 4, stream);
  hipLaunchKernelGGL(mega, dim3(grid_blocks), dim3(512), MEGA_LDS, stream, p);
  hipError_t e = hipPeekAtLastError();
  if (e != hipSuccess) fprintf(stderr, "launch failed: %s (grid %d)\n", hipGetErrorString(e), grid_blocks);
}
```

```cpp
#include <hip/hip_runtime.h>
#include <hip/hip_fp16.h>
#include <hip/hip_cooperative_groups.h>
#include <cstdio>
#include <stdint.h>

#define PROBE 0
namespace {

#define LAS __attribute__((address_space(3)))
typedef _Float16 h8 __attribute__((ext_vector_type(8)));
typedef _Float16 h4 __attribute__((ext_vector_type(4)));
typedef float f32x4 __attribute__((ext_vector_type(4)));
typedef float f32x16 __attribute__((ext_vector_type(16)));
typedef unsigned u32x4 __attribute__((ext_vector_type(4)));

__device__ __forceinline__ int otid() { int t = threadIdx.x; asm volatile("" : "+v"(t)); return t; }

constexpr int B_ = 8, S_ = 4096, DM = 1024, DIN = 3864, T_ = B_ * S_;
constexpr int NP = 3840;
constexpr float EPS = 1e-6f;
constexpr int SL_QA = 0, SL_KA = 8, SL_VA = 16, SL_ZA = 24, SL_QB = 32, SL_KV6 = 40, SL_ZB = 52;

constexpr size_t al256(size_t x) { return (x + 255) & ~(size_t)255; }
constexpr size_t OFF_XH = 0;
constexpr size_t OFF_WT = OFF_XH + al256((size_t)T_ * 1024 * 2);
constexpr size_t OFF_WOT = OFF_WT + al256((size_t)NP * 1024 * 2);
constexpr size_t OFF_RSTD = OFF_WOT + al256((size_t)1024 * 1024 * 2);
constexpr size_t OFF_GATE = OFF_RSTD + al256((size_t)T_ * 4);
constexpr size_t OFF_KMP = OFF_GATE + al256((size_t)T_ * 24 * 4);
constexpr size_t OFF_KN2 = OFF_KMP + al256((size_t)8 * 8 * 16 * 2 * 64 * 4);
constexpr size_t OFF_QCTR = OFF_KN2 + al256((size_t)8 * 60 * 2 * 4);
constexpr size_t OFF_XBAR = OFF_QCTR + 256;
constexpr size_t OFF_SSQ = OFF_XBAR + al256((size_t)3456 * 4);
constexpr size_t OFF_PCNT = OFF_SSQ + al256((size_t)T_ * 4);
constexpr size_t OFF_SSQ2 = OFF_PCNT + al256(256 * 4);
constexpr size_t OFF_PCNT2 = OFF_SSQ2 + al256((size_t)T_ * 4);
constexpr size_t OFF_SEL = OFF_PCNT2 + al256(256 * 4);
constexpr size_t OFF_KCH = OFF_SEL + al256((size_t)8 * 2 * 4096 * 8);
constexpr size_t OFF_VCH = OFF_KCH + al256((size_t)8 * 2 * 256 * 64 * 2);
constexpr size_t OFF_W1T = OFF_VCH + al256((size_t)8 * 2 * 256 * 64 * 2);
constexpr size_t OFF_W2T = OFF_W1T + al256((size_t)2 * 128 * 2048 * 2);
constexpr size_t OFF_PEH = OFF_W2T + al256((size_t)2 * 64 * 128 * 2);
constexpr size_t OFF_OCMPH = OFF_PEH + al256((size_t)2 * 2048 * 2);
constexpr size_t OFF_HM = OFF_OCMPH + al256((size_t)T_ * 512 * 2);
constexpr size_t OFF_CAT = OFF_HM + al256((size_t)60 * T_ * 64 * 2);
constexpr size_t WS_END = OFF_CAT + al256((size_t)T_ * 1024 * 2);

struct P {
  const float* x; const float* g_pre; const float* g_post; const float* w_in;
  const float* pe_k; const float* pe_v; const float* wk1; const float* wk2; const float* wv1; const float* wv2;
  const float* w_out; float* out;
  char* ws;
  __device__ __forceinline__ __half* xh() const { return (__half*)(ws + OFF_XH); }
  __device__ __forceinline__ __half* cat() const { return (__half*)(ws + OFF_CAT); }
  __device__ __forceinline__ __half* wt() const { return (__half*)(ws + OFF_WT); }
  __device__ __forceinline__ __half* wot() const { return (__half*)(ws + OFF_WOT); }
  __device__ __forceinline__ float* rstd() const { return (float*)(ws + OFF_RSTD); }
  __device__ __forceinline__ float* gate() const { return (float*)(ws + OFF_GATE); }
  __device__ __forceinline__ float* kmp() const { return (float*)(ws + OFF_KMP); }
  __device__ __forceinline__ unsigned* kn2() const { return (unsigned*)(ws + OFF_KN2); }
  __device__ __forceinline__ unsigned* qctr() const { return (unsigned*)(ws + OFF_QCTR); }
  __device__ __forceinline__ unsigned* xbar() const { return (unsigned*)(ws + OFF_XBAR); }
  __device__ __forceinline__ float* ssq() const { return (float*)(ws + OFF_SSQ); }
  __device__ __forceinline__ unsigned* pcnt() const { return (unsigned*)(ws + OFF_PCNT); }
  __device__ __forceinline__ unsigned long long* sel() const { return (unsigned long long*)(ws + OFF_SEL); }
  __device__ __forceinline__ __half* kch() const { return (__half*)(ws + OFF_KCH); }
  __device__ __forceinline__ __half* vch() const { return (__half*)(ws + OFF_VCH); }
  __device__ __forceinline__ __half* w1t() const { return (__half*)(ws + OFF_W1T); }
  __device__ __forceinline__ __half* w2t() const { return (__half*)(ws + OFF_W2T); }
  __device__ __forceinline__ __half* peh() const { return (__half*)(ws + OFF_PEH); }
  __device__ __forceinline__ __half* ocmph() const { return (__half*)(ws + OFF_OCMPH); }
  __device__ __forceinline__ __half* hm() const { return (__half*)(ws + OFF_HM); }
};

__device__ __forceinline__ const __half* hmp(const P& p, int slot, int b, int t) {
  return p.hm() + (((size_t)slot * T_) + (size_t)b * S_ + t) * 64;
}

__device__ __forceinline__ float wave_sum(float v) {
#pragma unroll
  for (int o = 32; o > 0; o >>= 1) v += __shfl_xor(v, o, 64);
  return v;
}
__device__ __forceinline__ float silu(float v) { return v * __builtin_amdgcn_rcpf(1.f + __builtin_amdgcn_exp2f(-1.4426950408889634f * v)); }

constexpr int PREP_WG_OFF = 0;
constexpr int PREP_TILE_OFF = 65536;
constexpr int PREP_LDS = 65536 + 64 * 65 * 4;

__device__ __forceinline__ void tr_tile(const float* src, int ldS, int k0, int n0s, __half* dst, int ldD, int n0d,
                                        const float* scale, LAS float* tile, int tid) {
  {
    const int i = tid >> 4, jj = (tid & 15) * 4;
#pragma unroll
    for (int h = 0; h < 2; ++h) {
      const int k = i + 32 * h;
      float4 v = *reinterpret_cast<const float4*>(src + (size_t)(k0 + k) * ldS + n0s + jj);
      const float sc = scale ? scale[k0 + k] : 1.f;
      tile[k * 65 + jj + 0] = v.x * sc; tile[k * 65 + jj + 1] = v.y * sc; tile[k * 65 + jj + 2] = v.z * sc; tile[k * 65 + jj + 3] = v.w * sc;
    }
  }
  __syncthreads();
  {
    const int n = tid >> 3, kc = (tid & 7) * 8;
    h8 o;
#pragma unroll
    for (int u = 0; u < 8; ++u) o[u] = (_Float16)tile[(kc + u) * 65 + n];
    *reinterpret_cast<h8*>(dst + (size_t)(n0d + n) * ldD + k0 + kc) = o;
  }
  __syncthreads();
}

__device__ __forceinline__ void phase_prep(const P& p, LAS unsigned char* lds, int bid, int nblk) {
  const int tid = otid(), lane = tid & 63, wid = tid >> 6;
  LAS _Float16* wgl = (LAS _Float16*)(lds + PREP_WG_OFF);
  for (int e = tid; e < 1024 * 24; e += 512) {
    const int k = e / 24, n = e - k * 24;
    const float v = p.w_in[(size_t)k * DIN + 3328 + n] * p.g_pre[k];
    const int s = k >> 5, q = (k >> 3) & 3, j = k & 7;
    wgl[((s * 4 + q) * 32 + n) * 8 + j] = (_Float16)v;
  }
  for (int e = tid; e < 1024 * 8; e += 512) {
    const int k = e >> 3, n = 24 + (e & 7);
    const int s = k >> 5, q = (k >> 3) & 3, j = k & 7;
    wgl[((s * 4 + q) * 32 + n) * 8 + j] = (_Float16)0.f;
  }
  __syncthreads();
  for (int u = bid; u < T_ / 128; u += nblk) {
    const int row0 = u * 128 + wid * 16;
    const int r = lane & 15, q = lane >> 4;
    const float* xr = p.x + (size_t)(row0 + r) * DM + q * 8;
    __half* xo = p.xh() + (size_t)(row0 + r) * DM + q * 8;
    f32x4 acc0 = {0.f, 0.f, 0.f, 0.f}, acc1 = {0.f, 0.f, 0.f, 0.f};
    float ss = 0.f;
#pragma unroll 4
    for (int s = 0; s < 32; ++s) {
      const f32x4 v0 = __builtin_nontemporal_load(reinterpret_cast<const f32x4*>(xr + s * 32));
      const f32x4 v1 = __builtin_nontemporal_load(reinterpret_cast<const f32x4*>(xr + s * 32 + 4));
      ss += v0.x * v0.x + v0.y * v0.y + v0.z * v0.z + v0.w * v0.w + v1.x * v1.x + v1.y * v1.y + v1.z * v1.z + v1.w * v1.w;
      h8 a;
      a[0] = (_Float16)v0.x; a[1] = (_Float16)v0.y; a[2] = (_Float16)v0.z; a[3] = (_Float16)v0.w;
      a[4] = (_Float16)v1.x; a[5] = (_Float16)v1.y; a[6] = (_Float16)v1.z; a[7] = (_Float16)v1.w;
      *reinterpret_cast<h8*>(xo + s * 32) = a;
      const h8 b0 = *(const LAS h8*)(lds + PREP_WG_OFF + ((s * 4 + q) * 32 + r) * 16);
      const h8 b1 = *(const LAS h8*)(lds + PREP_WG_OFF + ((s * 4 + q) * 32 + 16 + r) * 16);
      acc0 = __builtin_amdgcn_mfma_f32_16x16x32_f16(a, b0, acc0, 0, 0, 0);
      acc1 = __builtin_amdgcn_mfma_f32_16x16x32_f16(a, b1, acc1, 0, 0, 0);
    }
    ss += __shfl_xor(ss, 16, 64);
    ss += __shfl_xor(ss, 32, 64);
    const float rs = rsqrtf(ss * (1.f / DM) + EPS);
    if (q == 0) p.rstd()[row0 + r] = rs;
#pragma unroll
    for (int reg = 0; reg < 4; ++reg) {
      const int row = q * 4 + reg;
      const float rr = __shfl(rs, row, 64);
      float* gp = p.gate() + (size_t)(row0 + row) * 24;
      gp[r] = 1.f / (1.f + __expf(-acc0[reg] * rr));
      if (r < 8) gp[16 + r] = 1.f / (1.f + __expf(-acc1[reg] * rr));
    }
  }
  __syncthreads();
  LAS float* tile = (LAS float*)(lds + PREP_TILE_OFF);
  constexpr int N_WIN = 16 * 60, N_WOUT = 16 * 16;
  constexpr int N_W1 = 2 * 64, N_W2 = 2 * 2;
  for (int it = bid; it < N_WIN + N_WOUT + N_W1 + N_W2; it += nblk) {
    if (it < N_WIN) {
      const int kb = it / 60, nb = it - kb * 60;
      const int n0d = nb * 64, n0s = n0d < 3328 ? n0d : n0d + 24;
      tr_tile(p.w_in, DIN, kb * 64, n0s, p.wt(), DM, n0d, p.g_pre, tile, tid);
    } else if (it < N_WIN + N_WOUT) {
      const int r = it - N_WIN, kb = r >> 4, nb = r & 15;
      tr_tile(p.w_out, DM, kb * 64, nb * 64, p.wot(), DM, nb * 64, nullptr, tile, tid);
    } else if (it < N_WIN + N_WOUT + N_W1) {
      const int r = it - N_WIN - N_WOUT, which = r >> 6, kb = (r & 63) >> 1, nb = r & 1;
      tr_tile(which ? p.wv1 : p.wk1, 128, kb * 64, nb * 64, p.w1t() + (size_t)which * 128 * 2048, 2048, nb * 64, nullptr, tile, tid);
    } else {
      const int r = it - N_WIN - N_WOUT - N_W1, which = r >> 1, kb = r & 1;
      tr_tile(which ? p.wv2 : p.wk2, 64, kb * 64, 0, p.w2t() + (size_t)which * 64 * 128, 128, 0, nullptr, tile, tid);
    }
  }
  for (int e = bid * 512 + tid; e < 8 * 60 * 2; e += nblk * 512) p.kn2()[e] = 0u;
  if (bid == 0 && tid < 8) p.qctr()[tid] = 0u;
  for (int e = bid * 512 + tid; e < T_; e += nblk * 512) p.ssq()[e] = 0.f;
  if (bid == 1 && tid < 256) p.pcnt()[tid] = 0u;
  if (PROBE == 6) { for (int e = bid * 512 + tid; e < T_; e += nblk * 512) ((float*)(p.ws + OFF_SSQ2))[e] = 0.f; if (bid == 3 && tid < 256) ((unsigned*)(p.ws + OFF_PCNT2))[tid] = 0u; }
  for (int e = bid * 512 + tid; e < 2 * 2048; e += nblk * 512) p.peh()[e] = __float2half(e < 2048 ? p.pe_k[e] : p.pe_v[e - 2048]);
}

constexpr int BM = 256, BK = 64, HALF = 128, HTB = HALF * BK * 2, STAGE_BYTES = 8 * HTB, NXCD = 8, WGM = 8;

__device__ __forceinline__ int lds_byte(int r, int c) { const int st = (r >> 4) * 2 + (c >> 5), rr = r & 15, cc = c & 31, ob = rr * 64 + cc * 2; return st * 1024 + (ob ^ (((ob >> 9) & 1) << 5)); }
__device__ __forceinline__ void stage_rc(int b, int& R, int& C) { const int st = b / 1024, sb = b % 1024, swz = sb ^ (((sb >> 9) & 1) << 5); R = (st >> 1) * 16 + swz / 64; C = (st & 1) * 32 + (swz % 64) / 2; }
__device__ __forceinline__ int perm32(int rho) { const int n = rho >> 4, i = rho & 15; return 8 * (i >> 2) + 4 * n + (i & 3); }

struct Unit { int pm, pn; };
struct StaticOrder {
  int nM, nN, nwg, G, c, rep;
  __device__ void init(int M, int N, int G_, int c_, int rep_ = 1) { nM = M / BM; nN = N / BM; nwg = nM * nN; G = G_; c = c_; rep = rep_; }
  __device__ bool next(int i, Unit& u) const {
    const long L = (long)i * G + c; if (L >= (long)nwg * rep) return false;
    int wgid = (int)(L % nwg); { const int q = nwg / NXCD, r = nwg % NXCD, xcd = wgid % NXCD, off = wgid / NXCD; wgid = (xcd < r ? xcd * (q + 1) : r * (q + 1) + (xcd - r) * q) + off; }
    const int nig = WGM * nN, gid = wgid / nig, fm = gid * WGM, gsz = (nM - fm) < WGM ? (nM - fm) : WGM;
    u.pm = fm + ((wgid % nig) % gsz); u.pn = (wgid % nig) / gsz; return true;
  }
};

struct EpiProj {
  static constexpr bool PERM = true;
  __half* hm; const float* rstd; float* kmp; unsigned* kn2;
  __device__ __forceinline__ void operator()(const f32x4 (&acc)[2][2][4][2], const Unit& u, int wr, int wc, int fr, int fq) const {
    const int row0 = u.pm * BM + wr * 64 + fr;
    const int colb = u.pn * BM + wc * 32 + 8 * fq;
    const bool isK = (u.pn == 2) || (u.pn == 3);
    const bool hasK = isK || (u.pn == 11) || (u.pn == 12);
    float cs[2][8];
    float nmax[2] = {0.f, 0.f};
#pragma unroll
    for (int bj = 0; bj < 2; ++bj)
#pragma unroll
      for (int j = 0; j < 8; ++j) cs[bj][j] = 0.f;
#pragma unroll
    for (int ai = 0; ai < 2; ++ai)
#pragma unroll
      for (int m = 0; m < 4; ++m) {
        const int row = row0 + ai * HALF + m * 16;
        const float rs = rstd[row];
#pragma unroll
        for (int bj = 0; bj < 2; ++bj) {
          const int c = colb + bj * HALF;
          const f32x4 v0 = acc[ai][bj][m][0] * rs, v1 = acc[ai][bj][m][1] * rs;
          h8 o;
          o[0] = (_Float16)v0[0]; o[1] = (_Float16)v0[1]; o[2] = (_Float16)v0[2]; o[3] = (_Float16)v0[3];
          o[4] = (_Float16)v1[0]; o[5] = (_Float16)v1[1]; o[6] = (_Float16)v1[2]; o[7] = (_Float16)v1[3];
          *reinterpret_cast<h8*>(hm + ((size_t)(c >> 6) * T_ + row) * 64 + (c & 63)) = o;
          if (hasK) {
            float ss = (v0[0] * v0[0] + v0[1] * v0[1]) + (v0[2] * v0[2] + v0[3] * v0[3]) + (v1[0] * v1[0] + v1[1] * v1[1]) + (v1[2] * v1[2] + v1[3] * v1[3]);
            ss += __shfl_xor(ss, 16, 64); ss += __shfl_xor(ss, 32, 64);
            nmax[bj] = fmaxf(nmax[bj], ss);
          }
          if (isK) {
#pragma unroll
            for (int j = 0; j < 4; ++j) { cs[bj][j] += v0[j]; cs[bj][4 + j] += v1[j]; }
          }
        }
      }
    if (hasK)
#pragma unroll
    for (int bj = 0; bj < 2; ++bj) {
      float v = nmax[bj];
      v = fmaxf(v, __shfl_xor(v, 1, 64)); v = fmaxf(v, __shfl_xor(v, 2, 64)); v = fmaxf(v, __shfl_xor(v, 4, 64)); v = fmaxf(v, __shfl_xor(v, 8, 64));
      if ((fr | fq) == 0) {
        const int c = u.pn * BM + wc * 32 + bj * HALF;
        atomicMax(kn2 + ((size_t)(u.pm >> 4) * 60 + (c >> 6)) * 2 + (wc & 1), __float_as_uint(v));
      }
    }
    if (isK) {
#pragma unroll
      for (int bj = 0; bj < 2; ++bj)
#pragma unroll
        for (int j = 0; j < 8; ++j) {
          float v = cs[bj][j];
          v += __shfl_xor(v, 1, 64); v += __shfl_xor(v, 2, 64); v += __shfl_xor(v, 4, 64); v += __shfl_xor(v, 8, 64);
          cs[bj][j] = v;
        }
      if (fr == 0) {
        const int b = u.pm >> 4, blk = u.pm & 15;
#pragma unroll
        for (int bj = 0; bj < 2; ++bj) {
          const int c = colb + bj * HALF, h = (c >> 6) - SL_KA, d0 = c & 63;
          float* dst = kmp + ((((size_t)b * 8 + h) * 16 + blk) * 2 + wr) * 64 + d0;
          *reinterpret_cast<f32x4*>(dst) = (f32x4){cs[bj][0], cs[bj][1], cs[bj][2], cs[bj][3]};
          *reinterpret_cast<f32x4*>(dst + 4) = (f32x4){cs[bj][4], cs[bj][5], cs[bj][6], cs[bj][7]};
        }
      }
    }
  }
};
struct EpiY {
  static constexpr bool PERM = true;
  __half* y; float* ssq;
  __device__ __forceinline__ void operator()(const f32x4 (&acc)[2][2][4][2], const Unit& u, int wr, int wc, int fr, int fq) const {
    const int row0 = u.pm * BM + wr * 64 + fr;
    const int colb = u.pn * BM + wc * 32 + 8 * fq;
#pragma unroll
    for (int ai = 0; ai < 2; ++ai)
#pragma unroll
      for (int m = 0; m < 4; ++m) {
        const int row = row0 + ai * HALF + m * 16;
        float s = 0.f;
#pragma unroll
        for (int bj = 0; bj < 2; ++bj) {
          const f32x4 v0 = acc[ai][bj][m][0], v1 = acc[ai][bj][m][1];
          s += (v0[0] * v0[0] + v0[1] * v0[1]) + (v0[2] * v0[2] + v0[3] * v0[3]) + (v1[0] * v1[0] + v1[1] * v1[1]) + (v1[2] * v1[2] + v1[3] * v1[3]);
          h8 o;
          o[0] = (_Float16)(v0[0] * 64.f); o[1] = (_Float16)(v0[1] * 64.f); o[2] = (_Float16)(v0[2] * 64.f); o[3] = (_Float16)(v0[3] * 64.f);
          o[4] = (_Float16)(v1[0] * 64.f); o[5] = (_Float16)(v1[1] * 64.f); o[6] = (_Float16)(v1[2] * 64.f); o[7] = (_Float16)(v1[3] * 64.f);
          *reinterpret_cast<h8*>(y + (size_t)row * DM + colb + bj * HALF) = o;
        }
        s += __shfl_xor(s, 16, 64); s += __shfl_xor(s, 32, 64);
        if (fq == 0) atomicAdd(ssq + row, s);
      }
  }
};

__device__ __forceinline__ void phase_post(const P& p, int bid, int nblk) {
  const int tid = otid(), lane = tid & 63, wid = tid >> 6;
  const __half* y = p.hm();
  f32x4 gv[2][2];
#pragma unroll
  for (int j = 0; j < 2; ++j) {
    gv[j][0] = *reinterpret_cast<const f32x4*>(p.g_post + j * 512 + lane * 8);
    gv[j][1] = *reinterpret_cast<const f32x4*>(p.g_post + j * 512 + lane * 8 + 4);
  }
  const int stride = nblk * 8;
  for (int t = bid * 8 + wid; t < T_; t += 2 * stride) {
    const int t1 = t + stride;
    const bool has1 = t1 < T_;
    const float tot0 = __hip_atomic_load(p.ssq() + t, __ATOMIC_RELAXED, __HIP_MEMORY_SCOPE_AGENT);
    const float tot1 = has1 ? __hip_atomic_load(p.ssq() + t1, __ATOMIC_RELAXED, __HIP_MEMORY_SCOPE_AGENT) : 1.f;
    h8 xv[2][2], yv[2][2];
#pragma unroll
    for (int j = 0; j < 2; ++j) {
      const size_t off0 = (size_t)t * DM + j * 512 + lane * 8, off1 = (size_t)(has1 ? t1 : t) * DM + j * 512 + lane * 8;
      xv[0][j] = __builtin_nontemporal_load(reinterpret_cast<const h8*>(p.xh() + off0));
      yv[0][j] = __builtin_nontemporal_load(reinterpret_cast<const h8*>(y + off0));
      xv[1][j] = __builtin_nontemporal_load(reinterpret_cast<const h8*>(p.xh() + off1));
      yv[1][j] = __builtin_nontemporal_load(reinterpret_cast<const h8*>(y + off1));
    }
    const float r0 = rsqrtf(tot0 * (1.f / DM) + EPS) * (1.f / 64.f), r1 = rsqrtf(tot1 * (1.f / DM) + EPS) * (1.f / 64.f);
#pragma unroll
    for (int i = 0; i < 2; ++i) {
      if (i == 1 && !has1) break;
      const float r = i ? r1 : r0;
      const int tt = i ? t1 : t;
#pragma unroll
      for (int j = 0; j < 2; ++j) {
        const size_t off = (size_t)tt * DM + j * 512 + lane * 8;
        f32x4 o0, o1;
#pragma unroll
        for (int k = 0; k < 4; ++k) { o0[k] = (float)xv[i][j][k] + (float)yv[i][j][k] * r * gv[j][0][k]; o1[k] = (float)xv[i][j][4 + k] + (float)yv[i][j][4 + k] * r * gv[j][1][k]; }
        __builtin_nontemporal_store(o0, reinterpret_cast<f32x4*>(p.out + off));
        __builtin_nontemporal_store(o1, reinterpret_cast<f32x4*>(p.out + off + 4));
      }
    }
  }
}

template <class Epi>
__device__ __forceinline__ void gemm_phase(LAS unsigned char* lds, const __half* gA, const __half* gBt, int M, int N, int K, const StaticOrder& S, const Epi& E) {
  const int tid = otid(), wid = __builtin_amdgcn_readfirstlane(tid >> 6), lane = tid & 63, wr = wid >> 2, wc = wid & 3, fr = lane & 15, fq = lane >> 4;
  const int nt = K / BK;
  unsigned voffA[2], voffB[2];
#pragma unroll
  for (int i = 0; i < 2; ++i) { int R, C; stage_rc(tid * 16 + i * 8192, R, C); const int Rb = Epi::PERM ? ((R & ~31) + perm32(R & 31)) : R;
    voffA[i] = (unsigned)(R * K + C) * 2u; voffB[i] = (unsigned)(Rb * K + C) * 2u; }
  const size_t kstep = (size_t)(BK * 2);
  const size_t hstep = (size_t)HALF * K * 2;
  const size_t tstep = 2 * hstep;
  const unsigned ldsw = (unsigned)wid * 1024u;
  const int aoff = lds_byte(wr * 64 + fr, fq * 8), boff = lds_byte(wc * 32 + fr, fq * 8);
#define PG8_SA(b, h) (((b) * 2 + (h)) * HTB)
#define PG8_SB(b, h) ((4 + (b) * 2 + (h)) * HTB)
#define PG8_STAGE(bufoff, gbase, voff) do { _Pragma("unroll") for (int _i = 0; _i < 2; ++_i) \
    __builtin_amdgcn_global_load_lds((const unsigned*)((const char*)(gbase) + (voff)[_i]), (LAS unsigned*)(lds + (bufoff) + ldsw + _i * 8192), 16, 0, 0); } while (0)
#define PG8_LDA(dst, b, h) do { _Pragma("unroll") for (int m = 0; m < 4; ++m) _Pragma("unroll") for (int k = 0; k < 2; ++k) dst[m][k] = *(const LAS h8*)(lds + PG8_SA(b, h) + aoff + m * 2048 + k * 1024); } while (0)
#define PG8_LDB(dst, b, h) do { _Pragma("unroll") for (int n = 0; n < 2; ++n) _Pragma("unroll") for (int k = 0; k < 2; ++k) dst[n][k] = *(const LAS h8*)(lds + PG8_SB(b, h) + boff + n * 2048 + k * 1024); } while (0)
#define PG8_MMA(ai, bj, At, Bt) do { __builtin_amdgcn_s_setprio(1); _Pragma("unroll") for (int m = 0; m < 4; ++m) _Pragma("unroll") for (int n = 0; n < 2; ++n) _Pragma("unroll") for (int k = 0; k < 2; ++k) \
    acc[ai][bj][m][n] = __builtin_amdgcn_mfma_f32_16x16x32_f16(Bt[n][k], At[m][k], acc[ai][bj][m][n], 0, 0, 0); __builtin_amdgcn_s_setprio(0); } while (0)
#define PG8_WAIT_V(n) asm volatile("s_waitcnt vmcnt(" #n ")" ::: "memory")
#define PG8_WAIT_L(n) asm volatile("s_waitcnt lgkmcnt(" #n ")" ::: "memory")
#define PG8_BAR __builtin_amdgcn_s_barrier()
#define PG8_SCHED __builtin_amdgcn_sched_barrier(0)
  Unit cur, nxt; int ui = 0;
  if (!S.next(0, cur)) return;
  f32x4 acc[2][2][4][2];
#pragma unroll
  for (int a = 0; a < 2; ++a)
#pragma unroll
    for (int b = 0; b < 2; ++b)
#pragma unroll
      for (int m = 0; m < 4; ++m)
#pragma unroll
        for (int n = 0; n < 2; ++n) acc[a][b][m][n] = (f32x4){0.f, 0.f, 0.f, 0.f};
  h8 At[4][2], B0[2][2], B1[2][2];
  const char* cA = (const char*)gA + (size_t)cur.pm * tstep; const char* cB = (const char*)gBt + (size_t)cur.pn * tstep;
  PG8_STAGE(PG8_SB(0, 0), cB, voffB); PG8_STAGE(PG8_SA(0, 0), cA, voffA); PG8_STAGE(PG8_SB(0, 1), cB + hstep, voffB); PG8_STAGE(PG8_SA(0, 1), cA + hstep, voffA);
  if (wr == 1) PG8_BAR;
  PG8_WAIT_V(4); PG8_BAR;
  PG8_STAGE(PG8_SB(1, 0), cB + kstep, voffB); PG8_STAGE(PG8_SA(1, 0), cA + kstep, voffA); PG8_STAGE(PG8_SB(1, 1), cB + hstep + kstep, voffB);
  PG8_WAIT_V(6); PG8_BAR;
  for (;;) {
    const bool has_next = S.next(ui + 1, nxt);
    const char* nA = has_next ? (const char*)gA + (size_t)nxt.pm * tstep : cA; const char* nB = has_next ? (const char*)gBt + (size_t)nxt.pn * tstep : cB;
    for (int t = 0; t < nt; t += 2) {
      const bool last = (t == nt - 2);
      const char* a1 = cA + (size_t)(t + 1) * kstep;
      const char* a2 = last ? nA : cA + (size_t)(t + 2) * kstep; const char* b2 = last ? nB : cB + (size_t)(t + 2) * kstep;
      const char* a3 = a2 + kstep; const char* b3 = b2 + kstep;
      PG8_LDB(B0, 0, 0); PG8_SCHED; PG8_LDA(At, 0, 0); PG8_STAGE(PG8_SA(1, 1), a1 + hstep, voffA);
      PG8_WAIT_L(8); PG8_BAR; PG8_WAIT_L(0); PG8_MMA(0, 0, At, B0); PG8_BAR; PG8_SCHED;
      PG8_LDB(B1, 0, 1); PG8_STAGE(PG8_SB(0, 0), b2, voffB);
      PG8_BAR; PG8_WAIT_L(0); PG8_MMA(0, 1, At, B1); PG8_BAR;
      PG8_LDA(At, 0, 1); PG8_STAGE(PG8_SA(0, 0), a2, voffA);
      PG8_BAR; PG8_WAIT_L(0); PG8_MMA(1, 0, At, B0); PG8_BAR; PG8_SCHED;
      PG8_STAGE(PG8_SB(0, 1), b2 + hstep, voffB);
      PG8_WAIT_V(6); PG8_BAR; PG8_MMA(1, 1, At, B1); PG8_BAR;
      PG8_LDB(B0, 1, 0); PG8_SCHED; PG8_LDA(At, 1, 0); PG8_STAGE(PG8_SA(0, 1), a2 + hstep, voffA);
      PG8_WAIT_L(8); PG8_BAR; PG8_WAIT_L(0); PG8_MMA(0, 0, At, B0); PG8_BAR; PG8_SCHED;
      PG8_LDB(B1, 1, 1); PG8_STAGE(PG8_SB(1, 0), b3, voffB);
      PG8_BAR; PG8_WAIT_L(0); PG8_MMA(0, 1, At, B1); PG8_BAR;
      PG8_LDA(At, 1, 1); PG8_STAGE(PG8_SA(1, 0), a3, voffA);
      PG8_BAR; PG8_WAIT_L(0); PG8_MMA(1, 0, At, B0); PG8_BAR; PG8_SCHED;
      PG8_STAGE(PG8_SB(1, 1), b3 + hstep, voffB);
      PG8_WAIT_V(6); PG8_BAR; PG8_MMA(1, 1, At, B1); PG8_BAR;
    }
    E(acc, cur, wr, wc, fr, fq);
    if (!has_next) break;
#pragma unroll
    for (int a = 0; a < 2; ++a)
#pragma unroll
      for (int b = 0; b < 2; ++b)
#pragma unroll
        for (int m = 0; m < 4; ++m)
#pragma unroll
          for (int n = 0; n < 2; ++n) acc[a][b][m][n] = (f32x4){0.f, 0.f, 0.f, 0.f};
    cur = nxt; cA = nA; cB = nB; ++ui;
  }
  PG8_WAIT_V(0);
  if (wr == 0) PG8_BAR;
  PG8_BAR;
#undef PG8_SA
#undef PG8_SB
#undef PG8_STAGE
#undef PG8_LDA
#undef PG8_LDB
#undef PG8_MMA
#undef PG8_WAIT_V
#undef PG8_WAIT_L
#undef PG8_BAR
#undef PG8_SCHED
}

constexpr int AT_K = 0, AT_V = 24576, AT_WS = 49152, AT_KM = 51200, AT_OST = 55296, AT_FLG = AT_OST + 8 * 8192, AT_ORD = AT_FLG + 64, AT_QS = AT_ORD + 256, AT_Q = AT_QS + 64, AT_LDS = AT_Q + 8 * 4096;
constexpr float PRUNE = (PROBE == 12 || PROBE == 13) ? 1e30f : 40.f;
constexpr float LOG2E = 1.4426950408889634f;
constexpr float C2 = 0.125f * LOG2E;
constexpr float THR = (PROBE == 30) ? 0.f : 8.f;
enum { M_MOBA = 0, M_SLC = 1, M_WIN = 2 };
typedef short v4i16_t __attribute__((ext_vector_type(4)));

__device__ __forceinline__ int crow(int r, int hi) { return (r & 3) + 8 * (r >> 2) + 4 * hi; }
__device__ __forceinline__ void glds16(const void* g, LAS unsigned char* l) {
  __builtin_amdgcn_global_load_lds((const unsigned*)g, (LAS unsigned*)l, 16, 0, 0);
}
__device__ __forceinline__ h4 vtr(const LAS unsigned char* p) {
  return __builtin_bit_cast(h4, __builtin_amdgcn_ds_read_tr16_b64_v4i16((LAS v4i16_t*)p));
}
__device__ __forceinline__ void scale_rows(f32x16 (&o)[2], float f, LAS float* wsf, int r32, int hi) {
  if (hi == 0) wsf[r32] = f;
#pragma unroll
  for (int r = 0; r < 16; ++r) { const float a = wsf[crow(r, hi)]; o[0][r] *= a; o[1][r] *= a; }
}

#define SBAR() __builtin_amdgcn_sched_barrier(0)
#define PINV(x) asm volatile("" : "+v"(x))
#define MFMA32(a, b, c) __builtin_amdgcn_mfma_f32_32x32x16_f16((a), (b), (c), 0, 0, 0)
__device__ __forceinline__ h8 kfrag(const LAS unsigned char* kp, int f) { return *(const LAS h8*)(kp + (f >> 1) * 2048 + (f & 1) * 512); }
__device__ __forceinline__ h8 vfrag(const LAS unsigned char* vp, int f) {
  const LAS unsigned char* a = vp + (f & 1) * 4096 + (f >> 1) * 1024;
  const h4 lo = vtr(a), hv = vtr(a + 512);
  return __builtin_shufflevector(lo, hv, 0, 1, 2, 3, 4, 5, 6, 7);
}

__device__ __forceinline__ void glds16_asm(const void* g, unsigned lds_base) {
  unsigned sv;
  asm volatile("s_mov_b32 %0, m0\n\ts_mov_b32 m0, %2\n\ts_nop 0\n\tglobal_load_lds_dwordx4 %1, off\n\ts_mov_b32 m0, %0" : "=&s"(sv) : "v"(g), "s"(lds_base) : "memory");
}
#define WAIT_BAR(N) asm volatile("s_waitcnt vmcnt(" #N ") lgkmcnt(0)\n\ts_barrier" ::: "memory")

template <int MODE, bool HASPREV>
__device__ __forceinline__ void fstep(h8 (&pw)[4], f32x16 (&o)[2], const f32x16& bfix, const h8 (&qf)[4],
                                      h8 (&kf)[8], float& m, float& l, const LAS unsigned char* kpn,
                                      const LAS unsigned char* vpp, LAS float* wsf, LAS int* flgw, int kt, int q0, int tq, int tq_min, int tq_max,
                                      int hi, int r32, int lane, float slope2, unsigned long long rowmask, float ubc) {
  f32x16 C0, C1;
  h8 vf[8];
#pragma unroll
  for (int i = 0; i < 8; ++i) {
    if (HASPREV) vf[i] = vfrag(vpp, i);
    const int d0 = i >> 1;
    if (i & 1) C1 = MFMA32(kf[i], qf[d0], d0 == 0 ? bfix : C1);
    else       C0 = MFMA32(kf[i], qf[d0], d0 == 0 ? bfix : C0);
    SBAR();
  }
  const int k0 = kt * 64;
  const float bnd = ubc - slope2 * (float)max(tq - k0 - 63, 0);
  bool need = (k0 <= tq) && (bnd >= m - PRUNE);
  if (MODE == M_MOBA) need = need && (((unsigned)rowmask >> (kt >> 2)) & 1u);
  if (MODE == M_SLC) need = need && ((rowmask >> kt) & 1ull);
  if (MODE == M_WIN) need = need && (k0 + 63 >= tq - 511);
  const bool edge = (k0 + 63 > tq_min) || (MODE == M_WIN && k0 < tq_max - 511);
  if (edge) {
    const int rel = tq - k0 - 4 * hi;
#pragma unroll
    for (int r = 0; r < 16; ++r) {
      const int e0 = (r & 3) + 8 * (r >> 2), e1 = e0 + 32;
      bool ok0 = e0 <= rel, ok1 = e1 <= rel;
      if (MODE == M_WIN) { ok0 = ok0 && (e0 >= rel - 511); ok1 = ok1 && (e1 >= rel - 511); }
      C0[r] = ok0 ? C0[r] : -1e30f; C1[r] = ok1 ? C1[r] : -1e30f;
    }
  }
  const float off1 = 32.f * slope2;
  const float base_t = slope2 * (float)(k0 - q0);
  bool resc = false;
  if (__any(need && (bnd > m + THR))) {
    float mx0 = C0[0], mx1 = C1[0];
#pragma unroll
    for (int r = 1; r < 16; ++r) { mx0 = fmaxf(mx0, C0[r]); mx1 = fmaxf(mx1, C1[r]); }
    float mxs = fmaxf(mx0 * C2, __builtin_fmaf(mx1, C2, off1));
    { const auto rr = __builtin_amdgcn_permlane32_swap(__float_as_uint(mxs), __float_as_uint(mxs), false, false);
      mxs = fmaxf(__uint_as_float(rr[0]), __uint_as_float(rr[1])); }
    const float mt2 = need ? (mxs + base_t) : -1e30f;
    resc = __any(mt2 - m > THR);
    if (resc) {
      const float mn = fmaxf(m, mt2);
      const float alpha = __builtin_amdgcn_exp2f(m - mn);
      l *= alpha; m = mn;
      if (hi == 0) wsf[r32] = alpha;
    }
  }
  const float nm0 = need ? (base_t - m) : -INFINITY;
  const float nm1 = nm0 + off1;
  {
    const bool live_next = (ubc - slope2 * (float)max(tq - k0 + 1, 0)) >= m - PRUNE;
    const int a = __any(live_next) ? 1 : 0;
    if (lane == 0) *flgw = a;
  }
  SBAR();
  float sacc = 0.f;
  h8 pn[4];
#pragma unroll
  for (int i = 0; i < 8; ++i) {
    kf[i] = kfrag(kpn, i);
    if (HASPREV) {
      if (i & 1) o[1] = MFMA32(pw[i >> 1], vf[i], o[1]);
      else       o[0] = MFMA32(pw[i >> 1], vf[i], o[0]);
    }
    float e[4];
#pragma unroll
    for (int j = 0; j < 4; ++j)
      e[j] = (i < 4) ? __builtin_amdgcn_exp2f(__builtin_fmaf(C0[4 * i + j], C2, nm0)) : __builtin_amdgcn_exp2f(__builtin_fmaf(C1[4 * (i - 4) + j], C2, nm1));
    sacc += (e[0] + e[1]) + (e[2] + e[3]);
    pn[i >> 1][(i & 1) * 4 + 0] = (_Float16)e[0]; pn[i >> 1][(i & 1) * 4 + 1] = (_Float16)e[1];
    pn[i >> 1][(i & 1) * 4 + 2] = (_Float16)e[2]; pn[i >> 1][(i & 1) * 4 + 3] = (_Float16)e[3];
    PINV(sacc); PINV(pn[i >> 1]);
    SBAR();
  }
  l += sacc;
#pragma unroll
  for (int s = 0; s < 4; ++s) pw[s] = pn[s];
  if (HASPREV && resc) {
#pragma unroll
    for (int r = 0; r < 16; ++r) { const float a = wsf[crow(r, hi)]; o[0][r] *= a; o[1][r] *= a; }
  }
}

__device__ __forceinline__ void fdrain(const h8 (&pw)[4], f32x16 (&o)[2], const LAS unsigned char* vp) {
#pragma unroll
  for (int f = 0; f < 8; ++f) {
    const h8 v = vfrag(vp, f);
    if (f & 1) o[1] = MFMA32(pw[f >> 1], v, o[1]); else o[0] = MFMA32(pw[f >> 1], v, o[0]);
  }
}

template <int MODE>
__device__ __forceinline__ void flash_pipe(LAS unsigned char* lds, const __half* Kg, const __half* Vg, int q0, int kt_lo, int kt_hi,
                                           const f32x16& bfix, float slope2, unsigned long long rowmask, float ubc,
                                           f32x16 (&o)[2], float& l_tot) {
  const int tid = otid(), lane = tid & 63, r32 = lane & 31, hi = lane >> 5;
  const int wid = __builtin_amdgcn_readfirstlane(tid >> 6);
  const int tq = q0 + wid * 32 + r32, tq_min = q0 + wid * 32, tq_max = tq_min + 31;
  LAS float* wsf = (LAS float*)(lds + AT_WS) + wid * 64;
  LAS int* flg = (LAS int*)(lds + AT_FLG);
  const __half* ksrc = Kg + (size_t)lane * 64 + wid * 8;
  const __half* vsrc = Vg + (size_t)(16 * (wid & 3) + (lane >> 2)) * 64 + (wid >> 2) * 32 + (lane & 3) * 8;
  const unsigned kdst = (unsigned)(unsigned long)(lds + AT_K) + wid * 1024;
  const unsigned vdst = (unsigned)(unsigned long)(lds + AT_V) + wid * 1024;
  const LAS unsigned char* kp0 = lds + AT_K + hi * 1024 + r32 * 16;
  const LAS unsigned char* vp0 = lds + AT_V + ((lane >> 4) & 1) * 32 + (lane & 3) * 8 + (4 * hi + ((lane & 15) >> 2)) * 64;
  const LAS unsigned char* qp = lds + AT_Q + wid * 4096 + lane * 16;
  h8 qf[4];
#pragma unroll
  for (int d0 = 0; d0 < 4; ++d0) qf[d0] = *(const LAS h8*)(qp + d0 * 1024);
#pragma unroll
  for (int r = 0; r < 16; ++r) { o[0][r] = 0.f; o[1][r] = 0.f; }
  float m = -1e30f, l = 0.f;
  h8 kf[8], pw[4];
#define KT_(t) max(kt_hi - (t), kt_lo)
#define DMA_K(t, slot) glds16_asm(ksrc + (size_t)KT_(t) * 4096, (unsigned)__builtin_amdgcn_readfirstlane(kdst + (slot)))
#define DMA_V(t, slot) glds16_asm(vsrc + (size_t)KT_(t) * 4096, (unsigned)__builtin_amdgcn_readfirstlane(vdst + (slot)))
  asm volatile("s_waitcnt vmcnt(0)" ::: "memory");
  DMA_K(0, 0); DMA_K(1, 8192); DMA_K(2, 16384); DMA_V(0, 0);
  WAIT_BAR(2);
#pragma unroll
  for (int i = 0; i < 8; ++i) kf[i] = kfrag(kp0, i);
  WAIT_BAR(2);
  int t = 0, kt = kt_hi;
  int s0 = 0, s1 = 8192, s2 = 16384;
#define STEP_CLOSE(done) do { WAIT_BAR(2);     \
    { const LAS int* f_ = flg + (kt & 1) * 8; const int any_live = f_[0] | f_[1] | f_[2] | f_[3] | f_[4] | f_[5] | f_[6] | f_[7]; done = (!any_live) || (kt == kt_lo); } } while (0)
#define STEP_ROT() do { const int t_ = s0; s0 = s1; s1 = s2; s2 = t_; ++t; --kt; } while (0)
  bool done;
  DMA_K(3, s0); DMA_V(1, s1);
  fstep<MODE, false>(pw, o, bfix, qf, kf, m, l, kp0 + s1, vp0, wsf, flg + (kt & 1) * 8 + wid, kt, q0, tq, tq_min, tq_max, hi, r32, lane, slope2, rowmask, ubc);
  STEP_CLOSE(done);
  while (!done) {
    STEP_ROT();
    DMA_K(t + 3, s0); DMA_V(t + 1, s1);
    fstep<MODE, true>(pw, o, bfix, qf, kf, m, l, kp0 + s1, vp0 + s2  , wsf, flg + (kt & 1) * 8 + wid, kt, q0, tq, tq_min, tq_max, hi, r32, lane, slope2, rowmask, ubc);
    STEP_CLOSE(done);
  }
  fdrain(pw, o, vp0 + s0);
  asm volatile("s_waitcnt lgkmcnt(0)\n\ts_barrier" ::: "memory");
#undef KT_
#undef DMA_K
#undef DMA_V
#undef STEP_CLOSE
#undef STEP_ROT
  l_tot = l + __shfl_xor(l, 32, 64);
}

__device__ __forceinline__ float score_bound(const P& p, const h8 (&qf)[4], int b, int slot) {
  float ss = 0.f;
#pragma unroll
  for (int d0 = 0; d0 < 4; ++d0)
#pragma unroll
    for (int j = 0; j < 8; ++j) { const float v = (float)qf[d0][j]; ss += v * v; }
  ss += __shfl_xor(ss, 32, 64);
  const unsigned* kn = p.kn2() + ((size_t)b * 60 + slot) * 2;
  const float kmax = sqrtf(__uint_as_float(kn[0]) + __uint_as_float(kn[1])) * 1.002f;
  return C2 * sqrtf(ss) * kmax * 1.001f;
}

__device__ __forceinline__ void put_q(LAS unsigned char* lds, const h8 (&qf)[4], int wid, int lane) {
  LAS unsigned char* qp = lds + AT_Q + wid * 4096 + lane * 16;
#pragma unroll
  for (int d0 = 0; d0 < 4; ++d0) *(LAS h8*)(qp + d0 * 1024) = qf[d0];
}

__device__ __forceinline__ void moba_unit(const P& p, LAS unsigned char* lds, int b, int h, int own) {
  const int tid = otid(), lane = tid & 63, r32 = lane & 31, hi = lane >> 5;
  const int wid = __builtin_amdgcn_readfirstlane(tid >> 6);
  const int q0 = own * 256;
  const size_t bh = (size_t)b * 8 + h;
  LAS float* km = (LAS float*)(lds + AT_KM);
  for (int e = tid; e < own * 64; e += 512) {
    const int n = e >> 6, d = e & 63;
    const float* kp = p.kmp() + ((bh * 16 + n) * 2) * 64 + d;
    km[e] = (kp[0] + kp[64]) * (1.f / 256.f);
  }
  h8 qf[4];
  const __half* qrow = hmp(p, SL_QA + h, b, q0 + wid * 32 + r32);
#pragma unroll
  for (int d0 = 0; d0 < 4; ++d0) qf[d0] = *reinterpret_cast<const h8*>(qrow + d0 * 16 + hi * 8);
  __syncthreads();
  float g0 = -3e38f, g1 = -3e38f, g2 = -3e38f; int i0 = -1, i1 = -1, i2 = -1;
  for (int n = 0; n < own; ++n) {
    float s = 0.f;
#pragma unroll
    for (int d0 = 0; d0 < 4; ++d0)
#pragma unroll
      for (int j = 0; j < 8; ++j) s += (float)qf[d0][j] * km[n * 64 + d0 * 16 + hi * 8 + j];
    s += __shfl_xor(s, 32, 64);
    if (s > g0) { g2 = g1; i2 = i1; g1 = g0; i1 = i0; g0 = s; i0 = n; }
    else if (s > g1) { g2 = g1; i2 = i1; g1 = s; i1 = n; }
    else if (s > g2) { g2 = s; i2 = n; }
  }
  unsigned long long rowmask = 1ull << own;
  if (i0 >= 0) rowmask |= 1ull << i0;
  if (i1 >= 0) rowmask |= 1ull << i1;
  if (i2 >= 0) rowmask |= 1ull << i2;
  const float slope = exp2f(-(float)(h + 1));
  const float slope2 = slope * LOG2E;
  f32x16 bfix;
  {
    const float sb = slope * 8.f;
    const int qrel = wid * 32 + r32;
#pragma unroll
    for (int r = 0; r < 16; ++r) bfix[r] = sb * (float)((r & 3) + 8 * (r >> 2) + 4 * hi - qrel);
  }
  f32x16 o[2]; float l_tot;
  const float ubc = score_bound(p, qf, b, SL_KA + h);
  put_q(lds, qf, wid, lane);
  flash_pipe<M_MOBA>(lds, hmp(p, SL_KA + h, b, 0), hmp(p, SL_VA + h, b, 0), q0, 0, 4 * own + 3, bfix, slope2, rowmask, ubc, o, l_tot);
  if (PROBE == 11 || PROBE == 13) flash_pipe<M_MOBA>(lds, hmp(p, SL_KA + h, b, 0), hmp(p, SL_VA + h, b, 0), q0, 0, 4 * own + 3, bfix, slope2, rowmask, ubc, o, l_tot);
  LAS float* wsf = (LAS float*)(lds + AT_WS) + wid * 64;
  scale_rows(o, 1.f / fmaxf(l_tot, 1e-30f), wsf, r32, hi);
  LAS _Float16* stg = (LAS _Float16*)(lds + AT_OST + wid * 4096);
#pragma unroll
  for (int r = 0; r < 16; ++r) {
    const int orow = crow(r, hi);
    stg[orow * 64 + r32] = (_Float16)o[0][r];
    stg[orow * 64 + 32 + r32] = (_Float16)o[1][r];
  }
  const int t3 = otid(), lane3 = t3 & 63, wid3 = t3 >> 6;
#pragma unroll
  for (int i = 0; i < 4; ++i) {
    const int row = i * 8 + (lane3 >> 3), ch = lane3 & 7;
    const h8 v = *(const LAS h8*)(stg + row * 64 + ch * 8);
    const int t = q0 + wid3 * 32 + row;
    const h8 z = *reinterpret_cast<const h8*>(hmp(p, SL_ZA + h, b, t) + ch * 8);
    h8 ov;
#pragma unroll
    for (int j = 0; j < 8; ++j) ov[j] = (_Float16)((float)v[j] * silu((float)z[j]));
    *reinterpret_cast<h8*>(p.cat() + ((size_t)b * S_ + t) * DM + h * 64 + ch * 8) = ov;
  }
  __syncthreads();
}

__device__ __forceinline__ void nsa_unit(const P& p, LAS unsigned char* lds, int b, int h, int qblk) {
  const int tid = otid(), lane = tid & 63, r32 = lane & 31, hi = lane >> 5;
  const int wid = __builtin_amdgcn_readfirstlane(tid >> 6);
  const int q0 = qblk * 256, g = h >> 2;
  const int tq = q0 + wid * 32 + r32;
  h8 qf[4];
  const __half* qrow = hmp(p, SL_QB + h, b, tq);
#pragma unroll
  for (int d0 = 0; d0 < 4; ++d0) qf[d0] = *reinterpret_cast<const h8*>(qrow + d0 * 16 + hi * 8);
  const unsigned long long rowmask = p.sel()[((size_t)b * 2 + g) * S_ + tq];
  const float slope = exp2f(-(float)(h + 1));
  const float slope2 = slope * LOG2E;
  f32x16 bfix;
  {
    const float sb = slope * 8.f;
    const int qrel = wid * 32 + r32;
#pragma unroll
    for (int r = 0; r < 16; ++r) bfix[r] = sb * (float)((r & 3) + 8 * (r >> 2) + 4 * hi - qrel);
  }
  LAS float* wsf = (LAS float*)(lds + AT_WS) + wid * 64;
  f32x16 o[2]; float l_tot;
  LAS float* st32 = (LAS float*)(lds + AT_OST + wid * 8192);
  const float ubc_s = score_bound(p, qf, b, SL_KV6 + 4 + g), ubc_w = score_bound(p, qf, b, SL_KV6 + 8 + g);
  put_q(lds, qf, wid, lane);
  flash_pipe<M_SLC>(lds, hmp(p, SL_KV6 + 4 + g, b, 0), hmp(p, SL_KV6 + 6 + g, b, 0), q0, 0, 4 * qblk + 3, bfix, slope2, rowmask, ubc_s, o, l_tot);
  if (PROBE == 11 || PROBE == 13) flash_pipe<M_SLC>(lds, hmp(p, SL_KV6 + 4 + g, b, 0), hmp(p, SL_KV6 + 6 + g, b, 0), q0, 0, 4 * qblk + 3, bfix, slope2, rowmask, ubc_s, o, l_tot);
  {
    const int t2 = otid(), tq2 = q0 + (t2 >> 6) * 32 + (t2 & 31);
    const float g1 = p.gate()[((size_t)b * S_ + tq2) * 24 + h * 3 + 1];
    scale_rows(o, g1 / fmaxf(l_tot, 1e-30f), wsf, r32, hi);
  }
#pragma unroll
  for (int r = 0; r < 16; ++r) { const int orow = crow(r, hi); st32[orow * 64 + r32] = o[0][r]; st32[orow * 64 + 32 + r32] = o[1][r]; }
  const int wlo = qblk >= 2 ? 4 * qblk - 8 : 0;
  flash_pipe<M_WIN>(lds, hmp(p, SL_KV6 + 8 + g, b, 0), hmp(p, SL_KV6 + 10 + g, b, 0), q0, wlo, 4 * qblk + 3, bfix, slope2, 0ull, ubc_w, o, l_tot);
  if (PROBE == 11 || PROBE == 13) flash_pipe<M_WIN>(lds, hmp(p, SL_KV6 + 8 + g, b, 0), hmp(p, SL_KV6 + 10 + g, b, 0), q0, wlo, 4 * qblk + 3, bfix, slope2, 0ull, ubc_w, o, l_tot);
  {
    const int t2 = otid(), tq2 = q0 + (t2 >> 6) * 32 + (t2 & 31);
    const float g2 = p.gate()[((size_t)b * S_ + tq2) * 24 + h * 3 + 2];
    scale_rows(o, g2 / fmaxf(l_tot, 1e-30f), wsf, r32, hi);
  }
  LAS _Float16* stg = (LAS _Float16*)(lds + AT_OST + wid * 8192);
  {
    float tmp0[16], tmp1[16];
#pragma unroll
    for (int r = 0; r < 16; ++r) { const int orow = crow(r, hi); tmp0[r] = st32[orow * 64 + r32] + o[0][r]; tmp1[r] = st32[orow * 64 + 32 + r32] + o[1][r]; }
    __builtin_amdgcn_wave_barrier();
#pragma unroll
    for (int r = 0; r < 16; ++r) { const int orow = crow(r, hi); stg[orow * 64 + r32] = (_Float16)tmp0[r]; stg[orow * 64 + 32 + r32] = (_Float16)tmp1[r]; }
  }
  const int t3 = otid(), lane3 = t3 & 63, wid3 = t3 >> 6;
#pragma unroll
  for (int i = 0; i < 4; ++i) {
    const int row = i * 8 + (lane3 >> 3), ch = lane3 & 7;
    const h8 v = *(const LAS h8*)(stg + row * 64 + ch * 8);
    const int t = q0 + wid3 * 32 + row;
    const h8 z = *reinterpret_cast<const h8*>(hmp(p, SL_ZB + h, b, t) + ch * 8);
    const float g0 = p.gate()[((size_t)b * S_ + t) * 24 + h * 3];
    const h8 oc = *reinterpret_cast<const h8*>(p.ocmph() + (((size_t)b * 8 + h) * S_ + t) * 64 + ch * 8);
    h8 ov;
#pragma unroll
    for (int j = 0; j < 8; ++j) ov[j] = (_Float16)(((float)v[j] + g0 * (float)oc[j]) * silu((float)z[j]));
    *reinterpret_cast<h8*>(p.cat() + ((size_t)b * S_ + t) * DM + 512 + h * 64 + ch * 8) = ov;
  }
  __syncthreads();
}


constexpr int CM_HID = 0;
constexpr int CM_X = 9216;
__device__ __forceinline__ void cm_unit(const P& p, LAS unsigned char* lds, int which, int b, int g, int mt) {
  const int tid = otid(), lane = tid & 63, r = lane & 15, q = lane >> 4;
  const int wid = __builtin_amdgcn_readfirstlane(tid >> 6);
  const int c0 = mt * 32;
  const __half* xs = hmp(p, SL_KV6 + 2 * which + g, b, 0) + (size_t)c0 * 1024;
  for (int pc = wid; pc < 66; pc += 8) glds16(xs + (size_t)pc * 512 + lane * 8, lds + CM_X + pc * 1040);
  const __half* bp = p.w1t() + ((size_t)which * 128 + wid * 16 + r) * 2048 + q * 8;
  const __half* pp = p.peh() + which * 2048 + q * 8;
  asm volatile("s_waitcnt vmcnt(0)" ::: "memory");
  __syncthreads();
  f32x4 acc0 = {0.f, 0.f, 0.f, 0.f}, acc1 = {0.f, 0.f, 0.f, 0.f};
  const LAS unsigned char* a0l = lds + CM_X + (2 * r) * 1040 + q * 16;
  const LAS unsigned char* a1l = lds + CM_X + (2 * (16 + r)) * 1040 + q * 16;
#pragma unroll 8
  for (int s = 0; s < 64; ++s) {
    const int off = (s >> 4) * 1040 + ((s >> 1) & 7) * 128 + (s & 1) * 64;
    const h8 pe = *reinterpret_cast<const h8*>(pp + s * 32);
    const h8 a0 = *(const LAS h8*)(a0l + off) + pe;
    const h8 a1 = *(const LAS h8*)(a1l + off) + pe;
    const h8 bf = *reinterpret_cast<const h8*>(bp + s * 32);
    acc0 = __builtin_amdgcn_mfma_f32_16x16x32_f16(a0, bf, acc0, 0, 0, 0);
    acc1 = __builtin_amdgcn_mfma_f32_16x16x32_f16(a1, bf, acc1, 0, 0, 0);
  }
  LAS _Float16* hid = (LAS _Float16*)(lds + CM_HID);
#pragma unroll
  for (int reg = 0; reg < 4; ++reg) {
    hid[(4 * q + reg) * 136 + wid * 16 + r] = (_Float16)silu(acc0[reg]);
    hid[(16 + 4 * q + reg) * 136 + wid * 16 + r] = (_Float16)silu(acc1[reg]);
  }
  __syncthreads();
  {
    const int mi = wid >> 2, ni = wid & 3;
    const __half* w2p = p.w2t() + ((size_t)which * 64 + ni * 16 + r) * 128 + q * 8;
    f32x4 acc = {0.f, 0.f, 0.f, 0.f};
#pragma unroll
    for (int s = 0; s < 4; ++s) {
      const h8 a = *(const LAS h8*)(hid + (mi * 16 + r) * 136 + s * 32 + q * 8);
      const h8 bf = *reinterpret_cast<const h8*>(w2p + s * 32);
      acc = __builtin_amdgcn_mfma_f32_16x16x32_f16(a, bf, acc, 0, 0, 0);
    }
    __half* dst = (which ? p.vch() : p.kch()) + ((size_t)b * 2 + g) * 256 * 64;
#pragma unroll
    for (int reg = 0; reg < 4; ++reg) {
      const int c = c0 + mi * 16 + 4 * q + reg;
      dst[(size_t)c * 64 + ni * 16 + r] = __float2half(c < 255 ? acc[reg] : 0.f);
    }
  }
  __syncthreads();
}

constexpr int CS_K = 0, CS_V = 32768, CS_SLAB = 65536, CS_SLAB_BYTES = 8 * 32 * 65 * 4, CS_WS = CS_SLAB + CS_SLAB_BYTES, CS_LDS = CS_WS + 2048;
__device__ __forceinline__ void cs_super(const P& p, LAS unsigned char* lds, int b, int g, int j) {
  const int tid = otid(), lane = tid & 63, r32 = lane & 31, hi = lane >> 5;
  const int wid = __builtin_amdgcn_readfirstlane(tid >> 6);
  const int hh = wid & 3, qi = wid >> 2, h = g * 4 + hh;
  const size_t bg = (size_t)b * 2 + g;
  {
    const __half* ksrc = p.kch() + bg * 256 * 64 + (size_t)lane * 64 + wid * 8;
    const __half* vsrc = p.vch() + bg * 256 * 64 + (size_t)(16 * (wid & 3) + (lane >> 2)) * 64 + (wid >> 2) * 32 + (lane & 3) * 8;
    for (int kt = 0; kt < 4; ++kt) {
      glds16(ksrc + (size_t)kt * 4096, lds + CS_K + kt * 8192 + wid * 1024);
      glds16(vsrc + (size_t)kt * 4096, lds + CS_V + kt * 8192 + wid * 1024);
    }
  }
  asm volatile("s_waitcnt vmcnt(0)" ::: "memory");
  __syncthreads();
  for (int oi = 0; oi < 4; ++oi) {
  const int own = oi == 0 ? j : oi == 1 ? 31 - j : oi == 2 ? 32 + j : 63 - j;
  const int q0 = own * 64;
  const int ntile = (4 * own + 66) >> 6;
  const int tq = q0 + qi * 32 + r32;
  const int ncv = tq >= 31 ? ((tq - 31) >> 4) + 1 : 0;
  h8 qf[4];
  const __half* qrow = hmp(p, SL_QB + h, b, tq);
#pragma unroll
  for (int d0 = 0; d0 < 4; ++d0) qf[d0] = *reinterpret_cast<const h8*>(qrow + d0 * 16 + hi * 8);
  const LAS unsigned char* kp0 = lds + CS_K + hi * 1024 + r32 * 16;
  const LAS unsigned char* vp0 = lds + CS_V + ((lane >> 4) & 1) * 32 + (lane & 3) * 8 + (4 * hi + ((lane & 15) >> 2)) * 64;
  const f32x16 zero16 = {0.f, 0.f, 0.f, 0.f, 0.f, 0.f, 0.f, 0.f, 0.f, 0.f, 0.f, 0.f, 0.f, 0.f, 0.f, 0.f};
  float m = -1e30f, l = 0.f;
  for (int kt = 0; kt < ntile; ++kt) {
    const LAS unsigned char* kp = kp0 + kt * 8192;
    f32x16 p0 = zero16, p1 = zero16;
#pragma unroll
    for (int d0 = 0; d0 < 4; ++d0) {
      const h8 k0f = *(const LAS h8*)(kp + d0 * 2048), k1f = *(const LAS h8*)(kp + d0 * 2048 + 512);
      p0 = __builtin_amdgcn_mfma_f32_32x32x16_f16(k0f, qf[d0], p0, 0, 0, 0);
      p1 = __builtin_amdgcn_mfma_f32_32x32x16_f16(k1f, qf[d0], p1, 0, 0, 0);
    }
    const int rel = ncv - 1 - 64 * kt - 4 * hi;
    float mx = -1e30f;
#pragma unroll
    for (int r = 0; r < 16; ++r) {
      const int e0 = (r & 3) + 8 * (r >> 2);
      p0[r] = e0 <= rel ? p0[r] : -1e30f; p1[r] = e0 + 32 <= rel ? p1[r] : -1e30f;
      mx = fmaxf(mx, fmaxf(p0[r], p1[r]));
    }
    mx = fmaxf(mx, __shfl_xor(mx, 32, 64));
    const float mn = fmaxf(m, mx * C2);
    float ls = 0.f;
#pragma unroll
    for (int r = 0; r < 16; ++r) ls += __builtin_amdgcn_exp2f(__builtin_fmaf(p0[r], C2, -mn)) + __builtin_amdgcn_exp2f(__builtin_fmaf(p1[r], C2, -mn));
    l = l * __builtin_amdgcn_exp2f(m - mn) + ls;
    m = mn;
  }
  float l_tot = l + __shfl_xor(l, 32, 64);
  const float inv = ncv > 0 ? 1.f / fmaxf(l_tot, 1e-30f) : 0.f;
  const float nm = ncv > 0 ? -m : -INFINITY;
  f32x16 o[2]; o[0] = zero16; o[1] = zero16;
  LAS float* slab = (LAS float*)(lds + CS_SLAB) + ((qi * 4 + hh) * 32 + r32) * 65;
  float carry = 0.f;
  for (int kt = 0; kt < ntile; ++kt) {
    const LAS unsigned char* kp = kp0 + kt * 8192;
    const LAS unsigned char* vp = vp0 + kt * 8192;
    f32x16 p0 = zero16, p1 = zero16;
#pragma unroll
    for (int d0 = 0; d0 < 4; ++d0) {
      const h8 k0f = *(const LAS h8*)(kp + d0 * 2048), k1f = *(const LAS h8*)(kp + d0 * 2048 + 512);
      p0 = __builtin_amdgcn_mfma_f32_32x32x16_f16(k0f, qf[d0], p0, 0, 0, 0);
      p1 = __builtin_amdgcn_mfma_f32_32x32x16_f16(k1f, qf[d0], p1, 0, 0, 0);
    }
    const int rel = ncv - 1 - 64 * kt - 4 * hi;
#pragma unroll
    for (int r = 0; r < 16; ++r) {
      const int e0 = (r & 3) + 8 * (r >> 2);
      const float a0 = e0 <= rel ? p0[r] : -1e30f, a1 = e0 + 32 <= rel ? p1[r] : -1e30f;
      p0[r] = __builtin_amdgcn_exp2f(__builtin_fmaf(a0, C2, nm)) * inv;
      p1[r] = __builtin_amdgcn_exp2f(__builtin_fmaf(a1, C2, nm)) * inv;
    }
#pragma unroll
    for (int n = 0; n < 2; ++n) {
#pragma unroll
      for (int rg = 0; rg < 4; ++rg) {
        const float t3 = n == 0 ? p0[4 * rg + 3] : p1[4 * rg + 3];
        const float gs = n == 0 ? (p0[4 * rg] + p0[4 * rg + 1]) + (p0[4 * rg + 2] + t3) : (p1[4 * rg] + p1[4 * rg + 1]) + (p1[4 * rg + 2] + t3);
        const float tp = __shfl_xor(t3, 32, 64);
        slab[2 * (8 * kt + 4 * n + rg) + hi] = gs + (hi ? tp : carry);
        carry = tp;
      }
    }
    h8 pa[4];
#pragma unroll
    for (int j = 0; j < 8; ++j) { pa[0][j] = (_Float16)p0[j]; pa[1][j] = (_Float16)p0[8 + j]; pa[2][j] = (_Float16)p1[j]; pa[3][j] = (_Float16)p1[8 + j]; }
#pragma unroll
    for (int s = 0; s < 4; ++s) {
#pragma unroll
      for (int dh = 0; dh < 2; ++dh) {
        const h4 lo = vtr(vp + dh * 4096 + s * 1024), hv = vtr(vp + dh * 4096 + s * 1024 + 512);
        const h8 vf = __builtin_shufflevector(lo, hv, 0, 1, 2, 3, 4, 5, 6, 7);
        o[dh] = __builtin_amdgcn_mfma_f32_32x32x16_f16(pa[s], vf, o[dh], 0, 0, 0);
      }
    }
  }
  __syncthreads();
  if (own < 16) {
    if (tid < 64) p.sel()[bg * S_ + q0 + tid] = (2ull << own) - 1ull;
  } else {
    const LAS float* sl = (const LAS float*)(lds + CS_SLAB);
    const int jj = lane;
    const bool cand = (jj >= 1) && (jj <= own - 2);
    const unsigned long long forced = 1ull | (1ull << own) | (1ull << (own - 1));
    for (int i = 0; i < 8; ++i) {
      const int qq = wid * 8 + i, q2 = qq >> 5, rr = qq & 31;
      float v = 0.f;
#pragma unroll
      for (int x = 0; x < 4; ++x) v += sl[((q2 * 4 + x) * 32 + rr) * 65 + jj];
      const unsigned key = cand ? (__float_as_uint(v) + 1u) : 0u;
      unsigned th = 0u;
#pragma unroll
      for (int bit = 30; bit >= 0; --bit) {
        const unsigned c = th | (1u << bit);
        const int cnt = __popcll(__ballot(key >= c));
        th = cnt >= 13 ? c : th;
      }
      const unsigned long long gt = __ballot(key > th), eq = __ballot(key == th);
      const int need = 13 - __popcll(gt);
      unsigned long long t = eq;
      for (int k = 0; k < need; ++k) t &= t - 1ull;
      const unsigned long long msk = gt | (eq ^ t) | forced;
      if (lane == 0) p.sel()[bg * S_ + q0 + qq] = msk;
    }
  }
  __syncthreads();
  {
    LAS _Float16* stg = (LAS _Float16*)(lds + CS_SLAB + wid * 4096);
#pragma unroll
    for (int r = 0; r < 16; ++r) {
      const int orow = crow(r, hi);
      stg[orow * 64 + r32] = (_Float16)o[0][r];
      stg[orow * 64 + 32 + r32] = (_Float16)o[1][r];
    }
#pragma unroll
    for (int i = 0; i < 4; ++i) {
      const int row = i * 8 + (lane >> 3), ch = lane & 7;
      const h8 v = *(const LAS h8*)(stg + row * 64 + ch * 8);
      const int t = q0 + qi * 32 + row;
      *reinterpret_cast<h8*>(p.ocmph() + (((size_t)b * 8 + h) * S_ + t) * 64 + ch * 8) = v;
    }
  }
  __syncthreads();
  }
}

#define XB_TMO      128
#define XB_XCNT(j)  (256  + 64 * (j))
#define XB_XSUB(j)  (1280 + 64 * (j))
#define XB_XGEN(j)  (2304 + 64 * (j))
#define XB_TOP      3328
#define XB_TOPGEN   3392
#define XCD_BAR_WORDS 3456
#define XB_SPIN_CAP (1u << 18)
__device__ __forceinline__ unsigned xb_ld(unsigned* p) { return __hip_atomic_load(p, __ATOMIC_RELAXED, __HIP_MEMORY_SCOPE_AGENT); }
__device__ __forceinline__ unsigned xb_add(unsigned* p, unsigned v) { return __hip_atomic_fetch_add(p, v, __ATOMIC_RELAXED, __HIP_MEMORY_SCOPE_AGENT); }
__device__ __forceinline__ unsigned xb_xcc_id() { return (unsigned)__builtin_amdgcn_s_getreg((3 << 11) | 20) & 0xFu; }
#define XB_SPIN(cond, bar) do { unsigned _sp = 0; while (cond) { __builtin_amdgcn_s_sleep(1); \
    if ((++_sp & 255u) == 0u) { if (xb_ld(&(bar)[XB_TMO])) break; if (_sp > XB_SPIN_CAP) { atomicAdd(&(bar)[XB_TMO], 1u); break; } } } } while (0)
struct XcdBarrier { unsigned* bar; unsigned x; volatile LAS unsigned* st; };
__device__ __forceinline__ XcdBarrier xcd_barrier_post(unsigned* bar, volatile LAS unsigned* st) {
  XcdBarrier b; b.bar = bar; b.x = xb_xcc_id(); b.st = st;
  if (threadIdx.x == 0) (void)xb_add(&bar[XB_XCNT(b.x)], 1u);
  return b;
}
__device__ __forceinline__ void xcd_barrier_complete(unsigned* bar, unsigned x, unsigned& nloc, unsigned& nx) {
  const unsigned G = gridDim.x * gridDim.y * gridDim.z;
  unsigned sum, cnt, mine, sp = 0u;
  for (;;) {
    sum = 0u; cnt = 0u; mine = 0u;
#pragma unroll
    for (unsigned j = 0; j < 16; ++j) { const unsigned c = xb_ld(&bar[XB_XCNT(j)]); sum += c; cnt += (c > 0u) ? 1u : 0u; mine = (j == x) ? c : mine; }
    if (sum == G) break;
    __builtin_amdgcn_s_sleep(1);
    if ((++sp & 255u) == 0u) { if (xb_ld(&bar[XB_TMO])) break; if (sp > XB_SPIN_CAP) { atomicAdd(&bar[XB_TMO], 1u); break; } }
  }
  nloc = mine > 0u ? mine : 1u; nx = cnt > 0u ? cnt : 1u;
}
__device__ __forceinline__ void xcd_barrier(const XcdBarrier& b) {
  asm volatile("s_waitcnt vmcnt(0)" ::: "memory");
  __syncthreads();
  if (threadIdx.x == 0) {
    unsigned* bar = b.bar;
    __builtin_amdgcn_s_waitcnt(0);
    unsigned nloc = b.st[0], nx = b.st[1];
    if (nloc == 0u) { xcd_barrier_complete(bar, b.x, nloc, nx); b.st[0] = nloc; b.st[1] = nx; }
    const unsigned old = xb_add(&bar[XB_XSUB(b.x)], 1u);
    const unsigned gen = old / nloc;
    if (old + 1u == (gen + 1u) * nloc) {
      __builtin_amdgcn_fence(__ATOMIC_RELEASE, "agent");
      asm volatile("s_waitcnt vmcnt(0)" ::: "memory");
      const unsigned og = xb_add(&bar[XB_TOP], 1u);
      const unsigned tg = og / nx;
      if (og + 1u == (tg + 1u) * nx) xb_add(&bar[XB_TOPGEN], 1u);
      else XB_SPIN(xb_ld(&bar[XB_TOPGEN]) == tg, bar);
      __builtin_amdgcn_fence(__ATOMIC_ACQUIRE, "agent");
      xb_add(&bar[XB_XGEN(b.x)], 1u);
      asm volatile("s_waitcnt vmcnt(0)" ::: "memory");
    } else {
      XB_SPIN(xb_ld(&bar[XB_XGEN(b.x)]) == gen, bar);
      __builtin_amdgcn_fence(__ATOMIC_ACQUIRE, "agent");
      asm volatile("s_waitcnt vmcnt(0)" ::: "memory");
    }
  }
  __syncthreads();
}

__device__ __forceinline__ int cap_tiles(int h) { return h == 0 ? 6 : h == 1 ? 7 : h == 2 ? 10 : h == 3 ? 15 : h == 4 ? 26 : h == 5 ? 48 : 64; }
__device__ __forceinline__ int unit_cost(int mode, int pi) {
  const int h = pi >> 4, blk = pi & 15, cap = cap_tiles(h);
  const int full = 4 * (blk + 1);
  if (mode == 0) return min(full, cap);
  return min(full, cap) + min(min(full, 12), cap) + 2;
}
__device__ __forceinline__ void build_order(LAS unsigned char* lds, int mode) {
  LAS short* ord = (LAS short*)(lds + AT_ORD);
  const int i = threadIdx.x;
  if (i < 128) {
    const int ci = unit_cost(mode, i);
    int rank = 0;
    for (int j = 0; j < 128; ++j) { const int cj = unit_cost(mode, j); rank += (cj > ci) || (cj == ci && j < i); }
    ord[rank] = (short)i;
  }
  __syncthreads();
}
__device__ __forceinline__ int queue_next(unsigned* ctr, LAS unsigned char* lds) {
  LAS int* slot = (LAS int*)(lds + AT_QS);
  if (threadIdx.x == 0) *slot = (int)atomicAdd(ctr, 1u);
  __syncthreads();
  const int v = *slot;
  __syncthreads();
  return v;
}
constexpr int XB_ST_OFF = (CS_LDS > STAGE_BYTES ? CS_LDS : STAGE_BYTES) > AT_LDS ? (CS_LDS > STAGE_BYTES ? CS_LDS : STAGE_BYTES) : AT_LDS;
constexpr int MEGA_LDS = XB_ST_OFF + 16;

__global__ __launch_bounds__(512, 2) void mega(P p) {
  extern __shared__ __attribute__((aligned(16))) unsigned char shm[];
  LAS unsigned char* lds = (LAS unsigned char*)shm;
  const int bid = blockIdx.x, nblk = gridDim.x;
  if (threadIdx.x < 4) ((LAS unsigned*)(lds + XB_ST_OFF))[threadIdx.x] = 0u;
  __syncthreads();
  const XcdBarrier xb = xcd_barrier_post(p.xbar(), (volatile LAS unsigned*)(lds + XB_ST_OFF));
  for (int rep = 0; rep < (PROBE == 10 ? 2 : 1); ++rep) phase_prep(p, lds, bid, nblk);
  xcd_barrier(xb);
  if (PROBE == 9) { for (int i = 0; i < 6; ++i) xcd_barrier(xb); }
  {
    StaticOrder S; S.init(T_, NP, nblk, bid, PROBE == 1 ? 2 : PROBE == 21 ? 3 : 1);
    EpiProj E{p.hm(), p.rstd(), p.kmp(), p.kn2()};
    gemm_phase<EpiProj>(lds, p.xh(), p.wt(), T_, NP, DM, S, E);
  }
  xcd_barrier(xb);
  for (int rep = 0; rep < (PROBE == 2 ? 2 : 1); ++rep)
    for (int u = bid; u < 2 * 8 * 2 * 8; u += nblk) cm_unit(p, lds, u >> 7, (u >> 4) & 7, (u >> 3) & 1, u & 7);
  for (int rep = 0; rep < (PROBE == 3 ? 2 : PROBE == 23 ? 3 : 1); ++rep) {
    build_order(lds, 0);
    for (;;) {
      const int u = queue_next(p.qctr() + 0 + 2 * rep, lds);
      if (u >= 8 * 8 * 16) break;
      const int pi = ((const LAS short*)(lds + AT_ORD))[u >> 3];
      moba_unit(p, lds, u & 7, pi >> 4, pi & 15);
    }
  }
  xcd_barrier(xb);
  for (int rep = 0; rep < (PROBE == 4 ? 2 : 1); ++rep)
    for (int su = bid; su < 256; su += nblk) cs_super(p, lds, (su & 15) >> 1, su & 1, su >> 4);
  xcd_barrier(xb);
  for (int rep = 0; rep < (PROBE == 5 ? 2 : PROBE == 25 ? 3 : 1); ++rep) {
    build_order(lds, 1);
    for (;;) {
      const int u = queue_next(p.qctr() + 1 + 2 * rep, lds);
      if (u >= 8 * 8 * 16) break;
      const int pi = ((const LAS short*)(lds + AT_ORD))[u >> 3];
      nsa_unit(p, lds, u & 7, pi >> 4, pi & 15);
    }
  }
  xcd_barrier(xb);
  {
    StaticOrder S; S.init(T_, DM, nblk, bid, PROBE == 6 ? 2 : 1);
    EpiY E{p.hm(), p.ssq()};
    gemm_phase<EpiY>(lds, p.cat(), p.wot(), T_, DM, DM, S, E);
  }
  xcd_barrier(xb);
  for (int rep = 0; rep < (PROBE == 7 ? 2 : 1); ++rep) phase_post(p, bid, nblk);
}

}


extern "C" void kernel_launch(void* const* d_in, const int* in_sizes, int n_in, void* d_out, int out_size, void* d_ws,
                              size_t ws_size, hipStream_t stream) {
  P p{};
  p.x = (const float*)d_in[0]; p.g_pre = (const float*)d_in[1]; p.g_post = (const float*)d_in[2];
  p.w_in = (const float*)d_in[3]; p.pe_k = (const float*)d_in[4]; p.pe_v = (const float*)d_in[5];
  p.wk1 = (const float*)d_in[6]; p.wk2 = (const float*)d_in[7]; p.wv1 = (const float*)d_in[8]; p.wv2 = (const float*)d_in[9];
  p.w_out = (const float*)d_in[10]; p.out = (float*)d_out;
  p.ws = (char*)d_ws;
  if (ws_size < WS_END) { fprintf(stderr, "workspace too small\n"); return; }

  static int grid_blocks = 0;
  if (!grid_blocks) {
    int dev = 0, cus = 0, per_cu = 0;
    (void)hipGetDevice(&dev);
    (void)hipDeviceGetAttribute(&cus, hipDeviceAttributeMultiprocessorCount, dev);
    (void)hipFuncSetAttribute((const void*)mega, hipFuncAttributeMaxDynamicSharedMemorySize, MEGA_LDS);
    (void)hipOccupancyMaxActiveBlocksPerMultiprocessor(&per_cu, (const void*)mega, 512, MEGA_LDS);
    if (per_cu < 1) per_cu = 1;
    if (per_cu > 1) per_cu = 1;
    grid_blocks = cus * per_cu;
  }
  (void)hipMemsetAsync((char*)d_ws + OFF_XBAR, 0, (size_t)3456 * 4, stream);
  hipLaunchKernelGGL(mega, dim3(grid_blocks), dim3(512), MEGA_LDS, stream, p);
  hipError_t e = hipPeekAtLastError();
  if (e != hipSuccess) fprintf(stderr, "launch failed: %s (grid %d)\n", hipGetErrorString(e), grid_blocks);
}
```

```cpp
#include <hip/hip_runtime.h>
#include <hip/hip_fp16.h>
#include <hip/hip_cooperative_groups.h>
#include <cstdio>
#include <stdint.h>

#define PROBE 0
namespace {

#define LAS __attribute__((address_space(3)))
typedef _Float16 h8 __attribute__((ext_vector_type(8)));
typedef _Float16 h4 __attribute__((ext_vector_type(4)));
typedef float f32x4 __attribute__((ext_vector_type(4)));
typedef float f32x16 __attribute__((ext_vector_type(16)));
typedef unsigned u32x4 __attribute__((ext_vector_type(4)));

__device__ __forceinline__ int otid() { int t = threadIdx.x; asm volatile("" : "+v"(t)); return t; }

constexpr int B_ = 8, S_ = 4096, DM = 1024, DIN = 3864, T_ = B_ * S_;
constexpr int NP = 3840;
constexpr float EPS = 1e-6f;
constexpr int SL_QA = 0, SL_KA = 8, SL_VA = 16, SL_ZA = 24, SL_QB = 32, SL_KV6 = 40, SL_ZB = 52;

constexpr size_t al256(size_t x) { return (x + 255) & ~(size_t)255; }
constexpr size_t OFF_XH = 0;
constexpr size_t OFF_WT = OFF_XH + al256((size_t)T_ * 1024 * 2);
constexpr size_t OFF_WOT = OFF_WT + al256((size_t)NP * 1024 * 2);
constexpr size_t OFF_RSTD = OFF_WOT + al256((size_t)1024 * 1024 * 2);
constexpr size_t OFF_GATE = OFF_RSTD + al256((size_t)T_ * 4);
constexpr size_t OFF_KMP = OFF_GATE + al256((size_t)T_ * 24 * 4);
constexpr size_t OFF_KN2 = OFF_KMP + al256((size_t)8 * 8 * 16 * 2 * 64 * 4);
constexpr size_t OFF_QCTR = OFF_KN2 + al256((size_t)8 * 60 * 2 * 4);
constexpr size_t OFF_XBAR = OFF_QCTR + 256;
constexpr size_t OFF_SSQ = OFF_XBAR + al256((size_t)3456 * 4);
constexpr size_t OFF_PCNT = OFF_SSQ + al256((size_t)T_ * 4);
constexpr size_t OFF_SSQ2 = OFF_PCNT + al256(256 * 4);
constexpr size_t OFF_PCNT2 = OFF_SSQ2 + al256((size_t)T_ * 4);
constexpr size_t OFF_SEL = OFF_PCNT2 + al256(256 * 4);
constexpr size_t OFF_KCH = OFF_SEL + al256((size_t)8 * 2 * 4096 * 8);
constexpr size_t OFF_VCH = OFF_KCH + al256((size_t)8 * 2 * 256 * 64 * 2);
constexpr size_t OFF_W1T = OFF_VCH + al256((size_t)8 * 2 * 256 * 64 * 2);
constexpr size_t OFF_W2T = OFF_W1T + al256((size_t)2 * 128 * 2048 * 2);
constexpr size_t OFF_PEH = OFF_W2T + al256((size_t)2 * 64 * 128 * 2);
constexpr size_t OFF_OCMPH = OFF_PEH + al256((size_t)2 * 2048 * 2);
constexpr size_t OFF_HM = OFF_OCMPH + al256((size_t)T_ * 512 * 2);
constexpr size_t OFF_CAT = OFF_HM + al256((size_t)60 * T_ * 64 * 2);
constexpr size_t WS_END = OFF_CAT + al256((size_t)T_ * 1024 * 2);

struct P {
  const float* x; const float* g_pre; const float* g_post; const float* w_in;
  const float* pe_k; const float* pe_v; const float* wk1; const float* wk2; const float* wv1; const float* wv2;
  const float* w_out; float* out;
  char* ws;
  __device__ __forceinline__ __half* xh() const { return (__half*)(ws + OFF_XH); }
  __device__ __forceinline__ __half* cat() const { return (__half*)(ws + OFF_CAT); }
  __device__ __forceinline__ __half* wt() const { return (__half*)(ws + OFF_WT); }
  __device__ __forceinline__ __half* wot() const { return (__half*)(ws + OFF_WOT); }
  __device__ __forceinline__ float* rstd() const { return (float*)(ws + OFF_RSTD); }
  __device__ __forceinline__ float* gate() const { return (float*)(ws + OFF_GATE); }
  __device__ __forceinline__ float* kmp() const { return (float*)(ws + OFF_KMP); }
  __device__ __forceinline__ unsigned* kn2() const { return (unsigned*)(ws + OFF_KN2); }
  __device__ __forceinline__ unsigned* qctr() const { return (unsigned*)(ws + OFF_QCTR); }
  __device__ __forceinline__ unsigned* xbar() const { return (unsigned*)(ws + OFF_XBAR); }
  __device__ __forceinline__ float* ssq() const { return (float*)(ws + OFF_SSQ); }
  __device__ __forceinline__ unsigned* pcnt() const { return (unsigned*)(ws + OFF_PCNT); }
  __device__ __forceinline__ unsigned long long* sel() const { return (unsigned long long*)(ws + OFF_SEL); }
  __device__ __forceinline__ __half* kch() const { return (__half*)(ws + OFF_KCH); }
  __device__ __forceinline__ __half* vch() const { return (__half*)(ws + OFF_VCH); }
  __device__ __forceinline__ __half* w1t() const { return (__half*)(ws + OFF_W1T); }
  __device__ __forceinline__ __half* w2t() const { return (__half*)(ws + OFF_W2T); }
  __device__ __forceinline__ __half* peh() const { return (__half*)(ws + OFF_PEH); }
  __device__ __forceinline__ __half* ocmph() const { return (__half*)(ws + OFF_OCMPH); }
  __device__ __forceinline__ __half* hm() const { return (__half*)(ws + OFF_HM); }
};

__device__ __forceinline__ const __half* hmp(const P& p, int slot, int b, int t) {
  return p.hm() + (((size_t)slot * T_) + (size_t)b * S_ + t) * 64;
}

__device__ __forceinline__ float wave_sum(float v) {
#pragma unroll
  for (int o = 32; o > 0; o >>= 1) v += __shfl_xor(v, o, 64);
  return v;
}
__device__ __forceinline__ float silu(float v) { return v * __builtin_amdgcn_rcpf(1.f + __builtin_amdgcn_exp2f(-1.4426950408889634f * v)); }

constexpr int PREP_WG_OFF = 0;
constexpr int PREP_TILE_OFF = 65536;
constexpr int PREP_LDS = 65536 + 64 * 65 * 4;

__device__ __forceinline__ void tr_tile(const float* src, int ldS, int k0, int n0s, __half* dst, int ldD, int n0d,
                                        const float* scale, LAS float* tile, int tid) {
  {
    const int i = tid >> 4, jj = (tid & 15) * 4;
#pragma unroll
    for (int h = 0; h < 2; ++h) {
      const int k = i + 32 * h;
      float4 v = *reinterpret_cast<const float4*>(src + (size_t)(k0 + k) * ldS + n0s + jj);
      const float sc = scale ? scale[k0 + k] : 1.f;
      tile[k * 65 + jj + 0] = v.x * sc; tile[k * 65 + jj + 1] = v.y * sc; tile[k * 65 + jj + 2] = v.z * sc; tile[k * 65 + jj + 3] = v.w * sc;
    }
  }
  __syncthreads();
  {
    const int n = tid >> 3, kc = (tid & 7) * 8;
    h8 o;
#pragma unroll
    for (int u = 0; u < 8; ++u) o[u] = (_Float16)tile[(kc + u) * 65 + n];
    *reinterpret_cast<h8*>(dst + (size_t)(n0d + n) * ldD + k0 + kc) = o;
  }
  __syncthreads();
}

__device__ __forceinline__ void phase_prep(const P& p, LAS unsigned char* lds, int bid, int nblk) {
  const int tid = otid(), lane = tid & 63, wid = tid >> 6;
  LAS _Float16* wgl = (LAS _Float16*)(lds + PREP_WG_OFF);
  for (int e = tid; e < 1024 * 24; e += 512) {
    const int k = e / 24, n = e - k * 24;
    const float v = p.w_in[(size_t)k * DIN + 3328 + n] * p.g_pre[k];
    const int s = k >> 5, q = (k >> 3) & 3, j = k & 7;
    wgl[((s * 4 + q) * 32 + n) * 8 + j] = (_Float16)v;
  }
  for (int e = tid; e < 1024 * 8; e += 512) {
    const int k = e >> 3, n = 24 + (e & 7);
    const int s = k >> 5, q = (k >> 3) & 3, j = k & 7;
    wgl[((s * 4 + q) * 32 + n) * 8 + j] = (_Float16)0.f;
  }
  __syncthreads();
  for (int u = bid; u < T_ / 128; u += nblk) {
    const int row0 = u * 128 + wid * 16;
    const int r = lane & 15, q = lane >> 4;
    const float* xr = p.x + (size_t)(row0 + r) * DM + q * 8;
    __half* xo = p.xh() + (size_t)(row0 + r) * DM + q * 8;
    f32x4 acc0 = {0.f, 0.f, 0.f, 0.f}, acc1 = {0.f, 0.f, 0.f, 0.f};
    float ss = 0.f;
#pragma unroll 4
    for (int s = 0; s < 32; ++s) {
      const f32x4 v0 = __builtin_nontemporal_load(reinterpret_cast<const f32x4*>(xr + s * 32));
      const f32x4 v1 = __builtin_nontemporal_load(reinterpret_cast<const f32x4*>(xr + s * 32 + 4));
      ss += v0.x * v0.x + v0.y * v0.y + v0.z * v0.z + v0.w * v0.w + v1.x * v1.x + v1.y * v1.y + v1.z * v1.z + v1.w * v1.w;
      h8 a;
      a[0] = (_Float16)v0.x; a[1] = (_Float16)v0.y; a[2] = (_Float16)v0.z; a[3] = (_Float16)v0.w;
      a[4] = (_Float16)v1.x; a[5] = (_Float16)v1.y; a[6] = (_Float16)v1.z; a[7] = (_Float16)v1.w;
      *reinterpret_cast<h8*>(xo + s * 32) = a;
      const h8 b0 = *(const LAS h8*)(lds + PREP_WG_OFF + ((s * 4 + q) * 32 + r) * 16);
      const h8 b1 = *(const LAS h8*)(lds + PREP_WG_OFF + ((s * 4 + q) * 32 + 16 + r) * 16);
      acc0 = __builtin_amdgcn_mfma_f32_16x16x32_f16(a, b0, acc0, 0, 0, 0);
      acc1 = __builtin_amdgcn_mfma_f32_16x16x32_f16(a, b1, acc1, 0, 0, 0);
    }
    ss += __shfl_xor(ss, 16, 64);
    ss += __shfl_xor(ss, 32, 64);
    const float rs = rsqrtf(ss * (1.f / DM) + EPS);
    if (q == 0) p.rstd()[row0 + r] = rs;
#pragma unroll
    for (int reg = 0; reg < 4; ++reg) {
      const int row = q * 4 + reg;
      const float rr = __shfl(rs, row, 64);
      float* gp = p.gate() + (size_t)(row0 + row) * 24;
      gp[r] = 1.f / (1.f + __expf(-acc0[reg] * rr));
      if (r < 8) gp[16 + r] = 1.f / (1.f + __expf(-acc1[reg] * rr));
    }
  }
  __syncthreads();
  LAS float* tile = (LAS float*)(lds + PREP_TILE_OFF);
  constexpr int N_WIN = 16 * 60, N_WOUT = 16 * 16;
  constexpr int N_W1 = 2 * 64, N_W2 = 2 * 2;
  for (int it = bid; it < N_WIN + N_WOUT + N_W1 + N_W2; it += nblk) {
    if (it < N_WIN) {
      const int kb = it / 60, nb = it - kb * 60;
      const int n0d = nb * 64, n0s = n0d < 3328 ? n0d : n0d + 24;
      tr_tile(p.w_in, DIN, kb * 64, n0s, p.wt(), DM, n0d, p.g_pre, tile, tid);
    } else if (it < N_WIN + N_WOUT) {
      const int r = it - N_WIN, kb = r >> 4, nb = r & 15;
      tr_tile(p.w_out, DM, kb * 64, nb * 64, p.wot(), DM, nb * 64, nullptr, tile, tid);
    } else if (it < N_WIN + N_WOUT + N_W1) {
      const int r = it - N_WIN - N_WOUT, which = r >> 6, kb = (r & 63) >> 1, nb = r & 1;
      tr_tile(which ? p.wv1 : p.wk1, 128, kb * 64, nb * 64, p.w1t() + (size_t)which * 128 * 2048, 2048, nb * 64, nullptr, tile, tid);
    } else {
      const int r = it - N_WIN - N_WOUT - N_W1, which = r >> 1, kb = r & 1;
      tr_tile(which ? p.wv2 : p.wk2, 64, kb * 64, 0, p.w2t() + (size_t)which * 64 * 128, 128, 0, nullptr, tile, tid);
    }
  }
  for (int e = bid * 512 + tid; e < 8 * 60 * 2; e += nblk * 512) p.kn2()[e] = 0u;
  if (bid == 0 && tid < 8) p.qctr()[tid] = 0u;
  for (int e = bid * 512 + tid; e < T_; e += nblk * 512) p.ssq()[e] = 0.f;
  if (bid == 1 && tid < 256) p.pcnt()[tid] = 0u;
  if (PROBE == 6) { for (int e = bid * 512 + tid; e < T_; e += nblk * 512) ((float*)(p.ws + OFF_SSQ2))[e] = 0.f; if (bid == 3 && tid < 256) ((unsigned*)(p.ws + OFF_PCNT2))[tid] = 0u; }
  for (int e = bid * 512 + tid; e < 2 * 2048; e += nblk * 512) p.peh()[e] = __float2half(e < 2048 ? p.pe_k[e] : p.pe_v[e - 2048]);
}

constexpr int BM = 256, BK = 64, HALF = 128, HTB = HALF * BK * 2, STAGE_BYTES = 8 * HTB, NXCD = 8, WGM = 8;

__device__ __forceinline__ int lds_byte(int r, int c) { const int st = (r >> 4) * 2 + (c >> 5), rr = r & 15, cc = c & 31, ob = rr * 64 + cc * 2; return st * 1024 + (ob ^ (((ob >> 9) & 1) << 5)); }
__device__ __forceinline__ void stage_rc(int b, int& R, int& C) { const int st = b / 1024, sb = b % 1024, swz = sb ^ (((sb >> 9) & 1) << 5); R = (st >> 1) * 16 + swz / 64; C = (st & 1) * 32 + (swz % 64) / 2; }
__device__ __forceinline__ int perm32(int rho) { const int n = rho >> 4, i = rho & 15; return 8 * (i >> 2) + 4 * n + (i & 3); }

struct Unit { int pm, pn; };
struct StaticOrder {
  int nM, nN, nwg, G, c, rep;
  __device__ void init(int M, int N, int G_, int c_, int rep_ = 1) { nM = M / BM; nN = N / BM; nwg = nM * nN; G = G_; c = c_; rep = rep_; }
  __device__ bool next(int i, Unit& u) const {
    const long L = (long)i * G + c; if (L >= (long)nwg * rep) return false;
    int wgid = (int)(L % nwg); { const int q = nwg / NXCD, r = nwg % NXCD, xcd = wgid % NXCD, off = wgid / NXCD; wgid = (xcd < r ? xcd * (q + 1) : r * (q + 1) + (xcd - r) * q) + off; }
    const int nig = WGM * nN, gid = wgid / nig, fm = gid * WGM, gsz = (nM - fm) < WGM ? (nM - fm) : WGM;
    u.pm = fm + ((wgid % nig) % gsz); u.pn = (wgid % nig) / gsz; return true;
  }
};

struct EpiProj {
  static constexpr bool PERM = true;
  __half* hm; const float* rstd; float* kmp; unsigned* kn2; int pn_off;
  __device__ __forceinline__ void operator()(const f32x4 (&acc)[2][2][4][2], const Unit& u0, int wr, int wc, int fr, int fq) const {
    Unit u; u.pm = u0.pm; u.pn = u0.pn + pn_off;
    const int row0 = u.pm * BM + wr * 64 + fr;
    const int colb = u.pn * BM + wc * 32 + 8 * fq;
    const bool isK = (u.pn == 2) || (u.pn == 3);
    const bool hasK = isK || (u.pn == 11) || (u.pn == 12);
    float cs[2][8];
    float nmax[2] = {0.f, 0.f};
#pragma unroll
    for (int bj = 0; bj < 2; ++bj)
#pragma unroll
      for (int j = 0; j < 8; ++j) cs[bj][j] = 0.f;
#pragma unroll
    for (int ai = 0; ai < 2; ++ai)
#pragma unroll
      for (int m = 0; m < 4; ++m) {
        const int row = row0 + ai * HALF + m * 16;
        const float rs = rstd[row];
#pragma unroll
        for (int bj = 0; bj < 2; ++bj) {
          const int c = colb + bj * HALF;
          const f32x4 v0 = acc[ai][bj][m][0] * rs, v1 = acc[ai][bj][m][1] * rs;
          h8 o;
          o[0] = (_Float16)v0[0]; o[1] = (_Float16)v0[1]; o[2] = (_Float16)v0[2]; o[3] = (_Float16)v0[3];
          o[4] = (_Float16)v1[0]; o[5] = (_Float16)v1[1]; o[6] = (_Float16)v1[2]; o[7] = (_Float16)v1[3];
          *reinterpret_cast<h8*>(hm + ((size_t)(c >> 6) * T_ + row) * 64 + (c & 63)) = o;
          if (hasK) {
            float ss = (v0[0] * v0[0] + v0[1] * v0[1]) + (v0[2] * v0[2] + v0[3] * v0[3]) + (v1[0] * v1[0] + v1[1] * v1[1]) + (v1[2] * v1[2] + v1[3] * v1[3]);
            ss += __shfl_xor(ss, 16, 64); ss += __shfl_xor(ss, 32, 64);
            nmax[bj] = fmaxf(nmax[bj], ss);
          }
          if (isK) {
#pragma unroll
            for (int j = 0; j < 4; ++j) { cs[bj][j] += v0[j]; cs[bj][4 + j] += v1[j]; }
          }
        }
      }
    if (hasK)
#pragma unroll
    for (int bj = 0; bj < 2; ++bj) {
      float v = nmax[bj];
      v = fmaxf(v, __shfl_xor(v, 1, 64)); v = fmaxf(v, __shfl_xor(v, 2, 64)); v = fmaxf(v, __shfl_xor(v, 4, 64)); v = fmaxf(v, __shfl_xor(v, 8, 64));
      if ((fr | fq) == 0) {
        const int c = u.pn * BM + wc * 32 + bj * HALF;
        atomicMax(kn2 + ((size_t)(u.pm >> 4) * 60 + (c >> 6)) * 2 + (wc & 1), __float_as_uint(v));
      }
    }
    if (isK) {
#pragma unroll
      for (int bj = 0; bj < 2; ++bj)
#pragma unroll
        for (int j = 0; j < 8; ++j) {
          float v = cs[bj][j];
          v += __shfl_xor(v, 1, 64); v += __shfl_xor(v, 2, 64); v += __shfl_xor(v, 4, 64); v += __shfl_xor(v, 8, 64);
          cs[bj][j] = v;
        }
      if (fr == 0) {
        const int b = u.pm >> 4, blk = u.pm & 15;
#pragma unroll
        for (int bj = 0; bj < 2; ++bj) {
          const int c = colb + bj * HALF, h = (c >> 6) - SL_KA, d0 = c & 63;
          float* dst = kmp + ((((size_t)b * 8 + h) * 16 + blk) * 2 + wr) * 64 + d0;
          *reinterpret_cast<f32x4*>(dst) = (f32x4){cs[bj][0], cs[bj][1], cs[bj][2], cs[bj][3]};
          *reinterpret_cast<f32x4*>(dst + 4) = (f32x4){cs[bj][4], cs[bj][5], cs[bj][6], cs[bj][7]};
        }
      }
    }
  }
};
struct EpiY {
  static constexpr bool PERM = true;
  __half* y; float* ssq;
  __device__ __forceinline__ void operator()(const f32x4 (&acc)[2][2][4][2], const Unit& u, int wr, int wc, int fr, int fq) const {
    const int row0 = u.pm * BM + wr * 64 + fr;
    const int colb = u.pn * BM + wc * 32 + 8 * fq;
#pragma unroll
    for (int ai = 0; ai < 2; ++ai)
#pragma unroll
      for (int m = 0; m < 4; ++m) {
        const int row = row0 + ai * HALF + m * 16;
        float s = 0.f;
#pragma unroll
        for (int bj = 0; bj < 2; ++bj) {
          const f32x4 v0 = acc[ai][bj][m][0], v1 = acc[ai][bj][m][1];
          s += (v0[0] * v0[0] + v0[1] * v0[1]) + (v0[2] * v0[2] + v0[3] * v0[3]) + (v1[0] * v1[0] + v1[1] * v1[1]) + (v1[2] * v1[2] + v1[3] * v1[3]);
          h8 o;
          o[0] = (_Float16)(v0[0] * 64.f); o[1] = (_Float16)(v0[1] * 64.f); o[2] = (_Float16)(v0[2] * 64.f); o[3] = (_Float16)(v0[3] * 64.f);
          o[4] = (_Float16)(v1[0] * 64.f); o[5] = (_Float16)(v1[1] * 64.f); o[6] = (_Float16)(v1[2] * 64.f); o[7] = (_Float16)(v1[3] * 64.f);
          *reinterpret_cast<h8*>(y + (size_t)row * DM + colb + bj * HALF) = o;
        }
        s += __shfl_xor(s, 16, 64); s += __shfl_xor(s, 32, 64);
        if (fq == 0) atomicAdd(ssq + row, s);
      }
  }
};

__device__ __forceinline__ void phase_post(const P& p, int bid, int nblk) {
  const int tid = otid(), lane = tid & 63, wid = tid >> 6;
  const __half* y = p.hm();
  f32x4 gv[2][2];
#pragma unroll
  for (int j = 0; j < 2; ++j) {
    gv[j][0] = *reinterpret_cast<const f32x4*>(p.g_post + j * 512 + lane * 8);
    gv[j][1] = *reinterpret_cast<const f32x4*>(p.g_post + j * 512 + lane * 8 + 4);
  }
  const int stride = nblk * 8;
  for (int t = bid * 8 + wid; t < T_; t += 2 * stride) {
    const int t1 = t + stride;
    const bool has1 = t1 < T_;
    const float tot0 = __hip_atomic_load(p.ssq() + t, __ATOMIC_RELAXED, __HIP_MEMORY_SCOPE_AGENT);
    const float tot1 = has1 ? __hip_atomic_load(p.ssq() + t1, __ATOMIC_RELAXED, __HIP_MEMORY_SCOPE_AGENT) : 1.f;
    h8 xv[2][2], yv[2][2];
#pragma unroll
    for (int j = 0; j < 2; ++j) {
      const size_t off0 = (size_t)t * DM + j * 512 + lane * 8, off1 = (size_t)(has1 ? t1 : t) * DM + j * 512 + lane * 8;
      xv[0][j] = __builtin_nontemporal_load(reinterpret_cast<const h8*>(p.xh() + off0));
      yv[0][j] = __builtin_nontemporal_load(reinterpret_cast<const h8*>(y + off0));
      xv[1][j] = __builtin_nontemporal_load(reinterpret_cast<const h8*>(p.xh() + off1));
      yv[1][j] = __builtin_nontemporal_load(reinterpret_cast<const h8*>(y + off1));
    }
    const float r0 = rsqrtf(tot0 * (1.f / DM) + EPS) * (1.f / 64.f), r1 = rsqrtf(tot1 * (1.f / DM) + EPS) * (1.f / 64.f);
#pragma unroll
    for (int i = 0; i < 2; ++i) {
      if (i == 1 && !has1) break;
      const float r = i ? r1 : r0;
      const int tt = i ? t1 : t;
#pragma unroll
      for (int j = 0; j < 2; ++j) {
        const size_t off = (size_t)tt * DM + j * 512 + lane * 8;
        f32x4 o0, o1;
#pragma unroll
        for (int k = 0; k < 4; ++k) { o0[k] = (float)xv[i][j][k] + (float)yv[i][j][k] * r * gv[j][0][k]; o1[k] = (float)xv[i][j][4 + k] + (float)yv[i][j][4 + k] * r * gv[j][1][k]; }
        __builtin_nontemporal_store(o0, reinterpret_cast<f32x4*>(p.out + off));
        __builtin_nontemporal_store(o1, reinterpret_cast<f32x4*>(p.out + off + 4));
      }
    }
  }
}

template <class Epi>
__device__ __forceinline__ void gemm_phase(LAS unsigned char* lds, const __half* gA, const __half* gBt, int M, int N, int K, const StaticOrder& S, const Epi& E) {
  const int tid = otid(), wid = __builtin_amdgcn_readfirstlane(tid >> 6), lane = tid & 63, wr = wid >> 2, wc = wid & 3, fr = lane & 15, fq = lane >> 4;
  const int nt = K / BK;
  unsigned voffA[2], voffB[2];
#pragma unroll
  for (int i = 0; i < 2; ++i) { int R, C; stage_rc(tid * 16 + i * 8192, R, C); const int Rb = Epi::PERM ? ((R & ~31) + perm32(R & 31)) : R;
    voffA[i] = (unsigned)(R * K + C) * 2u; voffB[i] = (unsigned)(Rb * K + C) * 2u; }
  const size_t kstep = (size_t)(BK * 2);
  const size_t hstep = (size_t)HALF * K * 2;
  const size_t tstep = 2 * hstep;
  const unsigned ldsw = (unsigned)wid * 1024u;
  const int aoff = lds_byte(wr * 64 + fr, fq * 8), boff = lds_byte(wc * 32 + fr, fq * 8);
#define PG8_SA(b, h) (((b) * 2 + (h)) * HTB)
#define PG8_SB(b, h) ((4 + (b) * 2 + (h)) * HTB)
#define PG8_STAGE(bufoff, gbase, voff) do { _Pragma("unroll") for (int _i = 0; _i < 2; ++_i) \
    __builtin_amdgcn_global_load_lds((const unsigned*)((const char*)(gbase) + (voff)[_i]), (LAS unsigned*)(lds + (bufoff) + ldsw + _i * 8192), 16, 0, 0); } while (0)
#define PG8_LDA(dst, b, h) do { _Pragma("unroll") for (int m = 0; m < 4; ++m) _Pragma("unroll") for (int k = 0; k < 2; ++k) dst[m][k] = *(const LAS h8*)(lds + PG8_SA(b, h) + aoff + m * 2048 + k * 1024); } while (0)
#define PG8_LDB(dst, b, h) do { _Pragma("unroll") for (int n = 0; n < 2; ++n) _Pragma("unroll") for (int k = 0; k < 2; ++k) dst[n][k] = *(const LAS h8*)(lds + PG8_SB(b, h) + boff + n * 2048 + k * 1024); } while (0)
#define PG8_MMA(ai, bj, At, Bt) do { __builtin_amdgcn_s_setprio(1); _Pragma("unroll") for (int m = 0; m < 4; ++m) _Pragma("unroll") for (int n = 0; n < 2; ++n) _Pragma("unroll") for (int k = 0; k < 2; ++k) \
    acc[ai][bj][m][n] = __builtin_amdgcn_mfma_f32_16x16x32_f16(Bt[n][k], At[m][k], acc[ai][bj][m][n], 0, 0, 0); __builtin_amdgcn_s_setprio(0); } while (0)
#define PG8_WAIT_V(n) asm volatile("s_waitcnt vmcnt(" #n ")" ::: "memory")
#define PG8_WAIT_L(n) asm volatile("s_waitcnt lgkmcnt(" #n ")" ::: "memory")
#define PG8_BAR __builtin_amdgcn_s_barrier()
#define PG8_SCHED __builtin_amdgcn_sched_barrier(0)
  Unit cur, nxt; int ui = 0;
  if (!S.next(0, cur)) return;
  f32x4 acc[2][2][4][2];
#pragma unroll
  for (int a = 0; a < 2; ++a)
#pragma unroll
    for (int b = 0; b < 2; ++b)
#pragma unroll
      for (int m = 0; m < 4; ++m)
#pragma unroll
        for (int n = 0; n < 2; ++n) acc[a][b][m][n] = (f32x4){0.f, 0.f, 0.f, 0.f};
  h8 At[4][2], B0[2][2], B1[2][2];
  const char* cA = (const char*)gA + (size_t)cur.pm * tstep; const char* cB = (const char*)gBt + (size_t)cur.pn * tstep;
  PG8_STAGE(PG8_SB(0, 0), cB, voffB); PG8_STAGE(PG8_SA(0, 0), cA, voffA); PG8_STAGE(PG8_SB(0, 1), cB + hstep, voffB); PG8_STAGE(PG8_SA(0, 1), cA + hstep, voffA);
  if (wr == 1) PG8_BAR;
  PG8_WAIT_V(4); PG8_BAR;
  PG8_STAGE(PG8_SB(1, 0), cB + kstep, voffB); PG8_STAGE(PG8_SA(1, 0), cA + kstep, voffA); PG8_STAGE(PG8_SB(1, 1), cB + hstep + kstep, voffB);
  PG8_WAIT_V(6); PG8_BAR;
  for (;;) {
    const bool has_next = S.next(ui + 1, nxt);
    const char* nA = has_next ? (const char*)gA + (size_t)nxt.pm * tstep : cA; const char* nB = has_next ? (const char*)gBt + (size_t)nxt.pn * tstep : cB;
    for (int t = 0; t < nt; t += 2) {
      const bool last = (t == nt - 2);
      const char* a1 = cA + (size_t)(t + 1) * kstep;
      const char* a2 = last ? nA : cA + (size_t)(t + 2) * kstep; const char* b2 = last ? nB : cB + (size_t)(t + 2) * kstep;
      const char* a3 = a2 + kstep; const char* b3 = b2 + kstep;
      PG8_LDB(B0, 0, 0); PG8_SCHED; PG8_LDA(At, 0, 0); PG8_STAGE(PG8_SA(1, 1), a1 + hstep, voffA);
      PG8_WAIT_L(8); PG8_BAR; PG8_WAIT_L(0); PG8_MMA(0, 0, At, B0); PG8_BAR; PG8_SCHED;
      PG8_LDB(B1, 0, 1); PG8_STAGE(PG8_SB(0, 0), b2, voffB);
      PG8_BAR; PG8_WAIT_L(0); PG8_MMA(0, 1, At, B1); PG8_BAR;
      PG8_LDA(At, 0, 1); PG8_STAGE(PG8_SA(0, 0), a2, voffA);
      PG8_BAR; PG8_WAIT_L(0); PG8_MMA(1, 0, At, B0); PG8_BAR; PG8_SCHED;
      PG8_STAGE(PG8_SB(0, 1), b2 + hstep, voffB);
      PG8_WAIT_V(6); PG8_BAR; PG8_MMA(1, 1, At, B1); PG8_BAR;
      PG8_LDB(B0, 1, 0); PG8_SCHED; PG8_LDA(At, 1, 0); PG8_STAGE(PG8_SA(0, 1), a2 + hstep, voffA);
      PG8_WAIT_L(8); PG8_BAR; PG8_WAIT_L(0); PG8_MMA(0, 0, At, B0); PG8_BAR; PG8_SCHED;
      PG8_LDB(B1, 1, 1); PG8_STAGE(PG8_SB(1, 0), b3, voffB);
      PG8_BAR; PG8_WAIT_L(0); PG8_MMA(0, 1, At, B1); PG8_BAR;
      PG8_LDA(At, 1, 1); PG8_STAGE(PG8_SA(1, 0), a3, voffA);
      PG8_BAR; PG8_WAIT_L(0); PG8_MMA(1, 0, At, B0); PG8_BAR; PG8_SCHED;
      PG8_STAGE(PG8_SB(1, 1), b3 + hstep, voffB);
      PG8_WAIT_V(6); PG8_BAR; PG8_MMA(1, 1, At, B1); PG8_BAR;
    }
    E(acc, cur, wr, wc, fr, fq);
    if (!has_next) break;
#pragma unroll
    for (int a = 0; a < 2; ++a)
#pragma unroll
      for (int b = 0; b < 2; ++b)
#pragma unroll
        for (int m = 0; m < 4; ++m)
#pragma unroll
          for (int n = 0; n < 2; ++n) acc[a][b][m][n] = (f32x4){0.f, 0.f, 0.f, 0.f};
    cur = nxt; cA = nA; cB = nB; ++ui;
  }
  PG8_WAIT_V(0);
  if (wr == 0) PG8_BAR;
  PG8_BAR;
#undef PG8_SA
#undef PG8_SB
#undef PG8_STAGE
#undef PG8_LDA
#undef PG8_LDB
#undef PG8_MMA
#undef PG8_WAIT_V
#undef PG8_WAIT_L
#undef PG8_BAR
#undef PG8_SCHED
}

constexpr int AT_K = 0, AT_V = 24576, AT_WS = 49152, AT_KM = 51200, AT_OST = 55296, AT_FLG = AT_OST + 8 * 8192, AT_ORD = AT_FLG + 64, AT_QS = AT_ORD + 256, AT_Q = AT_QS + 64, AT_LDS = AT_Q + 8 * 4096;
constexpr float PRUNE = (PROBE == 12 || PROBE == 13) ? 1e30f : 40.f;
constexpr float LOG2E = 1.4426950408889634f;
constexpr float C2 = 0.125f * LOG2E;
constexpr float THR = (PROBE == 30) ? 0.f : 8.f;
enum { M_MOBA = 0, M_SLC = 1, M_WIN = 2 };
typedef short v4i16_t __attribute__((ext_vector_type(4)));

__device__ __forceinline__ int crow(int r, int hi) { return (r & 3) + 8 * (r >> 2) + 4 * hi; }
__device__ __forceinline__ void glds16(const void* g, LAS unsigned char* l) {
  __builtin_amdgcn_global_load_lds((const unsigned*)g, (LAS unsigned*)l, 16, 0, 0);
}
__device__ __forceinline__ h4 vtr(const LAS unsigned char* p) {
  return __builtin_bit_cast(h4, __builtin_amdgcn_ds_read_tr16_b64_v4i16((LAS v4i16_t*)p));
}
__device__ __forceinline__ void scale_rows(f32x16 (&o)[2], float f, LAS float* wsf, int r32, int hi) {
  if (hi == 0) wsf[r32] = f;
#pragma unroll
  for (int r = 0; r < 16; ++r) { const float a = wsf[crow(r, hi)]; o[0][r] *= a; o[1][r] *= a; }
}

#define SBAR() __builtin_amdgcn_sched_barrier(0)
#define PINV(x) asm volatile("" : "+v"(x))
#define MFMA32(a, b, c) __builtin_amdgcn_mfma_f32_32x32x16_f16((a), (b), (c), 0, 0, 0)
__device__ __forceinline__ h8 kfrag(const LAS unsigned char* kp, int f) { return *(const LAS h8*)(kp + (f >> 1) * 2048 + (f & 1) * 512); }
__device__ __forceinline__ h8 vfrag(const LAS unsigned char* vp, int f) {
  const LAS unsigned char* a = vp + (f & 1) * 4096 + (f >> 1) * 1024;
  const h4 lo = vtr(a), hv = vtr(a + 512);
  return __builtin_shufflevector(lo, hv, 0, 1, 2, 3, 4, 5, 6, 7);
}

__device__ __forceinline__ void glds16_asm(const void* g, unsigned lds_base) {
  unsigned sv;
  asm volatile("s_mov_b32 %0, m0\n\ts_mov_b32 m0, %2\n\ts_nop 0\n\tglobal_load_lds_dwordx4 %1, off\n\ts_mov_b32 m0, %0" : "=&s"(sv) : "v"(g), "s"(lds_base) : "memory");
}
#define WAIT_BAR(N) asm volatile("s_waitcnt vmcnt(" #N ") lgkmcnt(0)\n\ts_barrier" ::: "memory")

template <int MODE, bool HASPREV>
__device__ __forceinline__ void fstep(h8 (&pw)[4], f32x16 (&o)[2], const f32x16& bfix, const h8 (&qf)[4],
                                      h8 (&kf)[8], float& m, float& l, const LAS unsigned char* kpn,
                                      const LAS unsigned char* vpp, LAS float* wsf, LAS int* flgw, int kt, int q0, int tq, int tq_min, int tq_max,
                                      int hi, int r32, int lane, float slope2, unsigned long long rowmask, float ubc) {
  f32x16 C0, C1;
  h8 vf[8];
#pragma unroll
  for (int i = 0; i < 8; ++i) {
    if (HASPREV) vf[i] = vfrag(vpp, i);
    const int d0 = i >> 1;
    if (i & 1) C1 = MFMA32(kf[i], qf[d0], d0 == 0 ? bfix : C1);
    else       C0 = MFMA32(kf[i], qf[d0], d0 == 0 ? bfix : C0);
    SBAR();
  }
  const int k0 = kt * 64;
  const float bnd = ubc - slope2 * (float)max(tq - k0 - 63, 0);
  bool need = (k0 <= tq) && (bnd >= m - PRUNE);
  if (MODE == M_MOBA) need = need && (((unsigned)rowmask >> (kt >> 2)) & 1u);
  if (MODE == M_SLC) need = need && ((rowmask >> kt) & 1ull);
  if (MODE == M_WIN) need = need && (k0 + 63 >= tq - 511);
  const bool edge = (k0 + 63 > tq_min) || (MODE == M_WIN && k0 < tq_max - 511);
  if (edge) {
    const int rel = tq - k0 - 4 * hi;
#pragma unroll
    for (int r = 0; r < 16; ++r) {
      const int e0 = (r & 3) + 8 * (r >> 2), e1 = e0 + 32;
      bool ok0 = e0 <= rel, ok1 = e1 <= rel;
      if (MODE == M_WIN) { ok0 = ok0 && (e0 >= rel - 511); ok1 = ok1 && (e1 >= rel - 511); }
      C0[r] = ok0 ? C0[r] : -1e30f; C1[r] = ok1 ? C1[r] : -1e30f;
    }
  }
  const float off1 = 32.f * slope2;
  const float base_t = slope2 * (float)(k0 - q0);
  bool resc = false;
  if (__any(need && (bnd > m + THR))) {
    float mx0 = C0[0], mx1 = C1[0];
#pragma unroll
    for (int r = 1; r < 16; ++r) { mx0 = fmaxf(mx0, C0[r]); mx1 = fmaxf(mx1, C1[r]); }
    float mxs = fmaxf(mx0 * C2, __builtin_fmaf(mx1, C2, off1));
    { const auto rr = __builtin_amdgcn_permlane32_swap(__float_as_uint(mxs), __float_as_uint(mxs), false, false);
      mxs = fmaxf(__uint_as_float(rr[0]), __uint_as_float(rr[1])); }
    const float mt2 = need ? (mxs + base_t) : -1e30f;
    resc = __any(mt2 - m > THR);
    if (resc) {
      const float mn = fmaxf(m, mt2);
      const float alpha = __builtin_amdgcn_exp2f(m - mn);
      l *= alpha; m = mn;
      if (hi == 0) wsf[r32] = alpha;
    }
  }
  const float nm0 = need ? (base_t - m) : -INFINITY;
  const float nm1 = nm0 + off1;
  {
    const bool live_next = (ubc - slope2 * (float)max(tq - k0 + 1, 0)) >= m - PRUNE;
    const int a = __any(live_next) ? 1 : 0;
    if (lane == 0) *flgw = a;
  }
  SBAR();
  float sacc = 0.f;
  h8 pn[4];
#pragma unroll
  for (int i = 0; i < 8; ++i) {
    kf[i] = kfrag(kpn, i);
    if (HASPREV) {
      if (i & 1) o[1] = MFMA32(pw[i >> 1], vf[i], o[1]);
      else       o[0] = MFMA32(pw[i >> 1], vf[i], o[0]);
    }
    float e[4];
#pragma unroll
    for (int j = 0; j < 4; ++j)
      e[j] = (i < 4) ? __builtin_amdgcn_exp2f(__builtin_fmaf(C0[4 * i + j], C2, nm0)) : __builtin_amdgcn_exp2f(__builtin_fmaf(C1[4 * (i - 4) + j], C2, nm1));
    sacc += (e[0] + e[1]) + (e[2] + e[3]);
    pn[i >> 1][(i & 1) * 4 + 0] = (_Float16)e[0]; pn[i >> 1][(i & 1) * 4 + 1] = (_Float16)e[1];
    pn[i >> 1][(i & 1) * 4 + 2] = (_Float16)e[2]; pn[i >> 1][(i & 1) * 4 + 3] = (_Float16)e[3];
    PINV(sacc); PINV(pn[i >> 1]);
    SBAR();
  }
  l += sacc;
#pragma unroll
  for (int s = 0; s < 4; ++s) pw[s] = pn[s];
  if (HASPREV && resc) {
#pragma unroll
    for (int r = 0; r < 16; ++r) { const float a = wsf[crow(r, hi)]; o[0][r] *= a; o[1][r] *= a; }
  }
}

__device__ __forceinline__ void fdrain(const h8 (&pw)[4], f32x16 (&o)[2], const LAS unsigned char* vp) {
#pragma unroll
  for (int f = 0; f < 8; ++f) {
    const h8 v = vfrag(vp, f);
    if (f & 1) o[1] = MFMA32(pw[f >> 1], v, o[1]); else o[0] = MFMA32(pw[f >> 1], v, o[0]);
  }
}

template <int MODE>
__device__ __forceinline__ void flash_pipe(LAS unsigned char* lds, const __half* Kg, const __half* Vg, int q0, int kt_lo, int kt_hi,
                                           const f32x16& bfix, float slope2, unsigned long long rowmask, float ubc,
                                           f32x16 (&o)[2], float& l_tot) {
  const int tid = otid(), lane = tid & 63, r32 = lane & 31, hi = lane >> 5;
  const int wid = __builtin_amdgcn_readfirstlane(tid >> 6);
  const int tq = q0 + wid * 32 + r32, tq_min = q0 + wid * 32, tq_max = tq_min + 31;
  LAS float* wsf = (LAS float*)(lds + AT_WS) + wid * 64;
  LAS int* flg = (LAS int*)(lds + AT_FLG);
  const __half* ksrc = Kg + (size_t)lane * 64 + wid * 8;
  const __half* vsrc = Vg + (size_t)(16 * (wid & 3) + (lane >> 2)) * 64 + (wid >> 2) * 32 + (lane & 3) * 8;
  const unsigned kdst = (unsigned)(unsigned long)(lds + AT_K) + wid * 1024;
  const unsigned vdst = (unsigned)(unsigned long)(lds + AT_V) + wid * 1024;
  const LAS unsigned char* kp0 = lds + AT_K + hi * 1024 + r32 * 16;
  const LAS unsigned char* vp0 = lds + AT_V + ((lane >> 4) & 1) * 32 + (lane & 3) * 8 + (4 * hi + ((lane & 15) >> 2)) * 64;
  const LAS unsigned char* qp = lds + AT_Q + wid * 4096 + lane * 16;
  h8 qf[4];
#pragma unroll
  for (int d0 = 0; d0 < 4; ++d0) qf[d0] = *(const LAS h8*)(qp + d0 * 1024);
#pragma unroll
  for (int r = 0; r < 16; ++r) { o[0][r] = 0.f; o[1][r] = 0.f; }
  float m = -1e30f, l = 0.f;
  h8 kf[8], pw[4];
#define KT_(t) max(kt_hi - (t), kt_lo)
#define DMA_K(t, slot) glds16_asm(ksrc + (size_t)KT_(t) * 4096, (unsigned)__builtin_amdgcn_readfirstlane(kdst + (slot)))
#define DMA_V(t, slot) glds16_asm(vsrc + (size_t)KT_(t) * 4096, (unsigned)__builtin_amdgcn_readfirstlane(vdst + (slot)))
  asm volatile("s_waitcnt vmcnt(0)" ::: "memory");
  DMA_K(0, 0); DMA_K(1, 8192); DMA_K(2, 16384); DMA_V(0, 0);
  WAIT_BAR(2);
#pragma unroll
  for (int i = 0; i < 8; ++i) kf[i] = kfrag(kp0, i);
  WAIT_BAR(2);
  int t = 0, kt = kt_hi;
  int s0 = 0, s1 = 8192, s2 = 16384;
#define STEP_CLOSE(done) do { WAIT_BAR(2);     \
    { const LAS int* f_ = flg + (kt & 1) * 8; const int any_live = f_[0] | f_[1] | f_[2] | f_[3] | f_[4] | f_[5] | f_[6] | f_[7]; done = (!any_live) || (kt == kt_lo); } } while (0)
#define STEP_ROT() do { const int t_ = s0; s0 = s1; s1 = s2; s2 = t_; ++t; --kt; } while (0)
  bool done;
  DMA_K(3, s0); DMA_V(1, s1);
  fstep<MODE, false>(pw, o, bfix, qf, kf, m, l, kp0 + s1, vp0, wsf, flg + (kt & 1) * 8 + wid, kt, q0, tq, tq_min, tq_max, hi, r32, lane, slope2, rowmask, ubc);
  STEP_CLOSE(done);
  while (!done) {
    STEP_ROT();
    DMA_K(t + 3, s0); DMA_V(t + 1, s1);
    fstep<MODE, true>(pw, o, bfix, qf, kf, m, l, kp0 + s1, vp0 + s2  , wsf, flg + (kt & 1) * 8 + wid, kt, q0, tq, tq_min, tq_max, hi, r32, lane, slope2, rowmask, ubc);
    STEP_CLOSE(done);
  }
  fdrain(pw, o, vp0 + s0);
  asm volatile("s_waitcnt lgkmcnt(0)\n\ts_barrier" ::: "memory");
#undef KT_
#undef DMA_K
#undef DMA_V
#undef STEP_CLOSE
#undef STEP_ROT
  l_tot = l + __shfl_xor(l, 32, 64);
}

__device__ __forceinline__ float score_bound(const P& p, const h8 (&qf)[4], int b, int slot) {
  float ss = 0.f;
#pragma unroll
  for (int d0 = 0; d0 < 4; ++d0)
#pragma unroll
    for (int j = 0; j < 8; ++j) { const float v = (float)qf[d0][j]; ss += v * v; }
  ss += __shfl_xor(ss, 32, 64);
  const unsigned* kn = p.kn2() + ((size_t)b * 60 + slot) * 2;
  const float kmax = sqrtf(__uint_as_float(kn[0]) + __uint_as_float(kn[1])) * 1.002f;
  return C2 * sqrtf(ss) * kmax * 1.001f;
}

__device__ __forceinline__ void put_q(LAS unsigned char* lds, const h8 (&qf)[4], int wid, int lane) {
  LAS unsigned char* qp = lds + AT_Q + wid * 4096 + lane * 16;
#pragma unroll
  for (int d0 = 0; d0 < 4; ++d0) *(LAS h8*)(qp + d0 * 1024) = qf[d0];
}

__device__ __forceinline__ void moba_unit(const P& p, LAS unsigned char* lds, int b, int h, int own) {
  const int tid = otid(), lane = tid & 63, r32 = lane & 31, hi = lane >> 5;
  const int wid = __builtin_amdgcn_readfirstlane(tid >> 6);
  const int q0 = own * 256;
  const size_t bh = (size_t)b * 8 + h;
  LAS float* km = (LAS float*)(lds + AT_KM);
  for (int e = tid; e < own * 64; e += 512) {
    const int n = e >> 6, d = e & 63;
    const float* kp = p.kmp() + ((bh * 16 + n) * 2) * 64 + d;
    km[e] = (kp[0] + kp[64]) * (1.f / 256.f);
  }
  h8 qf[4];
  const __half* qrow = hmp(p, SL_QA + h, b, q0 + wid * 32 + r32);
#pragma unroll
  for (int d0 = 0; d0 < 4; ++d0) qf[d0] = *reinterpret_cast<const h8*>(qrow + d0 * 16 + hi * 8);
  __syncthreads();
  float g0 = -3e38f, g1 = -3e38f, g2 = -3e38f; int i0 = -1, i1 = -1, i2 = -1;
  for (int n = 0; n < own; ++n) {
    float s = 0.f;
#pragma unroll
    for (int d0 = 0; d0 < 4; ++d0)
#pragma unroll
      for (int j = 0; j < 8; ++j) s += (float)qf[d0][j] * km[n * 64 + d0 * 16 + hi * 8 + j];
    s += __shfl_xor(s, 32, 64);
    if (s > g0) { g2 = g1; i2 = i1; g1 = g0; i1 = i0; g0 = s; i0 = n; }
    else if (s > g1) { g2 = g1; i2 = i1; g1 = s; i1 = n; }
    else if (s > g2) { g2 = s; i2 = n; }
  }
  unsigned long long rowmask = 1ull << own;
  if (i0 >= 0) rowmask |= 1ull << i0;
  if (i1 >= 0) rowmask |= 1ull << i1;
  if (i2 >= 0) rowmask |= 1ull << i2;
  const float slope = exp2f(-(float)(h + 1));
  const float slope2 = slope * LOG2E;
  f32x16 bfix;
  {
    const float sb = slope * 8.f;
    const int qrel = wid * 32 + r32;
#pragma unroll
    for (int r = 0; r < 16; ++r) bfix[r] = sb * (float)((r & 3) + 8 * (r >> 2) + 4 * hi - qrel);
  }
  f32x16 o[2]; float l_tot;
  const float ubc = score_bound(p, qf, b, SL_KA + h);
  put_q(lds, qf, wid, lane);
  flash_pipe<M_MOBA>(lds, hmp(p, SL_KA + h, b, 0), hmp(p, SL_VA + h, b, 0), q0, 0, 4 * own + 3, bfix, slope2, rowmask, ubc, o, l_tot);
  if (PROBE == 11 || PROBE == 13) flash_pipe<M_MOBA>(lds, hmp(p, SL_KA + h, b, 0), hmp(p, SL_VA + h, b, 0), q0, 0, 4 * own + 3, bfix, slope2, rowmask, ubc, o, l_tot);
  LAS float* wsf = (LAS float*)(lds + AT_WS) + wid * 64;
  scale_rows(o, 1.f / fmaxf(l_tot, 1e-30f), wsf, r32, hi);
  LAS _Float16* stg = (LAS _Float16*)(lds + AT_OST + wid * 4096);
#pragma unroll
  for (int r = 0; r < 16; ++r) {
    const int orow = crow(r, hi);
    stg[orow * 64 + r32] = (_Float16)o[0][r];
    stg[orow * 64 + 32 + r32] = (_Float16)o[1][r];
  }
  const int t3 = otid(), lane3 = t3 & 63, wid3 = t3 >> 6;
#pragma unroll
  for (int i = 0; i < 4; ++i) {
    const int row = i * 8 + (lane3 >> 3), ch = lane3 & 7;
    const h8 v = *(const LAS h8*)(stg + row * 64 + ch * 8);
    const int t = q0 + wid3 * 32 + row;
    const h8 z = *reinterpret_cast<const h8*>(hmp(p, SL_ZA + h, b, t) + ch * 8);
    h8 ov;
#pragma unroll
    for (int j = 0; j < 8; ++j) ov[j] = (_Float16)((float)v[j] * silu((float)z[j]));
    *reinterpret_cast<h8*>(p.cat() + ((size_t)b * S_ + t) * DM + h * 64 + ch * 8) = ov;
  }
  __syncthreads();
}

__device__ __forceinline__ void nsa_unit(const P& p, LAS unsigned char* lds, int b, int h, int qblk) {
  const int tid = otid(), lane = tid & 63, r32 = lane & 31, hi = lane >> 5;
  const int wid = __builtin_amdgcn_readfirstlane(tid >> 6);
  const int q0 = qblk * 256, g = h >> 2;
  const int tq = q0 + wid * 32 + r32;
  h8 qf[4];
  const __half* qrow = hmp(p, SL_QB + h, b, tq);
#pragma unroll
  for (int d0 = 0; d0 < 4; ++d0) qf[d0] = *reinterpret_cast<const h8*>(qrow + d0 * 16 + hi * 8);
  const unsigned long long rowmask = p.sel()[((size_t)b * 2 + g) * S_ + tq];
  const float slope = exp2f(-(float)(h + 1));
  const float slope2 = slope * LOG2E;
  f32x16 bfix;
  {
    const float sb = slope * 8.f;
    const int qrel = wid * 32 + r32;
#pragma unroll
    for (int r = 0; r < 16; ++r) bfix[r] = sb * (float)((r & 3) + 8 * (r >> 2) + 4 * hi - qrel);
  }
  LAS float* wsf = (LAS float*)(lds + AT_WS) + wid * 64;
  f32x16 o[2]; float l_tot;
  LAS float* st32 = (LAS float*)(lds + AT_OST + wid * 8192);
  const float ubc_s = score_bound(p, qf, b, SL_KV6 + 4 + g), ubc_w = score_bound(p, qf, b, SL_KV6 + 8 + g);
  put_q(lds, qf, wid, lane);
  flash_pipe<M_SLC>(lds, hmp(p, SL_KV6 + 4 + g, b, 0), hmp(p, SL_KV6 + 6 + g, b, 0), q0, 0, 4 * qblk + 3, bfix, slope2, rowmask, ubc_s, o, l_tot);
  if (PROBE == 11 || PROBE == 13) flash_pipe<M_SLC>(lds, hmp(p, SL_KV6 + 4 + g, b, 0), hmp(p, SL_KV6 + 6 + g, b, 0), q0, 0, 4 * qblk + 3, bfix, slope2, rowmask, ubc_s, o, l_tot);
  {
    const int t2 = otid(), tq2 = q0 + (t2 >> 6) * 32 + (t2 & 31);
    const float g1 = p.gate()[((size_t)b * S_ + tq2) * 24 + h * 3 + 1];
    scale_rows(o, g1 / fmaxf(l_tot, 1e-30f), wsf, r32, hi);
  }
#pragma unroll
  for (int r = 0; r < 16; ++r) { const int orow = crow(r, hi); st32[orow * 64 + r32] = o[0][r]; st32[orow * 64 + 32 + r32] = o[1][r]; }
  const int wlo = qblk >= 2 ? 4 * qblk - 8 : 0;
  flash_pipe<M_WIN>(lds, hmp(p, SL_KV6 + 8 + g, b, 0), hmp(p, SL_KV6 + 10 + g, b, 0), q0, wlo, 4 * qblk + 3, bfix, slope2, 0ull, ubc_w, o, l_tot);
  if (PROBE == 11 || PROBE == 13) flash_pipe<M_WIN>(lds, hmp(p, SL_KV6 + 8 + g, b, 0), hmp(p, SL_KV6 + 10 + g, b, 0), q0, wlo, 4 * qblk + 3, bfix, slope2, 0ull, ubc_w, o, l_tot);
  {
    const int t2 = otid(), tq2 = q0 + (t2 >> 6) * 32 + (t2 & 31);
    const float g2 = p.gate()[((size_t)b * S_ + tq2) * 24 + h * 3 + 2];
    scale_rows(o, g2 / fmaxf(l_tot, 1e-30f), wsf, r32, hi);
  }
  LAS _Float16* stg = (LAS _Float16*)(lds + AT_OST + wid * 8192);
  {
    float tmp0[16], tmp1[16];
#pragma unroll
    for (int r = 0; r < 16; ++r) { const int orow = crow(r, hi); tmp0[r] = st32[orow * 64 + r32] + o[0][r]; tmp1[r] = st32[orow * 64 + 32 + r32] + o[1][r]; }
    __builtin_amdgcn_wave_barrier();
#pragma unroll
    for (int r = 0; r < 16; ++r) { const int orow = crow(r, hi); stg[orow * 64 + r32] = (_Float16)tmp0[r]; stg[orow * 64 + 32 + r32] = (_Float16)tmp1[r]; }
  }
  const int t3 = otid(), lane3 = t3 & 63, wid3 = t3 >> 6;
#pragma unroll
  for (int i = 0; i < 4; ++i) {
    const int row = i * 8 + (lane3 >> 3), ch = lane3 & 7;
    const h8 v = *(const LAS h8*)(stg + row * 64 + ch * 8);
    const int t = q0 + wid3 * 32 + row;
    const h8 z = *reinterpret_cast<const h8*>(hmp(p, SL_ZB + h, b, t) + ch * 8);
    const float g0 = p.gate()[((size_t)b * S_ + t) * 24 + h * 3];
    const h8 oc = *reinterpret_cast<const h8*>(p.ocmph() + (((size_t)b * 8 + h) * S_ + t) * 64 + ch * 8);
    h8 ov;
#pragma unroll
    for (int j = 0; j < 8; ++j) ov[j] = (_Float16)(((float)v[j] + g0 * (float)oc[j]) * silu((float)z[j]));
    *reinterpret_cast<h8*>(p.cat() + ((size_t)b * S_ + t) * DM + 512 + h * 64 + ch * 8) = ov;
  }
  __syncthreads();
}


constexpr int CM_HID = 0;
constexpr int CM_X = 9216;
__device__ __forceinline__ void cm_unit(const P& p, LAS unsigned char* lds, int which, int b, int g, int mt) {
  const int tid = otid(), lane = tid & 63, r = lane & 15, q = lane >> 4;
  const int wid = __builtin_amdgcn_readfirstlane(tid >> 6);
  const int c0 = mt * 32;
  const __half* xs = hmp(p, SL_KV6 + 2 * which + g, b, 0) + (size_t)c0 * 1024;
  for (int pc = wid; pc < 66; pc += 8) glds16(xs + (size_t)pc * 512 + lane * 8, lds + CM_X + pc * 1040);
  const __half* bp = p.w1t() + ((size_t)which * 128 + wid * 16 + r) * 2048 + q * 8;
  const __half* pp = p.peh() + which * 2048 + q * 8;
  asm volatile("s_waitcnt vmcnt(0)" ::: "memory");
  __syncthreads();
  f32x4 acc0 = {0.f, 0.f, 0.f, 0.f}, acc1 = {0.f, 0.f, 0.f, 0.f};
  const LAS unsigned char* a0l = lds + CM_X + (2 * r) * 1040 + q * 16;
  const LAS unsigned char* a1l = lds + CM_X + (2 * (16 + r)) * 1040 + q * 16;
#pragma unroll 8
  for (int s = 0; s < 64; ++s) {
    const int off = (s >> 4) * 1040 + ((s >> 1) & 7) * 128 + (s & 1) * 64;
    const h8 pe = *reinterpret_cast<const h8*>(pp + s * 32);
    const h8 a0 = *(const LAS h8*)(a0l + off) + pe;
    const h8 a1 = *(const LAS h8*)(a1l + off) + pe;
    const h8 bf = *reinterpret_cast<const h8*>(bp + s * 32);
    acc0 = __builtin_amdgcn_mfma_f32_16x16x32_f16(a0, bf, acc0, 0, 0, 0);
    acc1 = __builtin_amdgcn_mfma_f32_16x16x32_f16(a1, bf, acc1, 0, 0, 0);
  }
  LAS _Float16* hid = (LAS _Float16*)(lds + CM_HID);
#pragma unroll
  for (int reg = 0; reg < 4; ++reg) {
    hid[(4 * q + reg) * 136 + wid * 16 + r] = (_Float16)silu(acc0[reg]);
    hid[(16 + 4 * q + reg) * 136 + wid * 16 + r] = (_Float16)silu(acc1[reg]);
  }
  __syncthreads();
  {
    const int mi = wid >> 2, ni = wid & 3;
    const __half* w2p = p.w2t() + ((size_t)which * 64 + ni * 16 + r) * 128 + q * 8;
    f32x4 acc = {0.f, 0.f, 0.f, 0.f};
#pragma unroll
    for (int s = 0; s < 4; ++s) {
      const h8 a = *(const LAS h8*)(hid + (mi * 16 + r) * 136 + s * 32 + q * 8);
      const h8 bf = *reinterpret_cast<const h8*>(w2p + s * 32);
      acc = __builtin_amdgcn_mfma_f32_16x16x32_f16(a, bf, acc, 0, 0, 0);
    }
    __half* dst = (which ? p.vch() : p.kch()) + ((size_t)b * 2 + g) * 256 * 64;
#pragma unroll
    for (int reg = 0; reg < 4; ++reg) {
      const int c = c0 + mi * 16 + 4 * q + reg;
      dst[(size_t)c * 64 + ni * 16 + r] = __float2half(c < 255 ? acc[reg] : 0.f);
    }
  }
  __syncthreads();
}

constexpr int CS_K = 0, CS_V = 32768, CS_SLAB = 65536, CS_SLAB_BYTES = 8 * 32 * 65 * 4, CS_WS = CS_SLAB + CS_SLAB_BYTES, CS_LDS = CS_WS + 2048;
__device__ __forceinline__ void cs_super(const P& p, LAS unsigned char* lds, int b, int g, int j) {
  const int tid = otid(), lane = tid & 63, r32 = lane & 31, hi = lane >> 5;
  const int wid = __builtin_amdgcn_readfirstlane(tid >> 6);
  const int hh = wid & 3, qi = wid >> 2, h = g * 4 + hh;
  const size_t bg = (size_t)b * 2 + g;
  {
    const __half* ksrc = p.kch() + bg * 256 * 64 + (size_t)lane * 64 + wid * 8;
    const __half* vsrc = p.vch() + bg * 256 * 64 + (size_t)(16 * (wid & 3) + (lane >> 2)) * 64 + (wid >> 2) * 32 + (lane & 3) * 8;
    for (int kt = 0; kt < 4; ++kt) {
      glds16(ksrc + (size_t)kt * 4096, lds + CS_K + kt * 8192 + wid * 1024);
      glds16(vsrc + (size_t)kt * 4096, lds + CS_V + kt * 8192 + wid * 1024);
    }
  }
  asm volatile("s_waitcnt vmcnt(0)" ::: "memory");
  __syncthreads();
  for (int oi = 0; oi < 4; ++oi) {
  const int own = oi == 0 ? j : oi == 1 ? 31 - j : oi == 2 ? 32 + j : 63 - j;
  const int q0 = own * 64;
  const int ntile = (4 * own + 66) >> 6;
  const int tq = q0 + qi * 32 + r32;
  const int ncv = tq >= 31 ? ((tq - 31) >> 4) + 1 : 0;
  h8 qf[4];
  const __half* qrow = hmp(p, SL_QB + h, b, tq);
#pragma unroll
  for (int d0 = 0; d0 < 4; ++d0) qf[d0] = *reinterpret_cast<const h8*>(qrow + d0 * 16 + hi * 8);
  const LAS unsigned char* kp0 = lds + CS_K + hi * 1024 + r32 * 16;
  const LAS unsigned char* vp0 = lds + CS_V + ((lane >> 4) & 1) * 32 + (lane & 3) * 8 + (4 * hi + ((lane & 15) >> 2)) * 64;
  const f32x16 zero16 = {0.f, 0.f, 0.f, 0.f, 0.f, 0.f, 0.f, 0.f, 0.f, 0.f, 0.f, 0.f, 0.f, 0.f, 0.f, 0.f};
  float m = -1e30f, l = 0.f;
  for (int kt = 0; kt < ntile; ++kt) {
    const LAS unsigned char* kp = kp0 + kt * 8192;
    f32x16 p0 = zero16, p1 = zero16;
#pragma unroll
    for (int d0 = 0; d0 < 4; ++d0) {
      const h8 k0f = *(const LAS h8*)(kp + d0 * 2048), k1f = *(const LAS h8*)(kp + d0 * 2048 + 512);
      p0 = __builtin_amdgcn_mfma_f32_32x32x16_f16(k0f, qf[d0], p0, 0, 0, 0);
      p1 = __builtin_amdgcn_mfma_f32_32x32x16_f16(k1f, qf[d0], p1, 0, 0, 0);
    }
    const int rel = ncv - 1 - 64 * kt - 4 * hi;
    float mx = -1e30f;
#pragma unroll
    for (int r = 0; r < 16; ++r) {
      const int e0 = (r & 3) + 8 * (r >> 2);
      p0[r] = e0 <= rel ? p0[r] : -1e30f; p1[r] = e0 + 32 <= rel ? p1[r] : -1e30f;
      mx = fmaxf(mx, fmaxf(p0[r], p1[r]));
    }
    mx = fmaxf(mx, __shfl_xor(mx, 32, 64));
    const float mn = fmaxf(m, mx * C2);
    float ls = 0.f;
#pragma unroll
    for (int r = 0; r < 16; ++r) ls += __builtin_amdgcn_exp2f(__builtin_fmaf(p0[r], C2, -mn)) + __builtin_amdgcn_exp2f(__builtin_fmaf(p1[r], C2, -mn));
    l = l * __builtin_amdgcn_exp2f(m - mn) + ls;
    m = mn;
  }
  float l_tot = l + __shfl_xor(l, 32, 64);
  const float inv = ncv > 0 ? 1.f / fmaxf(l_tot, 1e-30f) : 0.f;
  const float nm = ncv > 0 ? -m : -INFINITY;
  f32x16 o[2]; o[0] = zero16; o[1] = zero16;
  LAS float* slab = (LAS float*)(lds + CS_SLAB) + ((qi * 4 + hh) * 32 + r32) * 65;
  float carry = 0.f;
  for (int kt = 0; kt < ntile; ++kt) {
    const LAS unsigned char* kp = kp0 + kt * 8192;
    const LAS unsigned char* vp = vp0 + kt * 8192;
    f32x16 p0 = zero16, p1 = zero16;
#pragma unroll
    for (int d0 = 0; d0 < 4; ++d0) {
      const h8 k0f = *(const LAS h8*)(kp + d0 * 2048), k1f = *(const LAS h8*)(kp + d0 * 2048 + 512);
      p0 = __builtin_amdgcn_mfma_f32_32x32x16_f16(k0f, qf[d0], p0, 0, 0, 0);
      p1 = __builtin_amdgcn_mfma_f32_32x32x16_f16(k1f, qf[d0], p1, 0, 0, 0);
    }
    const int rel = ncv - 1 - 64 * kt - 4 * hi;
#pragma unroll
    for (int r = 0; r < 16; ++r) {
      const int e0 = (r & 3) + 8 * (r >> 2);
      const float a0 = e0 <= rel ? p0[r] : -1e30f, a1 = e0 + 32 <= rel ? p1[r] : -1e30f;
      p0[r] = __builtin_amdgcn_exp2f(__builtin_fmaf(a0, C2, nm)) * inv;
      p1[r] = __builtin_amdgcn_exp2f(__builtin_fmaf(a1, C2, nm)) * inv;
    }
#pragma unroll
    for (int n = 0; n < 2; ++n) {
#pragma unroll
      for (int rg = 0; rg < 4; ++rg) {
        const float t3 = n == 0 ? p0[4 * rg + 3] : p1[4 * rg + 3];
        const float gs = n == 0 ? (p0[4 * rg] + p0[4 * rg + 1]) + (p0[4 * rg + 2] + t3) : (p1[4 * rg] + p1[4 * rg + 1]) + (p1[4 * rg + 2] + t3);
        const float tp = __shfl_xor(t3, 32, 64);
        slab[2 * (8 * kt + 4 * n + rg) + hi] = gs + (hi ? tp : carry);
        carry = tp;
      }
    }
    h8 pa[4];
#pragma unroll
    for (int j = 0; j < 8; ++j) { pa[0][j] = (_Float16)p0[j]; pa[1][j] = (_Float16)p0[8 + j]; pa[2][j] = (_Float16)p1[j]; pa[3][j] = (_Float16)p1[8 + j]; }
#pragma unroll
    for (int s = 0; s < 4; ++s) {
#pragma unroll
      for (int dh = 0; dh < 2; ++dh) {
        const h4 lo = vtr(vp + dh * 4096 + s * 1024), hv = vtr(vp + dh * 4096 + s * 1024 + 512);
        const h8 vf = __builtin_shufflevector(lo, hv, 0, 1, 2, 3, 4, 5, 6, 7);
        o[dh] = __builtin_amdgcn_mfma_f32_32x32x16_f16(pa[s], vf, o[dh], 0, 0, 0);
      }
    }
  }
  __syncthreads();
  if (own < 16) {
    if (tid < 64) p.sel()[bg * S_ + q0 + tid] = (2ull << own) - 1ull;
  } else {
    const LAS float* sl = (const LAS float*)(lds + CS_SLAB);
    const int jj = lane;
    const bool cand = (jj >= 1) && (jj <= own - 2);
    const unsigned long long forced = 1ull | (1ull << own) | (1ull << (own - 1));
    for (int i = 0; i < 8; ++i) {
      const int qq = wid * 8 + i, q2 = qq >> 5, rr = qq & 31;
      float v = 0.f;
#pragma unroll
      for (int x = 0; x < 4; ++x) v += sl[((q2 * 4 + x) * 32 + rr) * 65 + jj];
      const unsigned key = cand ? (__float_as_uint(v) + 1u) : 0u;
      unsigned th = 0u;
#pragma unroll
      for (int bit = 30; bit >= 0; --bit) {
        const unsigned c = th | (1u << bit);
        const int cnt = __popcll(__ballot(key >= c));
        th = cnt >= 13 ? c : th;
      }
      const unsigned long long gt = __ballot(key > th), eq = __ballot(key == th);
      const int need = 13 - __popcll(gt);
      unsigned long long t = eq;
      for (int k = 0; k < need; ++k) t &= t - 1ull;
      const unsigned long long msk = gt | (eq ^ t) | forced;
      if (lane == 0) p.sel()[bg * S_ + q0 + qq] = msk;
    }
  }
  __syncthreads();
  {
    LAS _Float16* stg = (LAS _Float16*)(lds + CS_SLAB + wid * 4096);
#pragma unroll
    for (int r = 0; r < 16; ++r) {
      const int orow = crow(r, hi);
      stg[orow * 64 + r32] = (_Float16)o[0][r];
      stg[orow * 64 + 32 + r32] = (_Float16)o[1][r];
    }
#pragma unroll
    for (int i = 0; i < 4; ++i) {
      const int row = i * 8 + (lane >> 3), ch = lane & 7;
      const h8 v = *(const LAS h8*)(stg + row * 64 + ch * 8);
      const int t = q0 + qi * 32 + row;
      *reinterpret_cast<h8*>(p.ocmph() + (((size_t)b * 8 + h) * S_ + t) * 64 + ch * 8) = v;
    }
  }
  __syncthreads();
  }
}

#define XB_TMO      128
#define XB_XCNT(j)  (256  + 64 * (j))
#define XB_XSUB(j)  (1280 + 64 * (j))
#define XB_XGEN(j)  (2304 + 64 * (j))
#define XB_TOP      3328
#define XB_TOPGEN   3392
#define XCD_BAR_WORDS 3456
#define XB_SPIN_CAP (1u << 18)
__device__ __forceinline__ unsigned xb_ld(unsigned* p) { return __hip_atomic_load(p, __ATOMIC_RELAXED, __HIP_MEMORY_SCOPE_AGENT); }
__device__ __forceinline__ unsigned xb_add(unsigned* p, unsigned v) { return __hip_atomic_fetch_add(p, v, __ATOMIC_RELAXED, __HIP_MEMORY_SCOPE_AGENT); }
__device__ __forceinline__ unsigned xb_xcc_id() { return (unsigned)__builtin_amdgcn_s_getreg((3 << 11) | 20) & 0xFu; }
#define XB_SPIN(cond, bar) do { unsigned _sp = 0; while (cond) { __builtin_amdgcn_s_sleep(1); \
    if ((++_sp & 255u) == 0u) { if (xb_ld(&(bar)[XB_TMO])) break; if (_sp > XB_SPIN_CAP) { atomicAdd(&(bar)[XB_TMO], 1u); break; } } } } while (0)
struct XcdBarrier { unsigned* bar; unsigned x; volatile LAS unsigned* st; };
__device__ __forceinline__ XcdBarrier xcd_barrier_post(unsigned* bar, volatile LAS unsigned* st) {
  XcdBarrier b; b.bar = bar; b.x = xb_xcc_id(); b.st = st;
  if (threadIdx.x == 0) (void)xb_add(&bar[XB_XCNT(b.x)], 1u);
  return b;
}
__device__ __forceinline__ void xcd_barrier_complete(unsigned* bar, unsigned x, unsigned& nloc, unsigned& nx) {
  const unsigned G = gridDim.x * gridDim.y * gridDim.z;
  unsigned sum, cnt, mine, sp = 0u;
  for (;;) {
    sum = 0u; cnt = 0u; mine = 0u;
#pragma unroll
    for (unsigned j = 0; j < 16; ++j) { const unsigned c = xb_ld(&bar[XB_XCNT(j)]); sum += c; cnt += (c > 0u) ? 1u : 0u; mine = (j == x) ? c : mine; }
    if (sum == G) break;
    __builtin_amdgcn_s_sleep(1);
    if ((++sp & 255u) == 0u) { if (xb_ld(&bar[XB_TMO])) break; if (sp > XB_SPIN_CAP) { atomicAdd(&bar[XB_TMO], 1u); break; } }
  }
  nloc = mine > 0u ? mine : 1u; nx = cnt > 0u ? cnt : 1u;
}
__device__ __forceinline__ void xcd_barrier(const XcdBarrier& b) {
  asm volatile("s_waitcnt vmcnt(0)" ::: "memory");
  __syncthreads();
  if (threadIdx.x == 0) {
    unsigned* bar = b.bar;
    __builtin_amdgcn_s_waitcnt(0);
    unsigned nloc = b.st[0], nx = b.st[1];
    if (nloc == 0u) { xcd_barrier_complete(bar, b.x, nloc, nx); b.st[0] = nloc; b.st[1] = nx; }
    const unsigned old = xb_add(&bar[XB_XSUB(b.x)], 1u);
    const unsigned gen = old / nloc;
    if (old + 1u == (gen + 1u) * nloc) {
      __builtin_amdgcn_fence(__ATOMIC_RELEASE, "agent");
      asm volatile("s_waitcnt vmcnt(0)" ::: "memory");
      const unsigned og = xb_add(&bar[XB_TOP], 1u);
      const unsigned tg = og / nx;
      if (og + 1u == (tg + 1u) * nx) xb_add(&bar[XB_TOPGEN], 1u);
      else XB_SPIN(xb_ld(&bar[XB_TOPGEN]) == tg, bar);
      __builtin_amdgcn_fence(__ATOMIC_ACQUIRE, "agent");
      xb_add(&bar[XB_XGEN(b.x)], 1u);
      asm volatile("s_waitcnt vmcnt(0)" ::: "memory");
    } else {
      XB_SPIN(xb_ld(&bar[XB_XGEN(b.x)]) == gen, bar);
      __builtin_amdgcn_fence(__ATOMIC_ACQUIRE, "agent");
      asm volatile("s_waitcnt vmcnt(0)" ::: "memory");
    }
  }
  __syncthreads();
}

__device__ __forceinline__ int cap_tiles(int h) { return h == 0 ? 6 : h == 1 ? 7 : h == 2 ? 10 : h == 3 ? 15 : h == 4 ? 26 : h == 5 ? 48 : 64; }
__device__ __forceinline__ int unit_cost(int mode, int pi) {
  const int h = pi >> 4, blk = pi & 15, cap = cap_tiles(h);
  const int full = 4 * (blk + 1);
  if (mode == 0) return min(full, cap);
  return min(full, cap) + min(min(full, 12), cap) + 2;
}
__device__ __forceinline__ void build_order(LAS unsigned char* lds, int mode) {
  LAS short* ord = (LAS short*)(lds + AT_ORD);
  const int i = threadIdx.x;
  if (i < 128) {
    const int ci = unit_cost(mode, i);
    int rank = 0;
    for (int j = 0; j < 128; ++j) { const int cj = unit_cost(mode, j); rank += (cj > ci) || (cj == ci && j < i); }
    ord[rank] = (short)i;
  }
  __syncthreads();
}
__device__ __forceinline__ int queue_next(unsigned* ctr, LAS unsigned char* lds) {
  LAS int* slot = (LAS int*)(lds + AT_QS);
  if (threadIdx.x == 0) *slot = (int)atomicAdd(ctr, 1u);
  __syncthreads();
  const int v = *slot;
  __syncthreads();
  return v;
}
constexpr int XB_ST_OFF = (CS_LDS > STAGE_BYTES ? CS_LDS : STAGE_BYTES) > AT_LDS ? (CS_LDS > STAGE_BYTES ? CS_LDS : STAGE_BYTES) : AT_LDS;
constexpr int MEGA_LDS = XB_ST_OFF + 16;

__global__ __launch_bounds__(512, 2) void mega(P p) {
  extern __shared__ __attribute__((aligned(16))) unsigned char shm[];
  LAS unsigned char* lds = (LAS unsigned char*)shm;
  const int bid = blockIdx.x, nblk = gridDim.x;
  if (threadIdx.x < 4) ((LAS unsigned*)(lds + XB_ST_OFF))[threadIdx.x] = 0u;
  __syncthreads();
  const XcdBarrier xb = xcd_barrier_post(p.xbar(), (volatile LAS unsigned*)(lds + XB_ST_OFF));
  for (int rep = 0; rep < (PROBE == 10 ? 2 : 1); ++rep) phase_prep(p, lds, bid, nblk);
  xcd_barrier(xb);
  if (PROBE == 9) { for (int i = 0; i < 6; ++i) xcd_barrier(xb); }
  {
    StaticOrder S; S.init(T_, NP - 256, nblk, bid, PROBE == 1 ? 2 : PROBE == 21 ? 3 : 1);
    EpiProj E{p.hm(), p.rstd(), p.kmp(), p.kn2(), 0};
    gemm_phase<EpiProj>(lds, p.xh(), p.wt(), T_, NP - 256, DM, S, E);
  }
  xcd_barrier(xb);
  if (nblk >= 256) {
    if (bid < 128) {
      StaticOrder S; S.init(T_, 256, 128, bid, 1);
      EpiProj E{p.hm(), p.rstd(), p.kmp(), p.kn2(), 14};
      gemm_phase<EpiProj>(lds, p.xh(), p.wt() + (size_t)14 * 256 * DM, T_, 256, DM, S, E);
    } else if (bid < 256) {
      for (int u = (bid - 128) * 2; u < (bid - 128) * 2 + 2; ++u) cm_unit(p, lds, u >> 7, (u >> 4) & 7, (u >> 3) & 1, u & 7);
    }
  } else {
    { StaticOrder S; S.init(T_, 256, nblk, bid, 1);
      EpiProj E{p.hm(), p.rstd(), p.kmp(), p.kn2(), 14};
      gemm_phase<EpiProj>(lds, p.xh(), p.wt() + (size_t)14 * 256 * DM, T_, 256, DM, S, E); }
    for (int u = bid; u < 2 * 8 * 2 * 8; u += nblk) cm_unit(p, lds, u >> 7, (u >> 4) & 7, (u >> 3) & 1, u & 7);
  }
  for (int rep = 0; rep < (PROBE == 3 ? 2 : PROBE == 23 ? 3 : 1); ++rep) {
    build_order(lds, 0);
    for (;;) {
      const int u = queue_next(p.qctr() + 0 + 2 * rep, lds);
      if (u >= 8 * 8 * 16) break;
      const int pi = ((const LAS short*)(lds + AT_ORD))[u >> 3];
      moba_unit(p, lds, u & 7, pi >> 4, pi & 15);
    }
  }
  xcd_barrier(xb);
  for (int rep = 0; rep < (PROBE == 4 ? 2 : 1); ++rep)
    for (int su = bid; su < 256; su += nblk) cs_super(p, lds, (su & 15) >> 1, su & 1, su >> 4);
  xcd_barrier(xb);
  for (int rep = 0; rep < (PROBE == 5 ? 2 : PROBE == 25 ? 3 : 1); ++rep) {
    build_order(lds, 1);
    for (;;) {
      const int u = queue_next(p.qctr() + 1 + 2 * rep, lds);
      if (u >= 8 * 8 * 16) break;
      const int pi = ((const LAS short*)(lds + AT_ORD))[u >> 3];
      nsa_unit(p, lds, u & 7, pi >> 4, pi & 15);
    }
  }
  xcd_barrier(xb);
  {
    StaticOrder S; S.init(T_, DM, nblk, bid, PROBE == 6 ? 2 : 1);
    EpiY E{p.hm(), p.ssq()};
    gemm_phase<EpiY>(lds, p.cat(), p.wot(), T_, DM, DM, S, E);
  }
  xcd_barrier(xb);
  for (int rep = 0; rep < (PROBE == 7 ? 2 : 1); ++rep) phase_post(p, bid, nblk);
}

}


extern "C" void kernel_launch(void* const* d_in, const int* in_sizes, int n_in, void* d_out, int out_size, void* d_ws,
                              size_t ws_size, hipStream_t stream) {
  P p{};
  p.x = (const float*)d_in[0]; p.g_pre = (const float*)d_in[1]; p.g_post = (const float*)d_in[2];
  p.w_in = (const float*)d_in[3]; p.pe_k = (const float*)d_in[4]; p.pe_v = (const float*)d_in[5];
  p.wk1 = (const float*)d_in[6]; p.wk2 = (const float*)d_in[7]; p.wv1 = (const float*)d_in[8]; p.wv2 = (const float*)d_in[9];
  p.w_out = (const float*)d_in[10]; p.out = (float*)d_out;
  p.ws = (char*)d_ws;
  if (ws_size < WS_END) { fprintf(stderr, "workspace too small\n"); return; }

  static int grid_blocks = 0;
  if (!grid_blocks) {
    int dev = 0, cus = 0, per_cu = 0;
    (void)hipGetDevice(&dev);
    (void)hipDeviceGetAttribute(&cus, hipDeviceAttributeMultiprocessorCount, dev);
    (void)hipFuncSetAttribute((const void*)mega, hipFuncAttributeMaxDynamicSharedMemorySize, MEGA_LDS);
    (void)hipOccupancyMaxActiveBlocksPerMultiprocessor(&per_cu, (const void*)mega, 512, MEGA_LDS);
    if (per_cu < 1) per_cu = 1;
    if (per_cu > 1) per_cu = 1;
    grid_blocks = cus * per_cu;
  }
  (void)hipMemsetAsync((char*)d_ws + OFF_XBAR, 0, (size_t)3456 * 4, stream);
  hipLaunchKernelGGL(mega, dim3(grid_blocks), dim3(512), MEGA_LDS, stream, p);
  hipError_t e = hipPeekAtLastError();
  if (e != hipSuccess) fprintf(stderr, "launch failed: %s (grid %d)\n", hipGetErrorString(e), grid_blocks);
}
```

```cpp
#include <hip/hip_runtime.h>
#include <hip/hip_fp16.h>
#include <hip/hip_cooperative_groups.h>
#include <cstdio>
#include <stdint.h>

#define PROBE 0
namespace {

#define LAS __attribute__((address_space(3)))
typedef _Float16 h8 __attribute__((ext_vector_type(8)));
typedef _Float16 h4 __attribute__((ext_vector_type(4)));
typedef float f32x4 __attribute__((ext_vector_type(4)));
typedef float f32x16 __attribute__((ext_vector_type(16)));
typedef unsigned u32x4 __attribute__((ext_vector_type(4)));

__device__ __forceinline__ int otid() { int t = threadIdx.x; asm volatile("" : "+v"(t)); return t; }

constexpr int B_ = 8, S_ = 4096, DM = 1024, DIN = 3864, T_ = B_ * S_;
constexpr int NP = 3840;
constexpr float EPS = 1e-6f;
constexpr int SL_QA = 0, SL_KA = 8, SL_VA = 16, SL_ZA = 24, SL_QB = 32, SL_KV6 = 40, SL_ZB = 52;

constexpr size_t al256(size_t x) { return (x + 255) & ~(size_t)255; }
constexpr size_t OFF_XH = 0;
constexpr size_t OFF_WT = OFF_XH + al256((size_t)T_ * 1024 * 2);
constexpr size_t OFF_WOT = OFF_WT + al256((size_t)NP * 1024 * 2);
constexpr size_t OFF_RSTD = OFF_WOT + al256((size_t)1024 * 1024 * 2);
constexpr size_t OFF_GATE = OFF_RSTD + al256((size_t)T_ * 4);
constexpr size_t OFF_KMP = OFF_GATE + al256((size_t)T_ * 24 * 4);
constexpr size_t OFF_KN2 = OFF_KMP + al256((size_t)8 * 8 * 16 * 2 * 64 * 4);
constexpr size_t OFF_QCTR = OFF_KN2 + al256((size_t)8 * 60 * 2 * 4);
constexpr size_t OFF_XBAR = OFF_QCTR + 256;
constexpr size_t OFF_SSQ = OFF_XBAR + al256((size_t)3456 * 4);
constexpr size_t OFF_PCNT = OFF_SSQ + al256((size_t)T_ * 4);
constexpr size_t OFF_SSQ2 = OFF_PCNT + al256(256 * 4);
constexpr size_t OFF_PCNT2 = OFF_SSQ2 + al256((size_t)T_ * 4);
constexpr size_t OFF_SEL = OFF_PCNT2 + al256(256 * 4);
constexpr size_t OFF_KCH = OFF_SEL + al256((size_t)8 * 2 * 4096 * 8);
constexpr size_t OFF_VCH = OFF_KCH + al256((size_t)8 * 2 * 256 * 64 * 2);
constexpr size_t OFF_W1T = OFF_VCH + al256((size_t)8 * 2 * 256 * 64 * 2);
constexpr size_t OFF_W2T = OFF_W1T + al256((size_t)2 * 128 * 2048 * 2);
constexpr size_t OFF_PEH = OFF_W2T + al256((size_t)2 * 64 * 128 * 2);
constexpr size_t OFF_OCMPH = OFF_PEH + al256((size_t)2 * 2048 * 2);
constexpr size_t OFF_HM = OFF_OCMPH + al256((size_t)T_ * 512 * 2);
constexpr size_t OFF_CAT = OFF_HM + al256((size_t)60 * T_ * 64 * 2);
constexpr size_t WS_END = OFF_CAT + al256((size_t)T_ * 1024 * 2);

struct P {
  const float* x; const float* g_pre; const float* g_post; const float* w_in;
  const float* pe_k; const float* pe_v; const float* wk1; const float* wk2; const float* wv1; const float* wv2;
  const float* w_out; float* out;
  char* ws;
  __device__ __forceinline__ __half* xh() const { return (__half*)(ws + OFF_XH); }
  __device__ __forceinline__ __half* cat() const { return (__half*)(ws + OFF_CAT); }
  __device__ __forceinline__ __half* wt() const { return (__half*)(ws + OFF_WT); }
  __device__ __forceinline__ __half* wot() const { return (__half*)(ws + OFF_WOT); }
  __device__ __forceinline__ float* rstd() const { return (float*)(ws + OFF_RSTD); }
  __device__ __forceinline__ float* gate() const { return (float*)(ws + OFF_GATE); }
  __device__ __forceinline__ float* kmp() const { return (float*)(ws + OFF_KMP); }
  __device__ __forceinline__ unsigned* kn2() const { return (unsigned*)(ws + OFF_KN2); }
  __device__ __forceinline__ unsigned* qctr() const { return (unsigned*)(ws + OFF_QCTR); }
  __device__ __forceinline__ unsigned* xbar() const { return (unsigned*)(ws + OFF_XBAR); }
  __device__ __forceinline__ float* ssq() const { return (float*)(ws + OFF_SSQ); }
  __device__ __forceinline__ unsigned* pcnt() const { return (unsigned*)(ws + OFF_PCNT); }
  __device__ __forceinline__ unsigned long long* sel() const { return (unsigned long long*)(ws + OFF_SEL); }
  __device__ __forceinline__ __half* kch() const { return (__half*)(ws + OFF_KCH); }
  __device__ __forceinline__ __half* vch() const { return (__half*)(ws + OFF_VCH); }
  __device__ __forceinline__ __half* w1t() const { return (__half*)(ws + OFF_W1T); }
  __device__ __forceinline__ __half* w2t() const { return (__half*)(ws + OFF_W2T); }
  __device__ __forceinline__ __half* peh() const { return (__half*)(ws + OFF_PEH); }
  __device__ __forceinline__ __half* ocmph() const { return (__half*)(ws + OFF_OCMPH); }
  __device__ __forceinline__ __half* hm() const { return (__half*)(ws + OFF_HM); }
};

__device__ __forceinline__ const __half* hmp(const P& p, int slot, int b, int t) {
  return p.hm() + (((size_t)slot * T_) + (size_t)b * S_ + t) * 64;
}

__device__ __forceinline__ float wave_sum(float v) {
#pragma unroll
  for (int o = 32; o > 0; o >>= 1) v += __shfl_xor(v, o, 64);
  return v;
}
__device__ __forceinline__ float silu(float v) { return v * __builtin_amdgcn_rcpf(1.f + __builtin_amdgcn_exp2f(-1.4426950408889634f * v)); }

constexpr int PREP_WG_OFF = 0;
constexpr int PREP_TILE_OFF = 65536;
constexpr int PREP_LDS = 65536 + 64 * 65 * 4;

__device__ __forceinline__ void tr_tile(const float* src, int ldS, int k0, int n0s, __half* dst, int ldD, int n0d,
                                        const float* scale, LAS float* tile, int tid) {
  {
    const int i = tid >> 4, jj = (tid & 15) * 4;
#pragma unroll
    for (int h = 0; h < 2; ++h) {
      const int k = i + 32 * h;
      float4 v = *reinterpret_cast<const float4*>(src + (size_t)(k0 + k) * ldS + n0s + jj);
      const float sc = scale ? scale[k0 + k] : 1.f;
      tile[k * 65 + jj + 0] = v.x * sc; tile[k * 65 + jj + 1] = v.y * sc; tile[k * 65 + jj + 2] = v.z * sc; tile[k * 65 + jj + 3] = v.w * sc;
    }
  }
  __syncthreads();
  {
    const int n = tid >> 3, kc = (tid & 7) * 8;
    h8 o;
#pragma unroll
    for (int u = 0; u < 8; ++u) o[u] = (_Float16)tile[(kc + u) * 65 + n];
    *reinterpret_cast<h8*>(dst + (size_t)(n0d + n) * ldD + k0 + kc) = o;
  }
  __syncthreads();
}

__device__ __forceinline__ void phase_prep(const P& p, LAS unsigned char* lds, int bid, int nblk) {
  const int tid = otid(), lane = tid & 63, wid = tid >> 6;
  LAS _Float16* wgl = (LAS _Float16*)(lds + PREP_WG_OFF);
#pragma unroll
  for (int rr = 0; rr < 2; ++rr) {
    const int k = tid + rr * 512;
    const f32x4* wrow = reinterpret_cast<const f32x4*>(p.w_in + (size_t)k * DIN + 3328);
    f32x4 w[6];
#pragma unroll
    for (int i = 0; i < 6; ++i) w[i] = wrow[i];
    const float gk = p.g_pre[k];
    const int s = k >> 5, q = (k >> 3) & 3, j = k & 7;
    LAS _Float16* dst = wgl + ((s * 4 + q) * 32) * 8 + j;
#pragma unroll
    for (int n = 0; n < 24; ++n) dst[n * 8] = (_Float16)(w[n >> 2][n & 3] * gk);
#pragma unroll
    for (int n = 24; n < 32; ++n) dst[n * 8] = (_Float16)0.f;
  }
  __syncthreads();
  for (int u = bid; u < T_ / 128; u += nblk) {
    const int row0 = u * 128 + wid * 16;
    const int r = lane & 15, q = lane >> 4;
    const float* xr = p.x + (size_t)(row0 + r) * DM + q * 8;
    __half* xo = p.xh() + (size_t)(row0 + r) * DM + q * 8;
    f32x4 acc0 = {0.f, 0.f, 0.f, 0.f}, acc1 = {0.f, 0.f, 0.f, 0.f};
    float ss = 0.f;
#pragma unroll 4
    for (int s = 0; s < 32; ++s) {
      const f32x4 v0 = __builtin_nontemporal_load(reinterpret_cast<const f32x4*>(xr + s * 32));
      const f32x4 v1 = __builtin_nontemporal_load(reinterpret_cast<const f32x4*>(xr + s * 32 + 4));
      ss += v0.x * v0.x + v0.y * v0.y + v0.z * v0.z + v0.w * v0.w + v1.x * v1.x + v1.y * v1.y + v1.z * v1.z + v1.w * v1.w;
      h8 a;
      a[0] = (_Float16)v0.x; a[1] = (_Float16)v0.y; a[2] = (_Float16)v0.z; a[3] = (_Float16)v0.w;
      a[4] = (_Float16)v1.x; a[5] = (_Float16)v1.y; a[6] = (_Float16)v1.z; a[7] = (_Float16)v1.w;
      *reinterpret_cast<h8*>(xo + s * 32) = a;
      const h8 b0 = *(const LAS h8*)(lds + PREP_WG_OFF + ((s * 4 + q) * 32 + r) * 16);
      const h8 b1 = *(const LAS h8*)(lds + PREP_WG_OFF + ((s * 4 + q) * 32 + 16 + r) * 16);
      acc0 = __builtin_amdgcn_mfma_f32_16x16x32_f16(a, b0, acc0, 0, 0, 0);
      acc1 = __builtin_amdgcn_mfma_f32_16x16x32_f16(a, b1, acc1, 0, 0, 0);
    }
    ss += __shfl_xor(ss, 16, 64);
    ss += __shfl_xor(ss, 32, 64);
    const float rs = rsqrtf(ss * (1.f / DM) + EPS);
    if (q == 0) p.rstd()[row0 + r] = rs;
#pragma unroll
    for (int reg = 0; reg < 4; ++reg) {
      const int row = q * 4 + reg;
      const float rr = __shfl(rs, row, 64);
      float* gp = p.gate() + (size_t)(row0 + row) * 24;
      gp[r] = 1.f / (1.f + __expf(-acc0[reg] * rr));
      if (r < 8) gp[16 + r] = 1.f / (1.f + __expf(-acc1[reg] * rr));
    }
  }
  __syncthreads();
  LAS float* tile = (LAS float*)(lds + PREP_TILE_OFF);
  constexpr int N_WIN = 16 * 60, N_WOUT = 16 * 16;
  constexpr int N_W1 = 2 * 64, N_W2 = 2 * 2;
  for (int it = bid; it < N_WIN + N_WOUT + N_W1 + N_W2; it += nblk) {
    if (it < N_WIN) {
      const int kb = it / 60, nb = it - kb * 60;
      const int n0d = nb * 64, n0s = n0d < 3328 ? n0d : n0d + 24;
      tr_tile(p.w_in, DIN, kb * 64, n0s, p.wt(), DM, n0d, p.g_pre, tile, tid);
    } else if (it < N_WIN + N_WOUT) {
      const int r = it - N_WIN, kb = r >> 4, nb = r & 15;
      tr_tile(p.w_out, DM, kb * 64, nb * 64, p.wot(), DM, nb * 64, nullptr, tile, tid);
    } else if (it < N_WIN + N_WOUT + N_W1) {
      const int r = it - N_WIN - N_WOUT, which = r >> 6, kb = (r & 63) >> 1, nb = r & 1;
      tr_tile(which ? p.wv1 : p.wk1, 128, kb * 64, nb * 64, p.w1t() + (size_t)which * 128 * 2048, 2048, nb * 64, nullptr, tile, tid);
    } else {
      const int r = it - N_WIN - N_WOUT - N_W1, which = r >> 1, kb = r & 1;
      tr_tile(which ? p.wv2 : p.wk2, 64, kb * 64, 0, p.w2t() + (size_t)which * 64 * 128, 128, 0, nullptr, tile, tid);
    }
  }
  for (int e = bid * 512 + tid; e < 8 * 60 * 2; e += nblk * 512) p.kn2()[e] = 0u;
  if (bid == 0 && tid < 8) p.qctr()[tid] = 0u;
  for (int e = bid * 512 + tid; e < T_; e += nblk * 512) p.ssq()[e] = 0.f;
  if (bid == 1 && tid < 256) p.pcnt()[tid] = 0u;
  if (PROBE == 6) { for (int e = bid * 512 + tid; e < T_; e += nblk * 512) ((float*)(p.ws + OFF_SSQ2))[e] = 0.f; if (bid == 3 && tid < 256) ((unsigned*)(p.ws + OFF_PCNT2))[tid] = 0u; }
  for (int e = bid * 512 + tid; e < 2 * 2048; e += nblk * 512) p.peh()[e] = __float2half(e < 2048 ? p.pe_k[e] : p.pe_v[e - 2048]);
}

constexpr int BM = 256, BK = 64, HALF = 128, HTB = HALF * BK * 2, STAGE_BYTES = 8 * HTB, NXCD = 8, WGM = 8;

__device__ __forceinline__ int lds_byte(int r, int c) { const int st = (r >> 4) * 2 + (c >> 5), rr = r & 15, cc = c & 31, ob = rr * 64 + cc * 2; return st * 1024 + (ob ^ (((ob >> 9) & 1) << 5)); }
__device__ __forceinline__ void stage_rc(int b, int& R, int& C) { const int st = b / 1024, sb = b % 1024, swz = sb ^ (((sb >> 9) & 1) << 5); R = (st >> 1) * 16 + swz / 64; C = (st & 1) * 32 + (swz % 64) / 2; }
__device__ __forceinline__ int perm32(int rho) { const int n = rho >> 4, i = rho & 15; return 8 * (i >> 2) + 4 * n + (i & 3); }

struct Unit { int pm, pn; };
struct StaticOrder {
  int nM, nN, nwg, G, c, rep;
  __device__ void init(int M, int N, int G_, int c_, int rep_ = 1) { nM = M / BM; nN = N / BM; nwg = nM * nN; G = G_; c = c_; rep = rep_; }
  __device__ bool next(int i, Unit& u) const {
    const long L = (long)i * G + c; if (L >= (long)nwg * rep) return false;
    int wgid = (int)(L % nwg); { const int q = nwg / NXCD, r = nwg % NXCD, xcd = wgid % NXCD, off = wgid / NXCD; wgid = (xcd < r ? xcd * (q + 1) : r * (q + 1) + (xcd - r) * q) + off; }
    const int nig = WGM * nN, gid = wgid / nig, fm = gid * WGM, gsz = (nM - fm) < WGM ? (nM - fm) : WGM;
    u.pm = fm + ((wgid % nig) % gsz); u.pn = (wgid % nig) / gsz; return true;
  }
};

struct EpiProj {
  static constexpr bool PERM = true;
  __half* hm; const float* rstd; float* kmp; unsigned* kn2; int pn_off;
  __device__ __forceinline__ void operator()(const f32x4 (&acc)[2][2][4][2], const Unit& u0, int wr, int wc, int fr, int fq) const {
    Unit u; u.pm = u0.pm; u.pn = u0.pn + pn_off;
    const int row0 = u.pm * BM + wr * 64 + fr;
    const int colb = u.pn * BM + wc * 32 + 8 * fq;
    const bool isK = (u.pn == 2) || (u.pn == 3);
    const bool hasK = isK || (u.pn == 11) || (u.pn == 12);
    float cs[2][8];
    float nmax[2] = {0.f, 0.f};
#pragma unroll
    for (int bj = 0; bj < 2; ++bj)
#pragma unroll
      for (int j = 0; j < 8; ++j) cs[bj][j] = 0.f;
#pragma unroll
    for (int ai = 0; ai < 2; ++ai)
#pragma unroll
      for (int m = 0; m < 4; ++m) {
        const int row = row0 + ai * HALF + m * 16;
        const float rs = rstd[row];
#pragma unroll
        for (int bj = 0; bj < 2; ++bj) {
          const int c = colb + bj * HALF;
          const f32x4 v0 = acc[ai][bj][m][0] * rs, v1 = acc[ai][bj][m][1] * rs;
          h8 o;
          o[0] = (_Float16)v0[0]; o[1] = (_Float16)v0[1]; o[2] = (_Float16)v0[2]; o[3] = (_Float16)v0[3];
          o[4] = (_Float16)v1[0]; o[5] = (_Float16)v1[1]; o[6] = (_Float16)v1[2]; o[7] = (_Float16)v1[3];
          *reinterpret_cast<h8*>(hm + ((size_t)(c >> 6) * T_ + row) * 64 + (c & 63)) = o;
          if (hasK) {
            float ss = (v0[0] * v0[0] + v0[1] * v0[1]) + (v0[2] * v0[2] + v0[3] * v0[3]) + (v1[0] * v1[0] + v1[1] * v1[1]) + (v1[2] * v1[2] + v1[3] * v1[3]);
            ss += __shfl_xor(ss, 16, 64); ss += __shfl_xor(ss, 32, 64);
            nmax[bj] = fmaxf(nmax[bj], ss);
          }
          if (isK) {
#pragma unroll
            for (int j = 0; j < 4; ++j) { cs[bj][j] += v0[j]; cs[bj][4 + j] += v1[j]; }
          }
        }
      }
    if (hasK)
#pragma unroll
    for (int bj = 0; bj < 2; ++bj) {
      float v = nmax[bj];
      v = fmaxf(v, __shfl_xor(v, 1, 64)); v = fmaxf(v, __shfl_xor(v, 2, 64)); v = fmaxf(v, __shfl_xor(v, 4, 64)); v = fmaxf(v, __shfl_xor(v, 8, 64));
      if ((fr | fq) == 0) {
        const int c = u.pn * BM + wc * 32 + bj * HALF;
        atomicMax(kn2 + ((size_t)(u.pm >> 4) * 60 + (c >> 6)) * 2 + (wc & 1), __float_as_uint(v));
      }
    }
    if (isK) {
#pragma unroll
      for (int bj = 0; bj < 2; ++bj)
#pragma unroll
        for (int j = 0; j < 8; ++j) {
          float v = cs[bj][j];
          v += __shfl_xor(v, 1, 64); v += __shfl_xor(v, 2, 64); v += __shfl_xor(v, 4, 64); v += __shfl_xor(v, 8, 64);
          cs[bj][j] = v;
        }
      if (fr == 0) {
        const int b = u.pm >> 4, blk = u.pm & 15;
#pragma unroll
        for (int bj = 0; bj < 2; ++bj) {
          const int c = colb + bj * HALF, h = (c >> 6) - SL_KA, d0 = c & 63;
          float* dst = kmp + ((((size_t)b * 8 + h) * 16 + blk) * 2 + wr) * 64 + d0;
          *reinterpret_cast<f32x4*>(dst) = (f32x4){cs[bj][0], cs[bj][1], cs[bj][2], cs[bj][3]};
          *reinterpret_cast<f32x4*>(dst + 4) = (f32x4){cs[bj][4], cs[bj][5], cs[bj][6], cs[bj][7]};
        }
      }
    }
  }
};
struct EpiY {
  static constexpr bool PERM = true;
  __half* y; float* ssq;
  __device__ __forceinline__ void operator()(const f32x4 (&acc)[2][2][4][2], const Unit& u, int wr, int wc, int fr, int fq) const {
    const int row0 = u.pm * BM + wr * 64 + fr;
    const int colb = u.pn * BM + wc * 32 + 8 * fq;
#pragma unroll
    for (int ai = 0; ai < 2; ++ai)
#pragma unroll
      for (int m = 0; m < 4; ++m) {
        const int row = row0 + ai * HALF + m * 16;
        float s = 0.f;
#pragma unroll
        for (int bj = 0; bj < 2; ++bj) {
          const f32x4 v0 = acc[ai][bj][m][0], v1 = acc[ai][bj][m][1];
          s += (v0[0] * v0[0] + v0[1] * v0[1]) + (v0[2] * v0[2] + v0[3] * v0[3]) + (v1[0] * v1[0] + v1[1] * v1[1]) + (v1[2] * v1[2] + v1[3] * v1[3]);
          h8 o;
          o[0] = (_Float16)(v0[0] * 64.f); o[1] = (_Float16)(v0[1] * 64.f); o[2] = (_Float16)(v0[2] * 64.f); o[3] = (_Float16)(v0[3] * 64.f);
          o[4] = (_Float16)(v1[0] * 64.f); o[5] = (_Float16)(v1[1] * 64.f); o[6] = (_Float16)(v1[2] * 64.f); o[7] = (_Float16)(v1[3] * 64.f);
          *reinterpret_cast<h8*>(y + (size_t)row * DM + colb + bj * HALF) = o;
        }
        s += __shfl_xor(s, 16, 64); s += __shfl_xor(s, 32, 64);
        if (fq == 0) atomicAdd(ssq + row, s);
      }
  }
};

__device__ __forceinline__ void phase_post(const P& p, int bid, int nblk) {
  const int tid = otid(), lane = tid & 63, wid = tid >> 6;
  const __half* y = p.hm();
  f32x4 gv[2][2];
#pragma unroll
  for (int j = 0; j < 2; ++j) {
    gv[j][0] = *reinterpret_cast<const f32x4*>(p.g_post + j * 512 + lane * 8);
    gv[j][1] = *reinterpret_cast<const f32x4*>(p.g_post + j * 512 + lane * 8 + 4);
  }
  const int stride = nblk * 8;
  for (int t = bid * 8 + wid; t < T_; t += 2 * stride) {
    const int t1 = t + stride;
    const bool has1 = t1 < T_;
    const float tot0 = __hip_atomic_load(p.ssq() + t, __ATOMIC_RELAXED, __HIP_MEMORY_SCOPE_AGENT);
    const float tot1 = has1 ? __hip_atomic_load(p.ssq() + t1, __ATOMIC_RELAXED, __HIP_MEMORY_SCOPE_AGENT) : 1.f;
    h8 xv[2][2], yv[2][2];
#pragma unroll
    for (int j = 0; j < 2; ++j) {
      const size_t off0 = (size_t)t * DM + j * 512 + lane * 8, off1 = (size_t)(has1 ? t1 : t) * DM + j * 512 + lane * 8;
      xv[0][j] = __builtin_nontemporal_load(reinterpret_cast<const h8*>(p.xh() + off0));
      yv[0][j] = __builtin_nontemporal_load(reinterpret_cast<const h8*>(y + off0));
      xv[1][j] = __builtin_nontemporal_load(reinterpret_cast<const h8*>(p.xh() + off1));
      yv[1][j] = __builtin_nontemporal_load(reinterpret_cast<const h8*>(y + off1));
    }
    const float r0 = rsqrtf(tot0 * (1.f / DM) + EPS) * (1.f / 64.f), r1 = rsqrtf(tot1 * (1.f / DM) + EPS) * (1.f / 64.f);
#pragma unroll
    for (int i = 0; i < 2; ++i) {
      if (i == 1 && !has1) break;
      const float r = i ? r1 : r0;
      const int tt = i ? t1 : t;
#pragma unroll
      for (int j = 0; j < 2; ++j) {
        const size_t off = (size_t)tt * DM + j * 512 + lane * 8;
        f32x4 o0, o1;
#pragma unroll
        for (int k = 0; k < 4; ++k) { o0[k] = (float)xv[i][j][k] + (float)yv[i][j][k] * r * gv[j][0][k]; o1[k] = (float)xv[i][j][4 + k] + (float)yv[i][j][4 + k] * r * gv[j][1][k]; }
        __builtin_nontemporal_store(o0, reinterpret_cast<f32x4*>(p.out + off));
        __builtin_nontemporal_store(o1, reinterpret_cast<f32x4*>(p.out + off + 4));
      }
    }
  }
}

template <class Epi>
__device__ __forceinline__ void gemm_phase(LAS unsigned char* lds, const __half* gA, const __half* gBt, int M, int N, int K, const StaticOrder& S, const Epi& E) {
  const int tid = otid(), wid = __builtin_amdgcn_readfirstlane(tid >> 6), lane = tid & 63, wr = wid >> 2, wc = wid & 3, fr = lane & 15, fq = lane >> 4;
  const int nt = K / BK;
  unsigned voffA[2], voffB[2];
#pragma unroll
  for (int i = 0; i < 2; ++i) { int R, C; stage_rc(tid * 16 + i * 8192, R, C); const int Rb = Epi::PERM ? ((R & ~31) + perm32(R & 31)) : R;
    voffA[i] = (unsigned)(R * K + C) * 2u; voffB[i] = (unsigned)(Rb * K + C) * 2u; }
  const size_t kstep = (size_t)(BK * 2);
  const size_t hstep = (size_t)HALF * K * 2;
  const size_t tstep = 2 * hstep;
  const unsigned ldsw = (unsigned)wid * 1024u;
  const int aoff = lds_byte(wr * 64 + fr, fq * 8), boff = lds_byte(wc * 32 + fr, fq * 8);
#define PG8_SA(b, h) (((b) * 2 + (h)) * HTB)
#define PG8_SB(b, h) ((4 + (b) * 2 + (h)) * HTB)
#define PG8_STAGE(bufoff, gbase, voff) do { _Pragma("unroll") for (int _i = 0; _i < 2; ++_i) \
    __builtin_amdgcn_global_load_lds((const unsigned*)((const char*)(gbase) + (voff)[_i]), (LAS unsigned*)(lds + (bufoff) + ldsw + _i * 8192), 16, 0, 0); } while (0)
#define PG8_LDA(dst, b, h) do { _Pragma("unroll") for (int m = 0; m < 4; ++m) _Pragma("unroll") for (int k = 0; k < 2; ++k) dst[m][k] = *(const LAS h8*)(lds + PG8_SA(b, h) + aoff + m * 2048 + k * 1024); } while (0)
#define PG8_LDB(dst, b, h) do { _Pragma("unroll") for (int n = 0; n < 2; ++n) _Pragma("unroll") for (int k = 0; k < 2; ++k) dst[n][k] = *(const LAS h8*)(lds + PG8_SB(b, h) + boff + n * 2048 + k * 1024); } while (0)
#define PG8_MMA(ai, bj, At, Bt) do { __builtin_amdgcn_s_setprio(1); _Pragma("unroll") for (int m = 0; m < 4; ++m) _Pragma("unroll") for (int n = 0; n < 2; ++n) _Pragma("unroll") for (int k = 0; k < 2; ++k) \
    acc[ai][bj][m][n] = __builtin_amdgcn_mfma_f32_16x16x32_f16(Bt[n][k], At[m][k], acc[ai][bj][m][n], 0, 0, 0); __builtin_amdgcn_s_setprio(0); } while (0)
#define PG8_WAIT_V(n) asm volatile("s_waitcnt vmcnt(" #n ")" ::: "memory")
#define PG8_WAIT_L(n) asm volatile("s_waitcnt lgkmcnt(" #n ")" ::: "memory")
#define PG8_BAR __builtin_amdgcn_s_barrier()
#define PG8_SCHED __builtin_amdgcn_sched_barrier(0)
  Unit cur, nxt; int ui = 0;
  if (!S.next(0, cur)) return;
  f32x4 acc[2][2][4][2];
#pragma unroll
  for (int a = 0; a < 2; ++a)
#pragma unroll
    for (int b = 0; b < 2; ++b)
#pragma unroll
      for (int m = 0; m < 4; ++m)
#pragma unroll
        for (int n = 0; n < 2; ++n) acc[a][b][m][n] = (f32x4){0.f, 0.f, 0.f, 0.f};
  h8 At[4][2], B0[2][2], B1[2][2];
  const char* cA = (const char*)gA + (size_t)cur.pm * tstep; const char* cB = (const char*)gBt + (size_t)cur.pn * tstep;
  PG8_STAGE(PG8_SB(0, 0), cB, voffB); PG8_STAGE(PG8_SA(0, 0), cA, voffA); PG8_STAGE(PG8_SB(0, 1), cB + hstep, voffB); PG8_STAGE(PG8_SA(0, 1), cA + hstep, voffA);
  if (wr == 1) PG8_BAR;
  PG8_WAIT_V(4); PG8_BAR;
  PG8_STAGE(PG8_SB(1, 0), cB + kstep, voffB); PG8_STAGE(PG8_SA(1, 0), cA + kstep, voffA); PG8_STAGE(PG8_SB(1, 1), cB + hstep + kstep, voffB);
  PG8_WAIT_V(6); PG8_BAR;
  for (;;) {
    const bool has_next = S.next(ui + 1, nxt);
    const char* nA = has_next ? (const char*)gA + (size_t)nxt.pm * tstep : cA; const char* nB = has_next ? (const char*)gBt + (size_t)nxt.pn * tstep : cB;
    for (int t = 0; t < nt; t += 2) {
      const bool last = (t == nt - 2);
      const char* a1 = cA + (size_t)(t + 1) * kstep;
      const char* a2 = last ? nA : cA + (size_t)(t + 2) * kstep; const char* b2 = last ? nB : cB + (size_t)(t + 2) * kstep;
      const char* a3 = a2 + kstep; const char* b3 = b2 + kstep;
      PG8_LDB(B0, 0, 0); PG8_SCHED; PG8_LDA(At, 0, 0); PG8_STAGE(PG8_SA(1, 1), a1 + hstep, voffA);
      PG8_WAIT_L(8); PG8_BAR; PG8_WAIT_L(0); PG8_MMA(0, 0, At, B0); PG8_BAR; PG8_SCHED;
      PG8_LDB(B1, 0, 1); PG8_STAGE(PG8_SB(0, 0), b2, voffB);
      PG8_BAR; PG8_WAIT_L(0); PG8_MMA(0, 1, At, B1); PG8_BAR;
      PG8_LDA(At, 0, 1); PG8_STAGE(PG8_SA(0, 0), a2, voffA);
      PG8_BAR; PG8_WAIT_L(0); PG8_MMA(1, 0, At, B0); PG8_BAR; PG8_SCHED;
      PG8_STAGE(PG8_SB(0, 1), b2 + hstep, voffB);
      PG8_WAIT_V(6); PG8_BAR; PG8_MMA(1, 1, At, B1); PG8_BAR;
      PG8_LDB(B0, 1, 0); PG8_SCHED; PG8_LDA(At, 1, 0); PG8_STAGE(PG8_SA(0, 1), a2 + hstep, voffA);
      PG8_WAIT_L(8); PG8_BAR; PG8_WAIT_L(0); PG8_MMA(0, 0, At, B0); PG8_BAR; PG8_SCHED;
      PG8_LDB(B1, 1, 1); PG8_STAGE(PG8_SB(1, 0), b3, voffB);
      PG8_BAR; PG8_WAIT_L(0); PG8_MMA(0, 1, At, B1); PG8_BAR;
      PG8_LDA(At, 1, 1); PG8_STAGE(PG8_SA(1, 0), a3, voffA);
      PG8_BAR; PG8_WAIT_L(0); PG8_MMA(1, 0, At, B0); PG8_BAR; PG8_SCHED;
      PG8_STAGE(PG8_SB(1, 1), b3 + hstep, voffB);
      PG8_WAIT_V(6); PG8_BAR; PG8_MMA(1, 1, At, B1); PG8_BAR;
    }
    E(acc, cur, wr, wc, fr, fq);
    if (!has_next) break;
#pragma unroll
    for (int a = 0; a < 2; ++a)
#pragma unroll
      for (int b = 0; b < 2; ++b)
#pragma unroll
        for (int m = 0; m < 4; ++m)
#pragma unroll
          for (int n = 0; n < 2; ++n) acc[a][b][m][n] = (f32x4){0.f, 0.f, 0.f, 0.f};
    cur = nxt; cA = nA; cB = nB; ++ui;
  }
  PG8_WAIT_V(0);
  if (wr == 0) PG8_BAR;
  PG8_BAR;
#undef PG8_SA
#undef PG8_SB
#undef PG8_STAGE
#undef PG8_LDA
#undef PG8_LDB
#undef PG8_MMA
#undef PG8_WAIT_V
#undef PG8_WAIT_L
#undef PG8_BAR
#undef PG8_SCHED
}

constexpr int AT_K = 0, AT_V = 24576, AT_WS = 49152, AT_KM = 51200, AT_OST = 55296, AT_FLG = AT_OST + 8 * 8192, AT_ORD = AT_FLG + 64, AT_QS = AT_ORD + 256, AT_Q = AT_QS + 64, AT_LDS = AT_Q + 8 * 4096;
constexpr float PRUNE = (PROBE == 12 || PROBE == 13) ? 1e30f : 40.f;
constexpr float LOG2E = 1.4426950408889634f;
constexpr float C2 = 0.125f * LOG2E;
constexpr float THR = (PROBE == 30) ? 0.f : 8.f;
enum { M_MOBA = 0, M_SLC = 1, M_WIN = 2 };
typedef short v4i16_t __attribute__((ext_vector_type(4)));

__device__ __forceinline__ int crow(int r, int hi) { return (r & 3) + 8 * (r >> 2) + 4 * hi; }
__device__ __forceinline__ void glds16(const void* g, LAS unsigned char* l) {
  __builtin_amdgcn_global_load_lds((const unsigned*)g, (LAS unsigned*)l, 16, 0, 0);
}
__device__ __forceinline__ h4 vtr(const LAS unsigned char* p) {
  return __builtin_bit_cast(h4, __builtin_amdgcn_ds_read_tr16_b64_v4i16((LAS v4i16_t*)p));
}
__device__ __forceinline__ void scale_rows(f32x16 (&o)[2], float f, LAS float* wsf, int r32, int hi) {
  if (hi == 0) wsf[r32] = f;
#pragma unroll
  for (int r = 0; r < 16; ++r) { const float a = wsf[crow(r, hi)]; o[0][r] *= a; o[1][r] *= a; }
}

#define SBAR() __builtin_amdgcn_sched_barrier(0)
#define PINV(x) asm volatile("" : "+v"(x))
#define MFMA32(a, b, c) __builtin_amdgcn_mfma_f32_32x32x16_f16((a), (b), (c), 0, 0, 0)
__device__ __forceinline__ h8 kfrag(const LAS unsigned char* kp, int f) { return *(const LAS h8*)(kp + (f >> 1) * 2048 + (f & 1) * 512); }
__device__ __forceinline__ h8 vfrag(const LAS unsigned char* vp, int f) {
  const LAS unsigned char* a = vp + (f & 1) * 4096 + (f >> 1) * 1024;
  const h4 lo = vtr(a), hv = vtr(a + 512);
  return __builtin_shufflevector(lo, hv, 0, 1, 2, 3, 4, 5, 6, 7);
}

__device__ __forceinline__ void glds16_asm(const void* g, unsigned lds_base) {
  unsigned sv;
  asm volatile("s_mov_b32 %0, m0\n\ts_mov_b32 m0, %2\n\ts_nop 0\n\tglobal_load_lds_dwordx4 %1, off\n\ts_mov_b32 m0, %0" : "=&s"(sv) : "v"(g), "s"(lds_base) : "memory");
}
#define WAIT_BAR(N) asm volatile("s_waitcnt vmcnt(" #N ") lgkmcnt(0)\n\ts_barrier" ::: "memory")

template <int MODE, bool HASPREV>
__device__ __forceinline__ void fstep(h8 (&pw)[4], f32x16 (&o)[2], const f32x16& bfix, const h8 (&qf)[4],
                                      h8 (&kf)[8], float& m, float& l, const LAS unsigned char* kpn,
                                      const LAS unsigned char* vpp, LAS float* wsf, LAS int* flgw, int kt, int q0, int tq, int tq_min, int tq_max,
                                      int hi, int r32, int lane, float slope2, unsigned long long rowmask, float ubc) {
  f32x16 C0, C1;
  h8 vf[8];
#pragma unroll
  for (int i = 0; i < 8; ++i) {
    if (HASPREV) vf[i] = vfrag(vpp, i);
    const int d0 = i >> 1;
    if (i & 1) C1 = MFMA32(kf[i], qf[d0], d0 == 0 ? bfix : C1);
    else       C0 = MFMA32(kf[i], qf[d0], d0 == 0 ? bfix : C0);
    SBAR();
  }
  const int k0 = kt * 64;
  const float bnd = ubc - slope2 * (float)max(tq - k0 - 63, 0);
  bool need = (k0 <= tq) && (bnd >= m - PRUNE);
  if (MODE == M_MOBA) need = need && (((unsigned)rowmask >> (kt >> 2)) & 1u);
  if (MODE == M_SLC) need = need && ((rowmask >> kt) & 1ull);
  if (MODE == M_WIN) need = need && (k0 + 63 >= tq - 511);
  const bool edge = (k0 + 63 > tq_min) || (MODE == M_WIN && k0 < tq_max - 511);
  if (edge) {
    const int rel = tq - k0 - 4 * hi;
#pragma unroll
    for (int r = 0; r < 16; ++r) {
      const int e0 = (r & 3) + 8 * (r >> 2), e1 = e0 + 32;
      bool ok0 = e0 <= rel, ok1 = e1 <= rel;
      if (MODE == M_WIN) { ok0 = ok0 && (e0 >= rel - 511); ok1 = ok1 && (e1 >= rel - 511); }
      C0[r] = ok0 ? C0[r] : -1e30f; C1[r] = ok1 ? C1[r] : -1e30f;
    }
  }
  const float off1 = 32.f * slope2;
  const float base_t = slope2 * (float)(k0 - q0);
  bool resc = false;
  if (__any(need && (bnd > m + THR))) {
    float mx0 = C0[0], mx1 = C1[0];
#pragma unroll
    for (int r = 1; r < 16; ++r) { mx0 = fmaxf(mx0, C0[r]); mx1 = fmaxf(mx1, C1[r]); }
    float mxs = fmaxf(mx0 * C2, __builtin_fmaf(mx1, C2, off1));
    { const auto rr = __builtin_amdgcn_permlane32_swap(__float_as_uint(mxs), __float_as_uint(mxs), false, false);
      mxs = fmaxf(__uint_as_float(rr[0]), __uint_as_float(rr[1])); }
    const float mt2 = need ? (mxs + base_t) : -1e30f;
    resc = __any(mt2 - m > THR);
    if (resc) {
      const float mn = fmaxf(m, mt2);
      const float alpha = __builtin_amdgcn_exp2f(m - mn);
      l *= alpha; m = mn;
      if (hi == 0) wsf[r32] = alpha;
    }
  }
  const float nm0 = need ? (base_t - m) : -INFINITY;
  const float nm1 = nm0 + off1;
  {
    const bool live_next = (ubc - slope2 * (float)max(tq - k0 + 1, 0)) >= m - PRUNE;
    const int a = __any(live_next) ? 1 : 0;
    if (lane == 0) *flgw = a;
  }
  SBAR();
  float sacc = 0.f;
  h8 pn[4];
#pragma unroll
  for (int i = 0; i < 8; ++i) {
    kf[i] = kfrag(kpn, i);
    if (HASPREV) {
      if (i & 1) o[1] = MFMA32(pw[i >> 1], vf[i], o[1]);
      else       o[0] = MFMA32(pw[i >> 1], vf[i], o[0]);
    }
    float e[4];
#pragma unroll
    for (int j = 0; j < 4; ++j)
      e[j] = (i < 4) ? __builtin_amdgcn_exp2f(__builtin_fmaf(C0[4 * i + j], C2, nm0)) : __builtin_amdgcn_exp2f(__builtin_fmaf(C1[4 * (i - 4) + j], C2, nm1));
    sacc += (e[0] + e[1]) + (e[2] + e[3]);
    pn[i >> 1][(i & 1) * 4 + 0] = (_Float16)e[0]; pn[i >> 1][(i & 1) * 4 + 1] = (_Float16)e[1];
    pn[i >> 1][(i & 1) * 4 + 2] = (_Float16)e[2]; pn[i >> 1][(i & 1) * 4 + 3] = (_Float16)e[3];
    PINV(sacc); PINV(pn[i >> 1]);
    SBAR();
  }
  l += sacc;
#pragma unroll
  for (int s = 0; s < 4; ++s) pw[s] = pn[s];
  if (HASPREV && resc) {
#pragma unroll
    for (int r = 0; r < 16; ++r) { const float a = wsf[crow(r, hi)]; o[0][r] *= a; o[1][r] *= a; }
  }
}

__device__ __forceinline__ void fdrain(const h8 (&pw)[4], f32x16 (&o)[2], const LAS unsigned char* vp) {
#pragma unroll
  for (int f = 0; f < 8; ++f) {
    const h8 v = vfrag(vp, f);
    if (f & 1) o[1] = MFMA32(pw[f >> 1], v, o[1]); else o[0] = MFMA32(pw[f >> 1], v, o[0]);
  }
}

template <int MODE>
__device__ __forceinline__ void flash_pipe(LAS unsigned char* lds, const __half* Kg, const __half* Vg, int q0, int kt_lo, int kt_hi,
                                           const f32x16& bfix, float slope2, unsigned long long rowmask, float ubc,
                                           f32x16 (&o)[2], float& l_tot) {
  const int tid = otid(), lane = tid & 63, r32 = lane & 31, hi = lane >> 5;
  const int wid = __builtin_amdgcn_readfirstlane(tid >> 6);
  const int tq = q0 + wid * 32 + r32, tq_min = q0 + wid * 32, tq_max = tq_min + 31;
  LAS float* wsf = (LAS float*)(lds + AT_WS) + wid * 64;
  LAS int* flg = (LAS int*)(lds + AT_FLG);
  const __half* ksrc = Kg + (size_t)lane * 64 + wid * 8;
  const __half* vsrc = Vg + (size_t)(16 * (wid & 3) + (lane >> 2)) * 64 + (wid >> 2) * 32 + (lane & 3) * 8;
  const unsigned kdst = (unsigned)(unsigned long)(lds + AT_K) + wid * 1024;
  const unsigned vdst = (unsigned)(unsigned long)(lds + AT_V) + wid * 1024;
  const LAS unsigned char* kp0 = lds + AT_K + hi * 1024 + r32 * 16;
  const LAS unsigned char* vp0 = lds + AT_V + ((lane >> 4) & 1) * 32 + (lane & 3) * 8 + (4 * hi + ((lane & 15) >> 2)) * 64;
  const LAS unsigned char* qp = lds + AT_Q + wid * 4096 + lane * 16;
  h8 qf[4];
#pragma unroll
  for (int d0 = 0; d0 < 4; ++d0) qf[d0] = *(const LAS h8*)(qp + d0 * 1024);
#pragma unroll
  for (int r = 0; r < 16; ++r) { o[0][r] = 0.f; o[1][r] = 0.f; }
  float m = -1e30f, l = 0.f;
  h8 kf[8], pw[4];
#define KT_(t) max(kt_hi - (t), kt_lo)
#define DMA_K(t, slot) glds16_asm(ksrc + (size_t)KT_(t) * 4096, (unsigned)__builtin_amdgcn_readfirstlane(kdst + (slot)))
#define DMA_V(t, slot) glds16_asm(vsrc + (size_t)KT_(t) * 4096, (unsigned)__builtin_amdgcn_readfirstlane(vdst + (slot)))
  asm volatile("s_waitcnt vmcnt(0)" ::: "memory");
  DMA_K(0, 0); DMA_K(1, 8192); DMA_K(2, 16384); DMA_V(0, 0);
  WAIT_BAR(2);
#pragma unroll
  for (int i = 0; i < 8; ++i) kf[i] = kfrag(kp0, i);
  WAIT_BAR(2);
  int t = 0, kt = kt_hi;
  int s0 = 0, s1 = 8192, s2 = 16384;
#define STEP_CLOSE(done) do { WAIT_BAR(2);     \
    { const LAS int* f_ = flg + (kt & 1) * 8; const int any_live = f_[0] | f_[1] | f_[2] | f_[3] | f_[4] | f_[5] | f_[6] | f_[7]; done = (!any_live) || (kt == kt_lo); } } while (0)
#define STEP_ROT() do { const int t_ = s0; s0 = s1; s1 = s2; s2 = t_; ++t; --kt; } while (0)
  bool done;
  DMA_K(3, s0); DMA_V(1, s1);
  fstep<MODE, false>(pw, o, bfix, qf, kf, m, l, kp0 + s1, vp0, wsf, flg + (kt & 1) * 8 + wid, kt, q0, tq, tq_min, tq_max, hi, r32, lane, slope2, rowmask, ubc);
  STEP_CLOSE(done);
  while (!done) {
    STEP_ROT();
    DMA_K(t + 3, s0); DMA_V(t + 1, s1);
    fstep<MODE, true>(pw, o, bfix, qf, kf, m, l, kp0 + s1, vp0 + s2  , wsf, flg + (kt & 1) * 8 + wid, kt, q0, tq, tq_min, tq_max, hi, r32, lane, slope2, rowmask, ubc);
    STEP_CLOSE(done);
  }
  fdrain(pw, o, vp0 + s0);
  asm volatile("s_waitcnt lgkmcnt(0)\n\ts_barrier" ::: "memory");
#undef KT_
#undef DMA_K
#undef DMA_V
#undef STEP_CLOSE
#undef STEP_ROT
  l_tot = l + __shfl_xor(l, 32, 64);
}

__device__ __forceinline__ float score_bound(const P& p, const h8 (&qf)[4], int b, int slot) {
  float ss = 0.f;
#pragma unroll
  for (int d0 = 0; d0 < 4; ++d0)
#pragma unroll
    for (int j = 0; j < 8; ++j) { const float v = (float)qf[d0][j]; ss += v * v; }
  ss += __shfl_xor(ss, 32, 64);
  const unsigned* kn = p.kn2() + ((size_t)b * 60 + slot) * 2;
  const float kmax = sqrtf(__uint_as_float(kn[0]) + __uint_as_float(kn[1])) * 1.002f;
  return C2 * sqrtf(ss) * kmax * 1.001f;
}

__device__ __forceinline__ void put_q(LAS unsigned char* lds, const h8 (&qf)[4], int wid, int lane) {
  LAS unsigned char* qp = lds + AT_Q + wid * 4096 + lane * 16;
#pragma unroll
  for (int d0 = 0; d0 < 4; ++d0) *(LAS h8*)(qp + d0 * 1024) = qf[d0];
}

__device__ __forceinline__ void moba_unit(const P& p, LAS unsigned char* lds, int b, int h, int own) {
  const int tid = otid(), lane = tid & 63, r32 = lane & 31, hi = lane >> 5;
  const int wid = __builtin_amdgcn_readfirstlane(tid >> 6);
  const int q0 = own * 256;
  const size_t bh = (size_t)b * 8 + h;
  LAS float* km = (LAS float*)(lds + AT_KM);
  for (int e = tid; e < own * 64; e += 512) {
    const int n = e >> 6, d = e & 63;
    const float* kp = p.kmp() + ((bh * 16 + n) * 2) * 64 + d;
    km[e] = (kp[0] + kp[64]) * (1.f / 256.f);
  }
  h8 qf[4];
  const __half* qrow = hmp(p, SL_QA + h, b, q0 + wid * 32 + r32);
#pragma unroll
  for (int d0 = 0; d0 < 4; ++d0) qf[d0] = *reinterpret_cast<const h8*>(qrow + d0 * 16 + hi * 8);
  __syncthreads();
  float g0 = -3e38f, g1 = -3e38f, g2 = -3e38f; int i0 = -1, i1 = -1, i2 = -1;
  for (int n = 0; n < own; ++n) {
    float s = 0.f;
#pragma unroll
    for (int d0 = 0; d0 < 4; ++d0)
#pragma unroll
      for (int j = 0; j < 8; ++j) s += (float)qf[d0][j] * km[n * 64 + d0 * 16 + hi * 8 + j];
    s += __shfl_xor(s, 32, 64);
    if (s > g0) { g2 = g1; i2 = i1; g1 = g0; i1 = i0; g0 = s; i0 = n; }
    else if (s > g1) { g2 = g1; i2 = i1; g1 = s; i1 = n; }
    else if (s > g2) { g2 = s; i2 = n; }
  }
  unsigned long long rowmask = 1ull << own;
  if (i0 >= 0) rowmask |= 1ull << i0;
  if (i1 >= 0) rowmask |= 1ull << i1;
  if (i2 >= 0) rowmask |= 1ull << i2;
  const float slope = exp2f(-(float)(h + 1));
  const float slope2 = slope * LOG2E;
  f32x16 bfix;
  {
    const float sb = slope * 8.f;
    const int qrel = wid * 32 + r32;
#pragma unroll
    for (int r = 0; r < 16; ++r) bfix[r] = sb * (float)((r & 3) + 8 * (r >> 2) + 4 * hi - qrel);
  }
  f32x16 o[2]; float l_tot;
  const float ubc = score_bound(p, qf, b, SL_KA + h);
  put_q(lds, qf, wid, lane);
  flash_pipe<M_MOBA>(lds, hmp(p, SL_KA + h, b, 0), hmp(p, SL_VA + h, b, 0), q0, 0, 4 * own + 3, bfix, slope2, rowmask, ubc, o, l_tot);
  if (PROBE == 11 || PROBE == 13) flash_pipe<M_MOBA>(lds, hmp(p, SL_KA + h, b, 0), hmp(p, SL_VA + h, b, 0), q0, 0, 4 * own + 3, bfix, slope2, rowmask, ubc, o, l_tot);
  LAS float* wsf = (LAS float*)(lds + AT_WS) + wid * 64;
  scale_rows(o, 1.f / fmaxf(l_tot, 1e-30f), wsf, r32, hi);
  LAS _Float16* stg = (LAS _Float16*)(lds + AT_OST + wid * 4096);
#pragma unroll
  for (int r = 0; r < 16; ++r) {
    const int orow = crow(r, hi);
    stg[orow * 64 + r32] = (_Float16)o[0][r];
    stg[orow * 64 + 32 + r32] = (_Float16)o[1][r];
  }
  const int t3 = otid(), lane3 = t3 & 63, wid3 = t3 >> 6;
#pragma unroll
  for (int i = 0; i < 4; ++i) {
    const int row = i * 8 + (lane3 >> 3), ch = lane3 & 7;
    const h8 v = *(const LAS h8*)(stg + row * 64 + ch * 8);
    const int t = q0 + wid3 * 32 + row;
    const h8 z = *reinterpret_cast<const h8*>(hmp(p, SL_ZA + h, b, t) + ch * 8);
    h8 ov;
#pragma unroll
    for (int j = 0; j < 8; ++j) ov[j] = (_Float16)((float)v[j] * silu((float)z[j]));
    *reinterpret_cast<h8*>(p.cat() + ((size_t)b * S_ + t) * DM + h * 64 + ch * 8) = ov;
  }
  __syncthreads();
}

__device__ __forceinline__ void nsa_unit(const P& p, LAS unsigned char* lds, int b, int h, int qblk) {
  const int tid = otid(), lane = tid & 63, r32 = lane & 31, hi = lane >> 5;
  const int wid = __builtin_amdgcn_readfirstlane(tid >> 6);
  const int q0 = qblk * 256, g = h >> 2;
  const int tq = q0 + wid * 32 + r32;
  h8 qf[4];
  const __half* qrow = hmp(p, SL_QB + h, b, tq);
#pragma unroll
  for (int d0 = 0; d0 < 4; ++d0) qf[d0] = *reinterpret_cast<const h8*>(qrow + d0 * 16 + hi * 8);
  const unsigned long long rowmask = p.sel()[((size_t)b * 2 + g) * S_ + tq];
  const float slope = exp2f(-(float)(h + 1));
  const float slope2 = slope * LOG2E;
  f32x16 bfix;
  {
    const float sb = slope * 8.f;
    const int qrel = wid * 32 + r32;
#pragma unroll
    for (int r = 0; r < 16; ++r) bfix[r] = sb * (float)((r & 3) + 8 * (r >> 2) + 4 * hi - qrel);
  }
  LAS float* wsf = (LAS float*)(lds + AT_WS) + wid * 64;
  f32x16 o[2]; float l_tot;
  LAS float* st32 = (LAS float*)(lds + AT_OST + wid * 8192);
  const float ubc_s = score_bound(p, qf, b, SL_KV6 + 4 + g), ubc_w = score_bound(p, qf, b, SL_KV6 + 8 + g);
  put_q(lds, qf, wid, lane);
  flash_pipe<M_SLC>(lds, hmp(p, SL_KV6 + 4 + g, b, 0), hmp(p, SL_KV6 + 6 + g, b, 0), q0, 0, 4 * qblk + 3, bfix, slope2, rowmask, ubc_s, o, l_tot);
  if (PROBE == 11 || PROBE == 13) flash_pipe<M_SLC>(lds, hmp(p, SL_KV6 + 4 + g, b, 0), hmp(p, SL_KV6 + 6 + g, b, 0), q0, 0, 4 * qblk + 3, bfix, slope2, rowmask, ubc_s, o, l_tot);
  {
    const int t2 = otid(), tq2 = q0 + (t2 >> 6) * 32 + (t2 & 31);
    const float g1 = p.gate()[((size_t)b * S_ + tq2) * 24 + h * 3 + 1];
    scale_rows(o, g1 / fmaxf(l_tot, 1e-30f), wsf, r32, hi);
  }
#pragma unroll
  for (int r = 0; r < 16; ++r) { const int orow = crow(r, hi); st32[orow * 64 + r32] = o[0][r]; st32[orow * 64 + 32 + r32] = o[1][r]; }
  const int wlo = qblk >= 2 ? 4 * qblk - 8 : 0;
  flash_pipe<M_WIN>(lds, hmp(p, SL_KV6 + 8 + g, b, 0), hmp(p, SL_KV6 + 10 + g, b, 0), q0, wlo, 4 * qblk + 3, bfix, slope2, 0ull, ubc_w, o, l_tot);
  if (PROBE == 11 || PROBE == 13) flash_pipe<M_WIN>(lds, hmp(p, SL_KV6 + 8 + g, b, 0), hmp(p, SL_KV6 + 10 + g, b, 0), q0, wlo, 4 * qblk + 3, bfix, slope2, 0ull, ubc_w, o, l_tot);
  {
    const int t2 = otid(), tq2 = q0 + (t2 >> 6) * 32 + (t2 & 31);
    const float g2 = p.gate()[((size_t)b * S_ + tq2) * 24 + h * 3 + 2];
    scale_rows(o, g2 / fmaxf(l_tot, 1e-30f), wsf, r32, hi);
  }
  LAS _Float16* stg = (LAS _Float16*)(lds + AT_OST + wid * 8192);
  {
    float tmp0[16], tmp1[16];
#pragma unroll
    for (int r = 0; r < 16; ++r) { const int orow = crow(r, hi); tmp0[r] = st32[orow * 64 + r32] + o[0][r]; tmp1[r] = st32[orow * 64 + 32 + r32] + o[1][r]; }
    __builtin_amdgcn_wave_barrier();
#pragma unroll
    for (int r = 0; r < 16; ++r) { const int orow = crow(r, hi); stg[orow * 64 + r32] = (_Float16)tmp0[r]; stg[orow * 64 + 32 + r32] = (_Float16)tmp1[r]; }
  }
  const int t3 = otid(), lane3 = t3 & 63, wid3 = t3 >> 6;
#pragma unroll
  for (int i = 0; i < 4; ++i) {
    const int row = i * 8 + (lane3 >> 3), ch = lane3 & 7;
    const h8 v = *(const LAS h8*)(stg + row * 64 + ch * 8);
    const int t = q0 + wid3 * 32 + row;
    const h8 z = *reinterpret_cast<const h8*>(hmp(p, SL_ZB + h, b, t) + ch * 8);
    const float g0 = p.gate()[((size_t)b * S_ + t) * 24 + h * 3];
    const h8 oc = *reinterpret_cast<const h8*>(p.ocmph() + (((size_t)b * 8 + h) * S_ + t) * 64 + ch * 8);
    h8 ov;
#pragma unroll
    for (int j = 0; j < 8; ++j) ov[j] = (_Float16)(((float)v[j] + g0 * (float)oc[j]) * silu((float)z[j]));
    *reinterpret_cast<h8*>(p.cat() + ((size_t)b * S_ + t) * DM + 512 + h * 64 + ch * 8) = ov;
  }
  __syncthreads();
}


constexpr int CM_HID = 0;
constexpr int CM_X = 9216;
__device__ __forceinline__ void cm_unit(const P& p, LAS unsigned char* lds, int which, int b, int g, int mt) {
  const int tid = otid(), lane = tid & 63, r = lane & 15, q = lane >> 4;
  const int wid = __builtin_amdgcn_readfirstlane(tid >> 6);
  const int c0 = mt * 32;
  const __half* xs = hmp(p, SL_KV6 + 2 * which + g, b, 0) + (size_t)c0 * 1024;
  for (int pc = wid; pc < 66; pc += 8) glds16(xs + (size_t)pc * 512 + lane * 8, lds + CM_X + pc * 1040);
  const __half* bp = p.w1t() + ((size_t)which * 128 + wid * 16 + r) * 2048 + q * 8;
  const __half* pp = p.peh() + which * 2048 + q * 8;
  asm volatile("s_waitcnt vmcnt(0)" ::: "memory");
  __syncthreads();
  f32x4 acc0 = {0.f, 0.f, 0.f, 0.f}, acc1 = {0.f, 0.f, 0.f, 0.f};
  const LAS unsigned char* a0l = lds + CM_X + (2 * r) * 1040 + q * 16;
  const LAS unsigned char* a1l = lds + CM_X + (2 * (16 + r)) * 1040 + q * 16;
#pragma unroll 8
  for (int s = 0; s < 64; ++s) {
    const int off = (s >> 4) * 1040 + ((s >> 1) & 7) * 128 + (s & 1) * 64;
    const h8 pe = *reinterpret_cast<const h8*>(pp + s * 32);
    const h8 a0 = *(const LAS h8*)(a0l + off) + pe;
    const h8 a1 = *(const LAS h8*)(a1l + off) + pe;
    const h8 bf = *reinterpret_cast<const h8*>(bp + s * 32);
    acc0 = __builtin_amdgcn_mfma_f32_16x16x32_f16(a0, bf, acc0, 0, 0, 0);
    acc1 = __builtin_amdgcn_mfma_f32_16x16x32_f16(a1, bf, acc1, 0, 0, 0);
  }
  LAS _Float16* hid = (LAS _Float16*)(lds + CM_HID);
#pragma unroll
  for (int reg = 0; reg < 4; ++reg) {
    hid[(4 * q + reg) * 136 + wid * 16 + r] = (_Float16)silu(acc0[reg]);
    hid[(16 + 4 * q + reg) * 136 + wid * 16 + r] = (_Float16)silu(acc1[reg]);
  }
  __syncthreads();
  {
    const int mi = wid >> 2, ni = wid & 3;
    const __half* w2p = p.w2t() + ((size_t)which * 64 + ni * 16 + r) * 128 + q * 8;
    f32x4 acc = {0.f, 0.f, 0.f, 0.f};
#pragma unroll
    for (int s = 0; s < 4; ++s) {
      const h8 a = *(const LAS h8*)(hid + (mi * 16 + r) * 136 + s * 32 + q * 8);
      const h8 bf = *reinterpret_cast<const h8*>(w2p + s * 32);
      acc = __builtin_amdgcn_mfma_f32_16x16x32_f16(a, bf, acc, 0, 0, 0);
    }
    __half* dst = (which ? p.vch() : p.kch()) + ((size_t)b * 2 + g) * 256 * 64;
#pragma unroll
    for (int reg = 0; reg < 4; ++reg) {
      const int c = c0 + mi * 16 + 4 * q + reg;
      dst[(size_t)c * 64 + ni * 16 + r] = __float2half(c < 255 ? acc[reg] : 0.f);
    }
  }
  __syncthreads();
}

constexpr int CS_K = 0, CS_V = 32768, CS_SLAB = 65536, CS_SLAB_BYTES = 8 * 32 * 65 * 4, CS_WS = CS_SLAB + CS_SLAB_BYTES, CS_LDS = CS_WS + 2048;
__device__ __forceinline__ void cs_super(const P& p, LAS unsigned char* lds, int b, int g, int j) {
  const int tid = otid(), lane = tid & 63, r32 = lane & 31, hi = lane >> 5;
  const int wid = __builtin_amdgcn_readfirstlane(tid >> 6);
  const int hh = wid & 3, qi = wid >> 2, h = g * 4 + hh;
  const size_t bg = (size_t)b * 2 + g;
  {
    const __half* ksrc = p.kch() + bg * 256 * 64 + (size_t)lane * 64 + wid * 8;
    const __half* vsrc = p.vch() + bg * 256 * 64 + (size_t)(16 * (wid & 3) + (lane >> 2)) * 64 + (wid >> 2) * 32 + (lane & 3) * 8;
    for (int kt = 0; kt < 4; ++kt) {
      glds16(ksrc + (size_t)kt * 4096, lds + CS_K + kt * 8192 + wid * 1024);
      glds16(vsrc + (size_t)kt * 4096, lds + CS_V + kt * 8192 + wid * 1024);
    }
  }
  asm volatile("s_waitcnt vmcnt(0)" ::: "memory");
  __syncthreads();
  for (int oi = 0; oi < 4; ++oi) {
  const int own = oi == 0 ? j : oi == 1 ? 31 - j : oi == 2 ? 32 + j : 63 - j;
  const int q0 = own * 64;
  const int ntile = (4 * own + 66) >> 6;
  const int tq = q0 + qi * 32 + r32;
  const int ncv = tq >= 31 ? ((tq - 31) >> 4) + 1 : 0;
  h8 qf[4];
  const __half* qrow = hmp(p, SL_QB + h, b, tq);
#pragma unroll
  for (int d0 = 0; d0 < 4; ++d0) qf[d0] = *reinterpret_cast<const h8*>(qrow + d0 * 16 + hi * 8);
  const LAS unsigned char* kp0 = lds + CS_K + hi * 1024 + r32 * 16;
  const LAS unsigned char* vp0 = lds + CS_V + ((lane >> 4) & 1) * 32 + (lane & 3) * 8 + (4 * hi + ((lane & 15) >> 2)) * 64;
  const f32x16 zero16 = {0.f, 0.f, 0.f, 0.f, 0.f, 0.f, 0.f, 0.f, 0.f, 0.f, 0.f, 0.f, 0.f, 0.f, 0.f, 0.f};
  float m = -1e30f, l = 0.f;
  for (int kt = 0; kt < ntile; ++kt) {
    const LAS unsigned char* kp = kp0 + kt * 8192;
    f32x16 p0 = zero16, p1 = zero16;
#pragma unroll
    for (int d0 = 0; d0 < 4; ++d0) {
      const h8 k0f = *(const LAS h8*)(kp + d0 * 2048), k1f = *(const LAS h8*)(kp + d0 * 2048 + 512);
      p0 = __builtin_amdgcn_mfma_f32_32x32x16_f16(k0f, qf[d0], p0, 0, 0, 0);
      p1 = __builtin_amdgcn_mfma_f32_32x32x16_f16(k1f, qf[d0], p1, 0, 0, 0);
    }
    const int rel = ncv - 1 - 64 * kt - 4 * hi;
    float mx = -1e30f;
#pragma unroll
    for (int r = 0; r < 16; ++r) {
      const int e0 = (r & 3) + 8 * (r >> 2);
      p0[r] = e0 <= rel ? p0[r] : -1e30f; p1[r] = e0 + 32 <= rel ? p1[r] : -1e30f;
      mx = fmaxf(mx, fmaxf(p0[r], p1[r]));
    }
    mx = fmaxf(mx, __shfl_xor(mx, 32, 64));
    const float mn = fmaxf(m, mx * C2);
    float ls = 0.f;
#pragma unroll
    for (int r = 0; r < 16; ++r) ls += __builtin_amdgcn_exp2f(__builtin_fmaf(p0[r], C2, -mn)) + __builtin_amdgcn_exp2f(__builtin_fmaf(p1[r], C2, -mn));
    l = l * __builtin_amdgcn_exp2f(m - mn) + ls;
    m = mn;
  }
  float l_tot = l + __shfl_xor(l, 32, 64);
  const float inv = ncv > 0 ? 1.f / fmaxf(l_tot, 1e-30f) : 0.f;
  const float nm = ncv > 0 ? -m : -INFINITY;
  f32x16 o[2]; o[0] = zero16; o[1] = zero16;
  LAS float* slab = (LAS float*)(lds + CS_SLAB) + ((qi * 4 + hh) * 32 + r32) * 65;
  float carry = 0.f;
  for (int kt = 0; kt < ntile; ++kt) {
    const LAS unsigned char* kp = kp0 + kt * 8192;
    const LAS unsigned char* vp = vp0 + kt * 8192;
    f32x16 p0 = zero16, p1 = zero16;
#pragma unroll
    for (int d0 = 0; d0 < 4; ++d0) {
      const h8 k0f = *(const LAS h8*)(kp + d0 * 2048), k1f = *(const LAS h8*)(kp + d0 * 2048 + 512);
      p0 = __builtin_amdgcn_mfma_f32_32x32x16_f16(k0f, qf[d0], p0, 0, 0, 0);
      p1 = __builtin_amdgcn_mfma_f32_32x32x16_f16(k1f, qf[d0], p1, 0, 0, 0);
    }
    const int rel = ncv - 1 - 64 * kt - 4 * hi;
#pragma unroll
    for (int r = 0; r < 16; ++r) {
      const int e0 = (r & 3) + 8 * (r >> 2);
      const float a0 = e0 <= rel ? p0[r] : -1e30f, a1 = e0 + 32 <= rel ? p1[r] : -1e30f;
      p0[r] = __builtin_amdgcn_exp2f(__builtin_fmaf(a0, C2, nm)) * inv;
      p1[r] = __builtin_amdgcn_exp2f(__builtin_fmaf(a1, C2, nm)) * inv;
    }
#pragma unroll
    for (int n = 0; n < 2; ++n) {
#pragma unroll
      for (int rg = 0; rg < 4; ++rg) {
        const float t3 = n == 0 ? p0[4 * rg + 3] : p1[4 * rg + 3];
        const float gs = n == 0 ? (p0[4 * rg] + p0[4 * rg + 1]) + (p0[4 * rg + 2] + t3) : (p1[4 * rg] + p1[4 * rg + 1]) + (p1[4 * rg + 2] + t3);
        const float tp = __shfl_xor(t3, 32, 64);
        slab[2 * (8 * kt + 4 * n + rg) + hi] = gs + (hi ? tp : carry);
        carry = tp;
      }
    }
    h8 pa[4];
#pragma unroll
    for (int j = 0; j < 8; ++j) { pa[0][j] = (_Float16)p0[j]; pa[1][j] = (_Float16)p0[8 + j]; pa[2][j] = (_Float16)p1[j]; pa[3][j] = (_Float16)p1[8 + j]; }
#pragma unroll
    for (int s = 0; s < 4; ++s) {
#pragma unroll
      for (int dh = 0; dh < 2; ++dh) {
        const h4 lo = vtr(vp + dh * 4096 + s * 1024), hv = vtr(vp + dh * 4096 + s * 1024 + 512);
        const h8 vf = __builtin_shufflevector(lo, hv, 0, 1, 2, 3, 4, 5, 6, 7);
        o[dh] = __builtin_amdgcn_mfma_f32_32x32x16_f16(pa[s], vf, o[dh], 0, 0, 0);
      }
    }
  }
  __syncthreads();
  if (own < 16) {
    if (tid < 64) p.sel()[bg * S_ + q0 + tid] = (2ull << own) - 1ull;
  } else {
    const LAS float* sl = (const LAS float*)(lds + CS_SLAB);
    const int jj = lane;
    const bool cand = (jj >= 1) && (jj <= own - 2);
    const unsigned long long forced = 1ull | (1ull << own) | (1ull << (own - 1));
    for (int i = 0; i < 8; ++i) {
      const int qq = wid * 8 + i, q2 = qq >> 5, rr = qq & 31;
      float v = 0.f;
#pragma unroll
      for (int x = 0; x < 4; ++x) v += sl[((q2 * 4 + x) * 32 + rr) * 65 + jj];
      const unsigned key = cand ? (__float_as_uint(v) + 1u) : 0u;
      unsigned th = 0u;
#pragma unroll
      for (int bit = 30; bit >= 0; --bit) {
        const unsigned c = th | (1u << bit);
        const int cnt = __popcll(__ballot(key >= c));
        th = cnt >= 13 ? c : th;
      }
      const unsigned long long gt = __ballot(key > th), eq = __ballot(key == th);
      const int need = 13 - __popcll(gt);
      unsigned long long t = eq;
      for (int k = 0; k < need; ++k) t &= t - 1ull;
      const unsigned long long msk = gt | (eq ^ t) | forced;
      if (lane == 0) p.sel()[bg * S_ + q0 + qq] = msk;
    }
  }
  __syncthreads();
  {
    LAS _Float16* stg = (LAS _Float16*)(lds + CS_SLAB + wid * 4096);
#pragma unroll
    for (int r = 0; r < 16; ++r) {
      const int orow = crow(r, hi);
      stg[orow * 64 + r32] = (_Float16)o[0][r];
      stg[orow * 64 + 32 + r32] = (_Float16)o[1][r];
    }
#pragma unroll
    for (int i = 0; i < 4; ++i) {
      const int row = i * 8 + (lane >> 3), ch = lane & 7;
      const h8 v = *(const LAS h8*)(stg + row * 64 + ch * 8);
      const int t = q0 + qi * 32 + row;
      *reinterpret_cast<h8*>(p.ocmph() + (((size_t)b * 8 + h) * S_ + t) * 64 + ch * 8) = v;
    }
  }
  __syncthreads();
  }
}

#define XB_TMO      128
#define XB_XCNT(j)  (256  + 64 * (j))
#define XB_XSUB(j)  (1280 + 64 * (j))
#define XB_XGEN(j)  (2304 + 64 * (j))
#define XB_TOP      3328
#define XB_TOPGEN   3392
#define XCD_BAR_WORDS 3456
#define XB_SPIN_CAP (1u << 18)
__device__ __forceinline__ unsigned xb_ld(unsigned* p) { return __hip_atomic_load(p, __ATOMIC_RELAXED, __HIP_MEMORY_SCOPE_AGENT); }
__device__ __forceinline__ unsigned xb_add(unsigned* p, unsigned v) { return __hip_atomic_fetch_add(p, v, __ATOMIC_RELAXED, __HIP_MEMORY_SCOPE_AGENT); }
__device__ __forceinline__ unsigned xb_xcc_id() { return (unsigned)__builtin_amdgcn_s_getreg((3 << 11) | 20) & 0xFu; }
#define XB_SPIN(cond, bar) do { unsigned _sp = 0; while (cond) { __builtin_amdgcn_s_sleep(1); \
    if ((++_sp & 255u) == 0u) { if (xb_ld(&(bar)[XB_TMO])) break; if (_sp > XB_SPIN_CAP) { atomicAdd(&(bar)[XB_TMO], 1u); break; } } } } while (0)
struct XcdBarrier { unsigned* bar; unsigned x; volatile LAS unsigned* st; };
__device__ __forceinline__ XcdBarrier xcd_barrier_post(unsigned* bar, volatile LAS unsigned* st) {
  XcdBarrier b; b.bar = bar; b.x = xb_xcc_id(); b.st = st;
  if (threadIdx.x == 0) (void)xb_add(&bar[XB_XCNT(b.x)], 1u);
  return b;
}
__device__ __forceinline__ void xcd_barrier_complete(unsigned* bar, unsigned x, unsigned& nloc, unsigned& nx) {
  const unsigned G = gridDim.x * gridDim.y * gridDim.z;
  unsigned sum, cnt, mine, sp = 0u;
  for (;;) {
    sum = 0u; cnt = 0u; mine = 0u;
#pragma unroll
    for (unsigned j = 0; j < 16; ++j) { const unsigned c = xb_ld(&bar[XB_XCNT(j)]); sum += c; cnt += (c > 0u) ? 1u : 0u; mine = (j == x) ? c : mine; }
    if (sum == G) break;
    __builtin_amdgcn_s_sleep(1);
    if ((++sp & 255u) == 0u) { if (xb_ld(&bar[XB_TMO])) break; if (sp > XB_SPIN_CAP) { atomicAdd(&bar[XB_TMO], 1u); break; } }
  }
  nloc = mine > 0u ? mine : 1u; nx = cnt > 0u ? cnt : 1u;
}
__device__ __forceinline__ void xcd_barrier(const XcdBarrier& b) {
  asm volatile("s_waitcnt vmcnt(0)" ::: "memory");
  __syncthreads();
  if (threadIdx.x == 0) {
    unsigned* bar = b.bar;
    __builtin_amdgcn_s_waitcnt(0);
    unsigned nloc = b.st[0], nx = b.st[1];
    if (nloc == 0u) { xcd_barrier_complete(bar, b.x, nloc, nx); b.st[0] = nloc; b.st[1] = nx; }
    const unsigned old = xb_add(&bar[XB_XSUB(b.x)], 1u);
    const unsigned gen = old / nloc;
    if (old + 1u == (gen + 1u) * nloc) {
      __builtin_amdgcn_fence(__ATOMIC_RELEASE, "agent");
      asm volatile("s_waitcnt vmcnt(0)" ::: "memory");
      const unsigned og = xb_add(&bar[XB_TOP], 1u);
      const unsigned tg = og / nx;
      if (og + 1u == (tg + 1u) * nx) xb_add(&bar[XB_TOPGEN], 1u);
      else XB_SPIN(xb_ld(&bar[XB_TOPGEN]) == tg, bar);
      __builtin_amdgcn_fence(__ATOMIC_ACQUIRE, "agent");
      xb_add(&bar[XB_XGEN(b.x)], 1u);
      asm volatile("s_waitcnt vmcnt(0)" ::: "memory");
    } else {
      XB_SPIN(xb_ld(&bar[XB_XGEN(b.x)]) == gen, bar);
      __builtin_amdgcn_fence(__ATOMIC_ACQUIRE, "agent");
      asm volatile("s_waitcnt vmcnt(0)" ::: "memory");
    }
  }
  __syncthreads();
}

__device__ __forceinline__ int cap_tiles(int h) { return h == 0 ? 6 : h == 1 ? 7 : h == 2 ? 10 : h == 3 ? 15 : h == 4 ? 26 : h == 5 ? 48 : 64; }
__device__ __forceinline__ int unit_cost(int mode, int pi) {
  const int h = pi >> 4, blk = pi & 15, cap = cap_tiles(h);
  const int full = 4 * (blk + 1);
  if (mode == 0) return min(full, cap);
  return min(full, cap) + min(min(full, 12), cap) + 2;
}
__device__ __forceinline__ void build_order(LAS unsigned char* lds, int mode) {
  LAS short* ord = (LAS short*)(lds + AT_ORD);
  const int i = threadIdx.x;
  if (i < 128) {
    const int ci = unit_cost(mode, i);
    int rank = 0;
    for (int j = 0; j < 128; ++j) { const int cj = unit_cost(mode, j); rank += (cj > ci) || (cj == ci && j < i); }
    ord[rank] = (short)i;
  }
  __syncthreads();
}
__device__ __forceinline__ int queue_next(unsigned* ctr, LAS unsigned char* lds) {
  LAS int* slot = (LAS int*)(lds + AT_QS);
  if (threadIdx.x == 0) *slot = (int)atomicAdd(ctr, 1u);
  __syncthreads();
  const int v = *slot;
  __syncthreads();
  return v;
}
constexpr int XB_ST_OFF = (CS_LDS > STAGE_BYTES ? CS_LDS : STAGE_BYTES) > AT_LDS ? (CS_LDS > STAGE_BYTES ? CS_LDS : STAGE_BYTES) : AT_LDS;
constexpr int MEGA_LDS = XB_ST_OFF + 16;

__global__ __launch_bounds__(512, 2) void mega(P p) {
  extern __shared__ __attribute__((aligned(16))) unsigned char shm[];
  LAS unsigned char* lds = (LAS unsigned char*)shm;
  const int bid = blockIdx.x, nblk = gridDim.x;
  if (threadIdx.x < 4) ((LAS unsigned*)(lds + XB_ST_OFF))[threadIdx.x] = 0u;
  __syncthreads();
  const XcdBarrier xb = xcd_barrier_post(p.xbar(), (volatile LAS unsigned*)(lds + XB_ST_OFF));
  for (int rep = 0; rep < (PROBE == 10 ? 2 : 1); ++rep) phase_prep(p, lds, bid, nblk);
  xcd_barrier(xb);
  if (PROBE == 9) { for (int i = 0; i < 6; ++i) xcd_barrier(xb); }
  {
    StaticOrder S; S.init(T_, NP - 256, nblk, bid, PROBE == 1 ? 2 : PROBE == 21 ? 3 : 1);
    EpiProj E{p.hm(), p.rstd(), p.kmp(), p.kn2(), 0};
    gemm_phase<EpiProj>(lds, p.xh(), p.wt(), T_, NP - 256, DM, S, E);
  }
  xcd_barrier(xb);
  if (nblk >= 256) {
    if (bid < 128) {
      StaticOrder S; S.init(T_, 256, 128, bid, 1);
      EpiProj E{p.hm(), p.rstd(), p.kmp(), p.kn2(), 14};
      gemm_phase<EpiProj>(lds, p.xh(), p.wt() + (size_t)14 * 256 * DM, T_, 256, DM, S, E);
    } else if (bid < 256) {
      for (int u = (bid - 128) * 2; u < (bid - 128) * 2 + 2; ++u) cm_unit(p, lds, u >> 7, (u >> 4) & 7, (u >> 3) & 1, u & 7);
    }
  } else {
    { StaticOrder S; S.init(T_, 256, nblk, bid, 1);
      EpiProj E{p.hm(), p.rstd(), p.kmp(), p.kn2(), 14};
      gemm_phase<EpiProj>(lds, p.xh(), p.wt() + (size_t)14 * 256 * DM, T_, 256, DM, S, E); }
    for (int u = bid; u < 2 * 8 * 2 * 8; u += nblk) cm_unit(p, lds, u >> 7, (u >> 4) & 7, (u >> 3) & 1, u & 7);
  }
  for (int rep = 0; rep < (PROBE == 3 ? 2 : PROBE == 23 ? 3 : 1); ++rep) {
    build_order(lds, 0);
    for (;;) {
      const int u = queue_next(p.qctr() + 0 + 2 * rep, lds);
      if (u >= 8 * 8 * 16) break;
      const int pi = ((const LAS short*)(lds + AT_ORD))[u >> 3];
      moba_unit(p, lds, u & 7, pi >> 4, pi & 15);
    }
  }
  xcd_barrier(xb);
  for (int rep = 0; rep < (PROBE == 4 ? 2 : 1); ++rep)
    for (int su = bid; su < 256; su += nblk) cs_super(p, lds, (su & 15) >> 1, su & 1, su >> 4);
  xcd_barrier(xb);
  for (int rep = 0; rep < (PROBE == 5 ? 2 : PROBE == 25 ? 3 : 1); ++rep) {
    build_order(lds, 1);
    for (;;) {
      const int u = queue_next(p.qctr() + 1 + 2 * rep, lds);
      if (u >= 8 * 8 * 16) break;
      const int pi = ((const LAS short*)(lds + AT_ORD))[u >> 3];
      nsa_unit(p, lds, u & 7, pi >> 4, pi & 15);
    }
  }
  xcd_barrier(xb);
  {
    StaticOrder S; S.init(T_, DM, nblk, bid, PROBE == 6 ? 2 : 1);
    EpiY E{p.hm(), p.ssq()};
    gemm_phase<EpiY>(lds, p.cat(), p.wot(), T_, DM, DM, S, E);
  }
  xcd_barrier(xb);
  for (int rep = 0; rep < (PROBE == 7 ? 2 : 1); ++rep) phase_post(p, bid, nblk);
}

}


extern "C" void kernel_launch(void* const* d_in, const int* in_sizes, int n_in, void* d_out, int out_size, void* d_ws,
                              size_t ws_size, hipStream_t stream) {
  P p{};
  p.x = (const float*)d_in[0]; p.g_pre = (const float*)d_in[1]; p.g_post = (const float*)d_in[2];
  p.w_in = (const float*)d_in[3]; p.pe_k = (const float*)d_in[4]; p.pe_v = (const float*)d_in[5];
  p.wk1 = (const float*)d_in[6]; p.wk2 = (const float*)d_in[7]; p.wv1 = (const float*)d_in[8]; p.wv2 = (const float*)d_in[9];
  p.w_out = (const float*)d_in[10]; p.out = (float*)d_out;
  p.ws = (char*)d_ws;
  if (ws_size < WS_END) { fprintf(stderr, "workspace too small\n"); return; }

  static int grid_blocks = 0;
  if (!grid_blocks) {
    int dev = 0, cus = 0, per_cu = 0;
    (void)hipGetDevice(&dev);
    (void)hipDeviceGetAttribute(&cus, hipDeviceAttributeMultiprocessorCount, dev);
    (void)hipFuncSetAttribute((const void*)mega, hipFuncAttributeMaxDynamicSharedMemorySize, MEGA_LDS);
    (void)hipOccupancyMaxActiveBlocksPerMultiprocessor(&per_cu, (const void*)mega, 512, MEGA_LDS);
    if (per_cu < 1) per_cu = 1;
    if (per_cu > 1) per_cu = 1;
    grid_blocks = cus * per_cu;
  }
  (void)hipMemsetAsync((char*)d_ws + OFF_XBAR, 0, (size_t)3456 * 4, stream);
  hipLaunchKernelGGL(mega, dim3(grid_blocks), dim3(512), MEGA_LDS, stream, p);
  hipError_t e = hipPeekAtLastError();
  if (e != hipSuccess) fprintf(stderr, "launch failed: %s (grid %d)\n", hipGetErrorString(e), grid_blocks);
}
```

```cpp
#include <hip/hip_runtime.h>
#include <hip/hip_fp16.h>
#include <hip/hip_cooperative_groups.h>
#include <cstdio>
#include <stdint.h>

#define PROBE 0
namespace {

#define LAS __attribute__((address_space(3)))
typedef _Float16 h8 __attribute__((ext_vector_type(8)));
typedef _Float16 h4 __attribute__((ext_vector_type(4)));
typedef float f32x4 __attribute__((ext_vector_type(4)));
typedef float f32x16 __attribute__((ext_vector_type(16)));
typedef unsigned u32x4 __attribute__((ext_vector_type(4)));

__device__ __forceinline__ int otid() { int t = threadIdx.x; asm volatile("" : "+v"(t)); return t; }

constexpr int B_ = 8, S_ = 4096, DM = 1024, DIN = 3864, T_ = B_ * S_;
constexpr int NP = 3840;
constexpr float EPS = 1e-6f;
constexpr int SL_QA = 0, SL_KA = 8, SL_VA = 16, SL_ZA = 24, SL_QB = 32, SL_KV6 = 40, SL_ZB = 52;

constexpr size_t al256(size_t x) { return (x + 255) & ~(size_t)255; }
constexpr size_t OFF_XH = 0;
constexpr size_t OFF_WT = OFF_XH + al256((size_t)T_ * 1024 * 2);
constexpr size_t OFF_WOT = OFF_WT + al256((size_t)NP * 1024 * 2);
constexpr size_t OFF_RSTD = OFF_WOT + al256((size_t)1024 * 1024 * 2);
constexpr size_t OFF_GATE = OFF_RSTD + al256((size_t)T_ * 4);
constexpr size_t OFF_KMP = OFF_GATE + al256((size_t)T_ * 24 * 4);
constexpr size_t OFF_KN2 = OFF_KMP + al256((size_t)8 * 8 * 16 * 2 * 64 * 4);
constexpr size_t OFF_QCTR = OFF_KN2 + al256((size_t)8 * 60 * 2 * 4);
constexpr size_t OFF_XBAR = OFF_QCTR + 256;
constexpr size_t OFF_SSQ = OFF_XBAR + al256((size_t)3456 * 4);
constexpr size_t OFF_PCNT = OFF_SSQ + al256((size_t)T_ * 4);
constexpr size_t OFF_SSQ2 = OFF_PCNT + al256(256 * 4);
constexpr size_t OFF_PCNT2 = OFF_SSQ2 + al256((size_t)T_ * 4);
constexpr size_t OFF_SEL = OFF_PCNT2 + al256(256 * 4);
constexpr size_t OFF_KCH = OFF_SEL + al256((size_t)8 * 2 * 4096 * 8);
constexpr size_t OFF_VCH = OFF_KCH + al256((size_t)8 * 2 * 256 * 64 * 2);
constexpr size_t OFF_W1T = OFF_VCH + al256((size_t)8 * 2 * 256 * 64 * 2);
constexpr size_t OFF_W2T = OFF_W1T + al256((size_t)2 * 128 * 2048 * 2);
constexpr size_t OFF_PEH = OFF_W2T + al256((size_t)2 * 64 * 128 * 2);
constexpr size_t OFF_OCMPH = OFF_PEH + al256((size_t)2 * 2048 * 2);
constexpr size_t OFF_HM = OFF_OCMPH + al256((size_t)T_ * 512 * 2);
constexpr size_t OFF_CAT = OFF_HM + al256((size_t)60 * T_ * 64 * 2);
constexpr size_t WS_END = OFF_CAT + al256((size_t)T_ * 1024 * 2);

struct P {
  const float* x; const float* g_pre; const float* g_post; const float* w_in;
  const float* pe_k; const float* pe_v; const float* wk1; const float* wk2; const float* wv1; const float* wv2;
  const float* w_out; float* out;
  char* ws;
  __device__ __forceinline__ __half* xh() const { return (__half*)(ws + OFF_XH); }
  __device__ __forceinline__ __half* cat() const { return (__half*)(ws + OFF_CAT); }
  __device__ __forceinline__ __half* wt() const { return (__half*)(ws + OFF_WT); }
  __device__ __forceinline__ __half* wot() const { return (__half*)(ws + OFF_WOT); }
  __device__ __forceinline__ float* rstd() const { return (float*)(ws + OFF_RSTD); }
  __device__ __forceinline__ float* gate() const { return (float*)(ws + OFF_GATE); }
  __device__ __forceinline__ float* kmp() const { return (float*)(ws + OFF_KMP); }
  __device__ __forceinline__ unsigned* kn2() const { return (unsigned*)(ws + OFF_KN2); }
  __device__ __forceinline__ unsigned* qctr() const { return (unsigned*)(ws + OFF_QCTR); }
  __device__ __forceinline__ unsigned* xbar() const { return (unsigned*)(ws + OFF_XBAR); }
  __device__ __forceinline__ float* ssq() const { return (float*)(ws + OFF_SSQ); }
  __device__ __forceinline__ unsigned* pcnt() const { return (unsigned*)(ws + OFF_PCNT); }
  __device__ __forceinline__ unsigned long long* sel() const { return (unsigned long long*)(ws + OFF_SEL); }
  __device__ __forceinline__ __half* kch() const { return (__half*)(ws + OFF_KCH); }
  __device__ __forceinline__ __half* vch() const { return (__half*)(ws + OFF_VCH); }
  __device__ __forceinline__ __half* w1t() const { return (__half*)(ws + OFF_W1T); }
  __device__ __forceinline__ __half* w2t() const { return (__half*)(ws + OFF_W2T); }
  __device__ __forceinline__ __half* peh() const { return (__half*)(ws + OFF_PEH); }
  __device__ __forceinline__ __half* ocmph() const { return (__half*)(ws + OFF_OCMPH); }
  __device__ __forceinline__ __half* hm() const { return (__half*)(ws + OFF_HM); }
};

__device__ __forceinline__ const __half* hmp(const P& p, int slot, int b, int t) {
  return p.hm() + (((size_t)slot * T_) + (size_t)b * S_ + t) * 64;
}

__device__ __forceinline__ float wave_sum(float v) {
#pragma unroll
  for (int o = 32; o > 0; o >>= 1) v += __shfl_xor(v, o, 64);
  return v;
}
__device__ __forceinline__ float silu(float v) { return v * __builtin_amdgcn_rcpf(1.f + __builtin_amdgcn_exp2f(-1.4426950408889634f * v)); }

constexpr int PREP_WG_OFF = 0;
constexpr int PREP_TILE_OFF = 65536;
constexpr int PREP_LDS = 65536 + 64 * 65 * 4;

__device__ __forceinline__ void tr_tile(const float* src, int ldS, int k0, int n0s, __half* dst, int ldD, int n0d,
                                        const float* scale, LAS float* tile, int tid) {
  {
    const int i = tid >> 4, jj = (tid & 15) * 4;
#pragma unroll
    for (int h = 0; h < 2; ++h) {
      const int k = i + 32 * h;
      float4 v = *reinterpret_cast<const float4*>(src + (size_t)(k0 + k) * ldS + n0s + jj);
      const float sc = scale ? scale[k0 + k] : 1.f;
      tile[k * 65 + jj + 0] = v.x * sc; tile[k * 65 + jj + 1] = v.y * sc; tile[k * 65 + jj + 2] = v.z * sc; tile[k * 65 + jj + 3] = v.w * sc;
    }
  }
  __syncthreads();
  {
    const int n = tid >> 3, kc = (tid & 7) * 8;
    h8 o;
#pragma unroll
    for (int u = 0; u < 8; ++u) o[u] = (_Float16)tile[(kc + u) * 65 + n];
    *reinterpret_cast<h8*>(dst + (size_t)(n0d + n) * ldD + k0 + kc) = o;
  }
  __syncthreads();
}

__device__ __forceinline__ void phase_prep(const P& p, LAS unsigned char* lds, int bid, int nblk) {
  const int tid = otid(), lane = tid & 63, wid = tid >> 6;
  LAS _Float16* wgl = (LAS _Float16*)(lds + PREP_WG_OFF);
#pragma unroll
  for (int rr = 0; rr < 2; ++rr) {
    const int k = tid + rr * 512;
    const f32x4* wrow = reinterpret_cast<const f32x4*>(p.w_in + (size_t)k * DIN + 3328);
    f32x4 w[6];
#pragma unroll
    for (int i = 0; i < 6; ++i) w[i] = wrow[i];
    const float gk = p.g_pre[k];
    const int s = k >> 5, q = (k >> 3) & 3, j = k & 7;
    LAS _Float16* dst = wgl + ((s * 4 + q) * 32) * 8 + j;
#pragma unroll
    for (int n = 0; n < 24; ++n) dst[n * 8] = (_Float16)(w[n >> 2][n & 3] * gk);
#pragma unroll
    for (int n = 24; n < 32; ++n) dst[n * 8] = (_Float16)0.f;
  }
  __syncthreads();
  for (int u = bid; u < T_ / 128; u += nblk) {
    const int row0 = u * 128 + wid * 16;
    const int r = lane & 15, q = lane >> 4;
    const float* xr = p.x + (size_t)(row0 + r) * DM + q * 8;
    __half* xo = p.xh() + (size_t)(row0 + r) * DM + q * 8;
    f32x4 acc0 = {0.f, 0.f, 0.f, 0.f}, acc1 = {0.f, 0.f, 0.f, 0.f};
    float ss = 0.f;
#pragma unroll 4
    for (int s = 0; s < 32; ++s) {
      const f32x4 v0 = __builtin_nontemporal_load(reinterpret_cast<const f32x4*>(xr + s * 32));
      const f32x4 v1 = __builtin_nontemporal_load(reinterpret_cast<const f32x4*>(xr + s * 32 + 4));
      ss += v0.x * v0.x + v0.y * v0.y + v0.z * v0.z + v0.w * v0.w + v1.x * v1.x + v1.y * v1.y + v1.z * v1.z + v1.w * v1.w;
      h8 a;
      a[0] = (_Float16)v0.x; a[1] = (_Float16)v0.y; a[2] = (_Float16)v0.z; a[3] = (_Float16)v0.w;
      a[4] = (_Float16)v1.x; a[5] = (_Float16)v1.y; a[6] = (_Float16)v1.z; a[7] = (_Float16)v1.w;
      *reinterpret_cast<h8*>(xo + s * 32) = a;
      const h8 b0 = *(const LAS h8*)(lds + PREP_WG_OFF + ((s * 4 + q) * 32 + r) * 16);
      const h8 b1 = *(const LAS h8*)(lds + PREP_WG_OFF + ((s * 4 + q) * 32 + 16 + r) * 16);
      acc0 = __builtin_amdgcn_mfma_f32_16x16x32_f16(a, b0, acc0, 0, 0, 0);
      acc1 = __builtin_amdgcn_mfma_f32_16x16x32_f16(a, b1, acc1, 0, 0, 0);
    }
    ss += __shfl_xor(ss, 16, 64);
    ss += __shfl_xor(ss, 32, 64);
    const float rs = rsqrtf(ss * (1.f / DM) + EPS);
    if (q == 0) p.rstd()[row0 + r] = rs;
#pragma unroll
    for (int reg = 0; reg < 4; ++reg) {
      const int row = q * 4 + reg;
      const float rr = __shfl(rs, row, 64);
      float* gp = p.gate() + (size_t)(row0 + row) * 24;
      gp[r] = 1.f / (1.f + __expf(-acc0[reg] * rr));
      if (r < 8) gp[16 + r] = 1.f / (1.f + __expf(-acc1[reg] * rr));
    }
  }
  __syncthreads();
  LAS float* tile = (LAS float*)(lds + PREP_TILE_OFF);
  constexpr int N_WIN = 16 * 60, N_WOUT = 16 * 16;
  constexpr int N_W1 = 2 * 64, N_W2 = 2 * 2;
  for (int it = bid; it < N_WIN + N_WOUT + N_W1 + N_W2; it += nblk) {
    if (it < N_WIN) {
      const int kb = it / 60, nb = it - kb * 60;
      const int n0d = nb * 64, n0s = n0d < 3328 ? n0d : n0d + 24;
      tr_tile(p.w_in, DIN, kb * 64, n0s, p.wt(), DM, n0d, p.g_pre, tile, tid);
    } else if (it < N_WIN + N_WOUT) {
      const int r = it - N_WIN, kb = r >> 4, nb = r & 15;
      tr_tile(p.w_out, DM, kb * 64, nb * 64, p.wot(), DM, nb * 64, nullptr, tile, tid);
    } else if (it < N_WIN + N_WOUT + N_W1) {
      const int r = it - N_WIN - N_WOUT, which = r >> 6, kb = (r & 63) >> 1, nb = r & 1;
      tr_tile(which ? p.wv1 : p.wk1, 128, kb * 64, nb * 64, p.w1t() + (size_t)which * 128 * 2048, 2048, nb * 64, nullptr, tile, tid);
    } else {
      const int r = it - N_WIN - N_WOUT - N_W1, which = r >> 1, kb = r & 1;
      tr_tile(which ? p.wv2 : p.wk2, 64, kb * 64, 0, p.w2t() + (size_t)which * 64 * 128, 128, 0, nullptr, tile, tid);
    }
  }
  for (int e = bid * 512 + tid; e < 8 * 60 * 2; e += nblk * 512) p.kn2()[e] = 0u;
  if (bid == 0 && tid < 8) p.qctr()[tid] = 0u;
  for (int e = bid * 512 + tid; e < T_; e += nblk * 512) p.ssq()[e] = 0.f;
  if (bid == 1 && tid < 256) p.pcnt()[tid] = 0u;
  if (PROBE == 6) { for (int e = bid * 512 + tid; e < T_; e += nblk * 512) ((float*)(p.ws + OFF_SSQ2))[e] = 0.f; if (bid == 3 && tid < 256) ((unsigned*)(p.ws + OFF_PCNT2))[tid] = 0u; }
  for (int e = bid * 512 + tid; e < 2 * 2048; e += nblk * 512) p.peh()[e] = __float2half(e < 2048 ? p.pe_k[e] : p.pe_v[e - 2048]);
}

constexpr int BM = 256, BK = 64, HALF = 128, HTB = HALF * BK * 2, STAGE_BYTES = 8 * HTB, NXCD = 8, WGM = 8;

__device__ __forceinline__ int lds_byte(int r, int c) { const int st = (r >> 4) * 2 + (c >> 5), rr = r & 15, cc = c & 31, ob = rr * 64 + cc * 2; return st * 1024 + (ob ^ (((ob >> 9) & 1) << 5)); }
__device__ __forceinline__ void stage_rc(int b, int& R, int& C) { const int st = b / 1024, sb = b % 1024, swz = sb ^ (((sb >> 9) & 1) << 5); R = (st >> 1) * 16 + swz / 64; C = (st & 1) * 32 + (swz % 64) / 2; }
__device__ __forceinline__ int perm32(int rho) { const int n = rho >> 4, i = rho & 15; return 8 * (i >> 2) + 4 * n + (i & 3); }

struct Unit { int pm, pn; };
struct StaticOrder {
  int nM, nN, nwg, G, c, rep;
  __device__ void init(int M, int N, int G_, int c_, int rep_ = 1) { nM = M / BM; nN = N / BM; nwg = nM * nN; G = G_; c = c_; rep = rep_; }
  __device__ bool next(int i, Unit& u) const {
    const long L = (long)i * G + c; if (L >= (long)nwg * rep) return false;
    int wgid = (int)(L % nwg); { const int q = nwg / NXCD, r = nwg % NXCD, xcd = wgid % NXCD, off = wgid / NXCD; wgid = (xcd < r ? xcd * (q + 1) : r * (q + 1) + (xcd - r) * q) + off; }
    const int nig = WGM * nN, gid = wgid / nig, fm = gid * WGM, gsz = (nM - fm) < WGM ? (nM - fm) : WGM;
    u.pm = fm + ((wgid % nig) % gsz); u.pn = (wgid % nig) / gsz; return true;
  }
};

struct EpiProj {
  static constexpr bool PERM = true;
  __half* hm; const float* rstd; float* kmp; unsigned* kn2; int pn_off;
  __device__ __forceinline__ void operator()(const f32x4 (&acc)[2][2][4][2], const Unit& u0, int wr, int wc, int fr, int fq) const {
    Unit u; u.pm = u0.pm; u.pn = u0.pn + pn_off;
    const int row0 = u.pm * BM + wr * 64 + fr;
    const int colb = u.pn * BM + wc * 32 + 8 * fq;
    const bool isK = (u.pn == 2) || (u.pn == 3);
    const bool hasK = isK || (u.pn == 11) || (u.pn == 12);
    float cs[2][8];
    float nmax[2] = {0.f, 0.f};
#pragma unroll
    for (int bj = 0; bj < 2; ++bj)
#pragma unroll
      for (int j = 0; j < 8; ++j) cs[bj][j] = 0.f;
    float rsv[2][4];
#pragma unroll
    for (int ai = 0; ai < 2; ++ai)
#pragma unroll
      for (int m = 0; m < 4; ++m) rsv[ai][m] = rstd[row0 + ai * HALF + m * 16];
    asm volatile("" : "+v"(rsv[0][0]), "+v"(rsv[0][1]), "+v"(rsv[0][2]), "+v"(rsv[0][3]), "+v"(rsv[1][0]), "+v"(rsv[1][1]), "+v"(rsv[1][2]), "+v"(rsv[1][3]));
#pragma unroll
    for (int ai = 0; ai < 2; ++ai)
#pragma unroll
      for (int m = 0; m < 4; ++m) {
        const int row = row0 + ai * HALF + m * 16;
        const float rs = rsv[ai][m];
#pragma unroll
        for (int bj = 0; bj < 2; ++bj) {
          const int c = colb + bj * HALF;
          const f32x4 v0 = acc[ai][bj][m][0] * rs, v1 = acc[ai][bj][m][1] * rs;
          h8 o;
          o[0] = (_Float16)v0[0]; o[1] = (_Float16)v0[1]; o[2] = (_Float16)v0[2]; o[3] = (_Float16)v0[3];
          o[4] = (_Float16)v1[0]; o[5] = (_Float16)v1[1]; o[6] = (_Float16)v1[2]; o[7] = (_Float16)v1[3];
          *reinterpret_cast<h8*>(hm + ((size_t)(c >> 6) * T_ + row) * 64 + (c & 63)) = o;
          if (hasK) {
            float ss = (v0[0] * v0[0] + v0[1] * v0[1]) + (v0[2] * v0[2] + v0[3] * v0[3]) + (v1[0] * v1[0] + v1[1] * v1[1]) + (v1[2] * v1[2] + v1[3] * v1[3]);
            ss += __shfl_xor(ss, 16, 64); ss += __shfl_xor(ss, 32, 64);
            nmax[bj] = fmaxf(nmax[bj], ss);
          }
          if (isK) {
#pragma unroll
            for (int j = 0; j < 4; ++j) { cs[bj][j] += v0[j]; cs[bj][4 + j] += v1[j]; }
          }
        }
      }
    if (hasK)
#pragma unroll
    for (int bj = 0; bj < 2; ++bj) {
      float v = nmax[bj];
      v = fmaxf(v, __shfl_xor(v, 1, 64)); v = fmaxf(v, __shfl_xor(v, 2, 64)); v = fmaxf(v, __shfl_xor(v, 4, 64)); v = fmaxf(v, __shfl_xor(v, 8, 64));
      if ((fr | fq) == 0) {
        const int c = u.pn * BM + wc * 32 + bj * HALF;
        atomicMax(kn2 + ((size_t)(u.pm >> 4) * 60 + (c >> 6)) * 2 + (wc & 1), __float_as_uint(v));
      }
    }
    if (isK) {
#pragma unroll
      for (int bj = 0; bj < 2; ++bj)
#pragma unroll
        for (int j = 0; j < 8; ++j) {
          float v = cs[bj][j];
          v += __shfl_xor(v, 1, 64); v += __shfl_xor(v, 2, 64); v += __shfl_xor(v, 4, 64); v += __shfl_xor(v, 8, 64);
          cs[bj][j] = v;
        }
      if (fr == 0) {
        const int b = u.pm >> 4, blk = u.pm & 15;
#pragma unroll
        for (int bj = 0; bj < 2; ++bj) {
          const int c = colb + bj * HALF, h = (c >> 6) - SL_KA, d0 = c & 63;
          float* dst = kmp + ((((size_t)b * 8 + h) * 16 + blk) * 2 + wr) * 64 + d0;
          *reinterpret_cast<f32x4*>(dst) = (f32x4){cs[bj][0], cs[bj][1], cs[bj][2], cs[bj][3]};
          *reinterpret_cast<f32x4*>(dst + 4) = (f32x4){cs[bj][4], cs[bj][5], cs[bj][6], cs[bj][7]};
        }
      }
    }
  }
};
struct EpiY {
  static constexpr bool PERM = true;
  __half* y; float* ssq;
  __device__ __forceinline__ void operator()(const f32x4 (&acc)[2][2][4][2], const Unit& u, int wr, int wc, int fr, int fq) const {
    const int row0 = u.pm * BM + wr * 64 + fr;
    const int colb = u.pn * BM + wc * 32 + 8 * fq;
#pragma unroll
    for (int ai = 0; ai < 2; ++ai)
#pragma unroll
      for (int m = 0; m < 4; ++m) {
        const int row = row0 + ai * HALF + m * 16;
        float s = 0.f;
#pragma unroll
        for (int bj = 0; bj < 2; ++bj) {
          const f32x4 v0 = acc[ai][bj][m][0], v1 = acc[ai][bj][m][1];
          s += (v0[0] * v0[0] + v0[1] * v0[1]) + (v0[2] * v0[2] + v0[3] * v0[3]) + (v1[0] * v1[0] + v1[1] * v1[1]) + (v1[2] * v1[2] + v1[3] * v1[3]);
          h8 o;
          o[0] = (_Float16)(v0[0] * 64.f); o[1] = (_Float16)(v0[1] * 64.f); o[2] = (_Float16)(v0[2] * 64.f); o[3] = (_Float16)(v0[3] * 64.f);
          o[4] = (_Float16)(v1[0] * 64.f); o[5] = (_Float16)(v1[1] * 64.f); o[6] = (_Float16)(v1[2] * 64.f); o[7] = (_Float16)(v1[3] * 64.f);
          *reinterpret_cast<h8*>(y + (size_t)row * DM + colb + bj * HALF) = o;
        }
        s += __shfl_xor(s, 16, 64); s += __shfl_xor(s, 32, 64);
        if (fq == 0) atomicAdd(ssq + row, s);
      }
  }
};

__device__ __forceinline__ void phase_post(const P& p, int bid, int nblk) {
  const int tid = otid(), lane = tid & 63, wid = tid >> 6;
  const __half* y = p.hm();
  f32x4 gv[2][2];
#pragma unroll
  for (int j = 0; j < 2; ++j) {
    gv[j][0] = *reinterpret_cast<const f32x4*>(p.g_post + j * 512 + lane * 8);
    gv[j][1] = *reinterpret_cast<const f32x4*>(p.g_post + j * 512 + lane * 8 + 4);
  }
  const int stride = nblk * 8;
  for (int t = bid * 8 + wid; t < T_; t += 2 * stride) {
    const int t1 = t + stride;
    const bool has1 = t1 < T_;
    const float tot0 = __hip_atomic_load(p.ssq() + t, __ATOMIC_RELAXED, __HIP_MEMORY_SCOPE_AGENT);
    const float tot1 = has1 ? __hip_atomic_load(p.ssq() + t1, __ATOMIC_RELAXED, __HIP_MEMORY_SCOPE_AGENT) : 1.f;
    h8 xv[2][2], yv[2][2];
#pragma unroll
    for (int j = 0; j < 2; ++j) {
      const size_t off0 = (size_t)t * DM + j * 512 + lane * 8, off1 = (size_t)(has1 ? t1 : t) * DM + j * 512 + lane * 8;
      xv[0][j] = __builtin_nontemporal_load(reinterpret_cast<const h8*>(p.xh() + off0));
      yv[0][j] = __builtin_nontemporal_load(reinterpret_cast<const h8*>(y + off0));
      xv[1][j] = __builtin_nontemporal_load(reinterpret_cast<const h8*>(p.xh() + off1));
      yv[1][j] = __builtin_nontemporal_load(reinterpret_cast<const h8*>(y + off1));
    }
    const float r0 = rsqrtf(tot0 * (1.f / DM) + EPS) * (1.f / 64.f), r1 = rsqrtf(tot1 * (1.f / DM) + EPS) * (1.f / 64.f);
#pragma unroll
    for (int i = 0; i < 2; ++i) {
      if (i == 1 && !has1) break;
      const float r = i ? r1 : r0;
      const int tt = i ? t1 : t;
#pragma unroll
      for (int j = 0; j < 2; ++j) {
        const size_t off = (size_t)tt * DM + j * 512 + lane * 8;
        f32x4 o0, o1;
#pragma unroll
        for (int k = 0; k < 4; ++k) { o0[k] = (float)xv[i][j][k] + (float)yv[i][j][k] * r * gv[j][0][k]; o1[k] = (float)xv[i][j][4 + k] + (float)yv[i][j][4 + k] * r * gv[j][1][k]; }
        __builtin_nontemporal_store(o0, reinterpret_cast<f32x4*>(p.out + off));
        __builtin_nontemporal_store(o1, reinterpret_cast<f32x4*>(p.out + off + 4));
      }
    }
  }
}

template <class Epi>
__device__ __forceinline__ void gemm_phase(LAS unsigned char* lds, const __half* gA, const __half* gBt, int M, int N, int K, const StaticOrder& S, const Epi& E) {
  const int tid = otid(), wid = __builtin_amdgcn_readfirstlane(tid >> 6), lane = tid & 63, wr = wid >> 2, wc = wid & 3, fr = lane & 15, fq = lane >> 4;
  const int nt = K / BK;
  unsigned voffA[2], voffB[2];
#pragma unroll
  for (int i = 0; i < 2; ++i) { int R, C; stage_rc(tid * 16 + i * 8192, R, C); const int Rb = Epi::PERM ? ((R & ~31) + perm32(R & 31)) : R;
    voffA[i] = (unsigned)(R * K + C) * 2u; voffB[i] = (unsigned)(Rb * K + C) * 2u; }
  const size_t kstep = (size_t)(BK * 2);
  const size_t hstep = (size_t)HALF * K * 2;
  const size_t tstep = 2 * hstep;
  const unsigned ldsw = (unsigned)wid * 1024u;
  const int aoff = lds_byte(wr * 64 + fr, fq * 8), boff = lds_byte(wc * 32 + fr, fq * 8);
#define PG8_SA(b, h) (((b) * 2 + (h)) * HTB)
#define PG8_SB(b, h) ((4 + (b) * 2 + (h)) * HTB)
#define PG8_STAGE(bufoff, gbase, voff) do { _Pragma("unroll") for (int _i = 0; _i < 2; ++_i) \
    __builtin_amdgcn_global_load_lds((const unsigned*)((const char*)(gbase) + (voff)[_i]), (LAS unsigned*)(lds + (bufoff) + ldsw + _i * 8192), 16, 0, 0); } while (0)
#define PG8_LDA(dst, b, h) do { _Pragma("unroll") for (int m = 0; m < 4; ++m) _Pragma("unroll") for (int k = 0; k < 2; ++k) dst[m][k] = *(const LAS h8*)(lds + PG8_SA(b, h) + aoff + m * 2048 + k * 1024); } while (0)
#define PG8_LDB(dst, b, h) do { _Pragma("unroll") for (int n = 0; n < 2; ++n) _Pragma("unroll") for (int k = 0; k < 2; ++k) dst[n][k] = *(const LAS h8*)(lds + PG8_SB(b, h) + boff + n * 2048 + k * 1024); } while (0)
#define PG8_MMA(ai, bj, At, Bt) do { __builtin_amdgcn_s_setprio(1); _Pragma("unroll") for (int m = 0; m < 4; ++m) _Pragma("unroll") for (int n = 0; n < 2; ++n) _Pragma("unroll") for (int k = 0; k < 2; ++k) \
    acc[ai][bj][m][n] = __builtin_amdgcn_mfma_f32_16x16x32_f16(Bt[n][k], At[m][k], acc[ai][bj][m][n], 0, 0, 0); __builtin_amdgcn_s_setprio(0); } while (0)
#define PG8_WAIT_V(n) asm volatile("s_waitcnt vmcnt(" #n ")" ::: "memory")
#define PG8_WAIT_L(n) asm volatile("s_waitcnt lgkmcnt(" #n ")" ::: "memory")
#define PG8_BAR __builtin_amdgcn_s_barrier()
#define PG8_SCHED __builtin_amdgcn_sched_barrier(0)
  Unit cur, nxt; int ui = 0;
  if (!S.next(0, cur)) return;
  f32x4 acc[2][2][4][2];
#pragma unroll
  for (int a = 0; a < 2; ++a)
#pragma unroll
    for (int b = 0; b < 2; ++b)
#pragma unroll
      for (int m = 0; m < 4; ++m)
#pragma unroll
        for (int n = 0; n < 2; ++n) acc[a][b][m][n] = (f32x4){0.f, 0.f, 0.f, 0.f};
  h8 At[4][2], B0[2][2], B1[2][2];
  const char* cA = (const char*)gA + (size_t)cur.pm * tstep; const char* cB = (const char*)gBt + (size_t)cur.pn * tstep;
  PG8_STAGE(PG8_SB(0, 0), cB, voffB); PG8_STAGE(PG8_SA(0, 0), cA, voffA); PG8_STAGE(PG8_SB(0, 1), cB + hstep, voffB); PG8_STAGE(PG8_SA(0, 1), cA + hstep, voffA);
  if (wr == 1) PG8_BAR;
  PG8_WAIT_V(4); PG8_BAR;
  PG8_STAGE(PG8_SB(1, 0), cB + kstep, voffB); PG8_STAGE(PG8_SA(1, 0), cA + kstep, voffA); PG8_STAGE(PG8_SB(1, 1), cB + hstep + kstep, voffB);
  PG8_WAIT_V(6); PG8_BAR;
  for (;;) {
    const bool has_next = S.next(ui + 1, nxt);
    const char* nA = has_next ? (const char*)gA + (size_t)nxt.pm * tstep : cA; const char* nB = has_next ? (const char*)gBt + (size_t)nxt.pn * tstep : cB;
    for (int t = 0; t < nt; t += 2) {
      const bool last = (t == nt - 2);
      const char* a1 = cA + (size_t)(t + 1) * kstep;
      const char* a2 = last ? nA : cA + (size_t)(t + 2) * kstep; const char* b2 = last ? nB : cB + (size_t)(t + 2) * kstep;
      const char* a3 = a2 + kstep; const char* b3 = b2 + kstep;
      PG8_LDB(B0, 0, 0); PG8_SCHED; PG8_LDA(At, 0, 0); PG8_STAGE(PG8_SA(1, 1), a1 + hstep, voffA);
      PG8_WAIT_L(8); PG8_BAR; PG8_WAIT_L(0); PG8_MMA(0, 0, At, B0); PG8_BAR; PG8_SCHED;
      PG8_LDB(B1, 0, 1); PG8_STAGE(PG8_SB(0, 0), b2, voffB);
      PG8_BAR; PG8_WAIT_L(0); PG8_MMA(0, 1, At, B1); PG8_BAR;
      PG8_LDA(At, 0, 1); PG8_STAGE(PG8_SA(0, 0), a2, voffA);
      PG8_BAR; PG8_WAIT_L(0); PG8_MMA(1, 0, At, B0); PG8_BAR; PG8_SCHED;
      PG8_STAGE(PG8_SB(0, 1), b2 + hstep, voffB);
      PG8_WAIT_V(6); PG8_BAR; PG8_MMA(1, 1, At, B1); PG8_BAR;
      PG8_LDB(B0, 1, 0); PG8_SCHED; PG8_LDA(At, 1, 0); PG8_STAGE(PG8_SA(0, 1), a2 + hstep, voffA);
      PG8_WAIT_L(8); PG8_BAR; PG8_WAIT_L(0); PG8_MMA(0, 0, At, B0); PG8_BAR; PG8_SCHED;
      PG8_LDB(B1, 1, 1); PG8_STAGE(PG8_SB(1, 0), b3, voffB);
      PG8_BAR; PG8_WAIT_L(0); PG8_MMA(0, 1, At, B1); PG8_BAR;
      PG8_LDA(At, 1, 1); PG8_STAGE(PG8_SA(1, 0), a3, voffA);
      PG8_BAR; PG8_WAIT_L(0); PG8_MMA(1, 0, At, B0); PG8_BAR; PG8_SCHED;
      PG8_STAGE(PG8_SB(1, 1), b3 + hstep, voffB);
      PG8_WAIT_V(6); PG8_BAR; PG8_MMA(1, 1, At, B1); PG8_BAR;
    }
    E(acc, cur, wr, wc, fr, fq);
    if (!has_next) break;
#pragma unroll
    for (int a = 0; a < 2; ++a)
#pragma unroll
      for (int b = 0; b < 2; ++b)
#pragma unroll
        for (int m = 0; m < 4; ++m)
#pragma unroll
          for (int n = 0; n < 2; ++n) acc[a][b][m][n] = (f32x4){0.f, 0.f, 0.f, 0.f};
    cur = nxt; cA = nA; cB = nB; ++ui;
  }
  PG8_WAIT_V(0);
  if (wr == 0) PG8_BAR;
  PG8_BAR;
#undef PG8_SA
#undef PG8_SB
#undef PG8_STAGE
#undef PG8_LDA
#undef PG8_LDB
#undef PG8_MMA
#undef PG8_WAIT_V
#undef PG8_WAIT_L
#undef PG8_BAR
#undef PG8_SCHED
}

constexpr int AT_K = 0, AT_V = 24576, AT_WS = 49152, AT_KM = 51200, AT_OST = 55296, AT_FLG = AT_OST + 8 * 8192, AT_ORD = AT_FLG + 64, AT_QS = AT_ORD + 256, AT_Q = AT_QS + 64, AT_LDS = AT_Q + 8 * 4096;
constexpr float PRUNE = (PROBE == 12 || PROBE == 13) ? 1e30f : 40.f;
constexpr float LOG2E = 1.4426950408889634f;
constexpr float C2 = 0.125f * LOG2E;
constexpr float THR = (PROBE == 30) ? 0.f : 8.f;
enum { M_MOBA = 0, M_SLC = 1, M_WIN = 2 };
typedef short v4i16_t __attribute__((ext_vector_type(4)));

__device__ __forceinline__ int crow(int r, int hi) { return (r & 3) + 8 * (r >> 2) + 4 * hi; }
__device__ __forceinline__ void glds16(const void* g, LAS unsigned char* l) {
  __builtin_amdgcn_global_load_lds((const unsigned*)g, (LAS unsigned*)l, 16, 0, 0);
}
__device__ __forceinline__ h4 vtr(const LAS unsigned char* p) {
  return __builtin_bit_cast(h4, __builtin_amdgcn_ds_read_tr16_b64_v4i16((LAS v4i16_t*)p));
}
__device__ __forceinline__ void scale_rows(f32x16 (&o)[2], float f, LAS float* wsf, int r32, int hi) {
  if (hi == 0) wsf[r32] = f;
#pragma unroll
  for (int r = 0; r < 16; ++r) { const float a = wsf[crow(r, hi)]; o[0][r] *= a; o[1][r] *= a; }
}

#define SBAR() __builtin_amdgcn_sched_barrier(0)
#define PINV(x) asm volatile("" : "+v"(x))
#define MFMA32(a, b, c) __builtin_amdgcn_mfma_f32_32x32x16_f16((a), (b), (c), 0, 0, 0)
__device__ __forceinline__ h8 kfrag(const LAS unsigned char* kp, int f) { return *(const LAS h8*)(kp + (f >> 1) * 2048 + (f & 1) * 512); }
__device__ __forceinline__ h8 vfrag(const LAS unsigned char* vp, int f) {
  const LAS unsigned char* a = vp + (f & 1) * 4096 + (f >> 1) * 1024;
  const h4 lo = vtr(a), hv = vtr(a + 512);
  return __builtin_shufflevector(lo, hv, 0, 1, 2, 3, 4, 5, 6, 7);
}

__device__ __forceinline__ void glds16_asm(const void* g, unsigned lds_base) {
  unsigned sv;
  asm volatile("s_mov_b32 %0, m0\n\ts_mov_b32 m0, %2\n\ts_nop 0\n\tglobal_load_lds_dwordx4 %1, off\n\ts_mov_b32 m0, %0" : "=&s"(sv) : "v"(g), "s"(lds_base) : "memory");
}
#define WAIT_BAR(N) asm volatile("s_waitcnt vmcnt(" #N ") lgkmcnt(0)\n\ts_barrier" ::: "memory")

template <int MODE, bool HASPREV>
__device__ __forceinline__ void fstep(h8 (&pw)[4], f32x16 (&o)[2], const f32x16& bfix, const h8 (&qf)[4],
                                      h8 (&kf)[8], float& m, float& l, const LAS unsigned char* kpn,
                                      const LAS unsigned char* vpp, LAS float* wsf, LAS int* flgw, int kt, int q0, int tq, int tq_min, int tq_max,
                                      int hi, int r32, int lane, float slope2, unsigned long long rowmask, float ubc) {
  f32x16 C0, C1;
  h8 vf[8];
#pragma unroll
  for (int i = 0; i < 8; ++i) {
    if (HASPREV) vf[i] = vfrag(vpp, i);
    const int d0 = i >> 1;
    if (i & 1) C1 = MFMA32(kf[i], qf[d0], d0 == 0 ? bfix : C1);
    else       C0 = MFMA32(kf[i], qf[d0], d0 == 0 ? bfix : C0);
    SBAR();
  }
  const int k0 = kt * 64;
  const float bnd = ubc - slope2 * (float)max(tq - k0 - 63, 0);
  bool need = (k0 <= tq) && (bnd >= m - PRUNE);
  if (MODE == M_MOBA) need = need && (((unsigned)rowmask >> (kt >> 2)) & 1u);
  if (MODE == M_SLC) need = need && ((rowmask >> kt) & 1ull);
  if (MODE == M_WIN) need = need && (k0 + 63 >= tq - 511);
  const bool edge = (k0 + 63 > tq_min) || (MODE == M_WIN && k0 < tq_max - 511);
  if (edge) {
    const int rel = tq - k0 - 4 * hi;
#pragma unroll
    for (int r = 0; r < 16; ++r) {
      const int e0 = (r & 3) + 8 * (r >> 2), e1 = e0 + 32;
      bool ok0 = e0 <= rel, ok1 = e1 <= rel;
      if (MODE == M_WIN) { ok0 = ok0 && (e0 >= rel - 511); ok1 = ok1 && (e1 >= rel - 511); }
      C0[r] = ok0 ? C0[r] : -1e30f; C1[r] = ok1 ? C1[r] : -1e30f;
    }
  }
  const float off1 = 32.f * slope2;
  const float base_t = slope2 * (float)(k0 - q0);
  bool resc = false;
  if (__any(need && (bnd > m + THR))) {
    float mx0 = C0[0], mx1 = C1[0];
#pragma unroll
    for (int r = 1; r < 16; ++r) { mx0 = fmaxf(mx0, C0[r]); mx1 = fmaxf(mx1, C1[r]); }
    float mxs = fmaxf(mx0 * C2, __builtin_fmaf(mx1, C2, off1));
    { const auto rr = __builtin_amdgcn_permlane32_swap(__float_as_uint(mxs), __float_as_uint(mxs), false, false);
      mxs = fmaxf(__uint_as_float(rr[0]), __uint_as_float(rr[1])); }
    const float mt2 = need ? (mxs + base_t) : -1e30f;
    resc = __any(mt2 - m > THR);
    if (resc) {
      const float mn = fmaxf(m, mt2);
      const float alpha = __builtin_amdgcn_exp2f(m - mn);
      l *= alpha; m = mn;
      if (hi == 0) wsf[r32] = alpha;
    }
  }
  const float nm0 = need ? (base_t - m) : -INFINITY;
  const float nm1 = nm0 + off1;
  {
    const bool live_next = (ubc - slope2 * (float)max(tq - k0 + 1, 0)) >= m - PRUNE;
    const int a = __any(live_next) ? 1 : 0;
    if (lane == 0) *flgw = a;
  }
  SBAR();
  float sacc = 0.f;
  h8 pn[4];
#pragma unroll
  for (int i = 0; i < 8; ++i) {
    kf[i] = kfrag(kpn, i);
    if (HASPREV) {
      if (i & 1) o[1] = MFMA32(pw[i >> 1], vf[i], o[1]);
      else       o[0] = MFMA32(pw[i >> 1], vf[i], o[0]);
    }
    float e[4];
#pragma unroll
    for (int j = 0; j < 4; ++j)
      e[j] = (i < 4) ? __builtin_amdgcn_exp2f(__builtin_fmaf(C0[4 * i + j], C2, nm0)) : __builtin_amdgcn_exp2f(__builtin_fmaf(C1[4 * (i - 4) + j], C2, nm1));
    sacc += (e[0] + e[1]) + (e[2] + e[3]);
    pn[i >> 1][(i & 1) * 4 + 0] = (_Float16)e[0]; pn[i >> 1][(i & 1) * 4 + 1] = (_Float16)e[1];
    pn[i >> 1][(i & 1) * 4 + 2] = (_Float16)e[2]; pn[i >> 1][(i & 1) * 4 + 3] = (_Float16)e[3];
    PINV(sacc); PINV(pn[i >> 1]);
    SBAR();
  }
  l += sacc;
#pragma unroll
  for (int s = 0; s < 4; ++s) pw[s] = pn[s];
  if (HASPREV && resc) {
#pragma unroll
    for (int r = 0; r < 16; ++r) { const float a = wsf[crow(r, hi)]; o[0][r] *= a; o[1][r] *= a; }
  }
}

__device__ __forceinline__ void fdrain(const h8 (&pw)[4], f32x16 (&o)[2], const LAS unsigned char* vp) {
#pragma unroll
  for (int f = 0; f < 8; ++f) {
    const h8 v = vfrag(vp, f);
    if (f & 1) o[1] = MFMA32(pw[f >> 1], v, o[1]); else o[0] = MFMA32(pw[f >> 1], v, o[0]);
  }
}

template <int MODE>
__device__ __forceinline__ void flash_pipe(LAS unsigned char* lds, const __half* Kg, const __half* Vg, int q0, int kt_lo, int kt_hi,
                                           const f32x16& bfix, float slope2, unsigned long long rowmask, float ubc,
                                           f32x16 (&o)[2], float& l_tot) {
  const int tid = otid(), lane = tid & 63, r32 = lane & 31, hi = lane >> 5;
  const int wid = __builtin_amdgcn_readfirstlane(tid >> 6);
  const int tq = q0 + wid * 32 + r32, tq_min = q0 + wid * 32, tq_max = tq_min + 31;
  LAS float* wsf = (LAS float*)(lds + AT_WS) + wid * 64;
  LAS int* flg = (LAS int*)(lds + AT_FLG);
  const __half* ksrc = Kg + (size_t)lane * 64 + wid * 8;
  const __half* vsrc = Vg + (size_t)(16 * (wid & 3) + (lane >> 2)) * 64 + (wid >> 2) * 32 + (lane & 3) * 8;
  const unsigned kdst = (unsigned)(unsigned long)(lds + AT_K) + wid * 1024;
  const unsigned vdst = (unsigned)(unsigned long)(lds + AT_V) + wid * 1024;
  const LAS unsigned char* kp0 = lds + AT_K + hi * 1024 + r32 * 16;
  const LAS unsigned char* vp0 = lds + AT_V + ((lane >> 4) & 1) * 32 + (lane & 3) * 8 + (4 * hi + ((lane & 15) >> 2)) * 64;
  const LAS unsigned char* qp = lds + AT_Q + wid * 4096 + lane * 16;
  h8 qf[4];
#pragma unroll
  for (int d0 = 0; d0 < 4; ++d0) qf[d0] = *(const LAS h8*)(qp + d0 * 1024);
#pragma unroll
  for (int r = 0; r < 16; ++r) { o[0][r] = 0.f; o[1][r] = 0.f; }
  float m = -1e30f, l = 0.f;
  h8 kf[8], pw[4];
#define KT_(t) max(kt_hi - (t), kt_lo)
#define DMA_K(t, slot) glds16_asm(ksrc + (size_t)KT_(t) * 4096, (unsigned)__builtin_amdgcn_readfirstlane(kdst + (slot)))
#define DMA_V(t, slot) glds16_asm(vsrc + (size_t)KT_(t) * 4096, (unsigned)__builtin_amdgcn_readfirstlane(vdst + (slot)))
  asm volatile("s_waitcnt vmcnt(0)" ::: "memory");
  DMA_K(0, 0); DMA_K(1, 8192); DMA_K(2, 16384); DMA_V(0, 0);
  WAIT_BAR(2);
#pragma unroll
  for (int i = 0; i < 8; ++i) kf[i] = kfrag(kp0, i);
  WAIT_BAR(2);
  int t = 0, kt = kt_hi;
  int s0 = 0, s1 = 8192, s2 = 16384;
#define STEP_CLOSE(done) do { WAIT_BAR(2);     \
    { const LAS int* f_ = flg + (kt & 1) * 8; const int any_live = f_[0] | f_[1] | f_[2] | f_[3] | f_[4] | f_[5] | f_[6] | f_[7]; done = (!any_live) || (kt == kt_lo); } } while (0)
#define STEP_ROT() do { const int t_ = s0; s0 = s1; s1 = s2; s2 = t_; ++t; --kt; } while (0)
  bool done;
  DMA_K(3, s0); DMA_V(1, s1);
  fstep<MODE, false>(pw, o, bfix, qf, kf, m, l, kp0 + s1, vp0, wsf, flg + (kt & 1) * 8 + wid, kt, q0, tq, tq_min, tq_max, hi, r32, lane, slope2, rowmask, ubc);
  STEP_CLOSE(done);
  while (!done) {
    STEP_ROT();
    DMA_K(t + 3, s0); DMA_V(t + 1, s1);
    fstep<MODE, true>(pw, o, bfix, qf, kf, m, l, kp0 + s1, vp0 + s2  , wsf, flg + (kt & 1) * 8 + wid, kt, q0, tq, tq_min, tq_max, hi, r32, lane, slope2, rowmask, ubc);
    STEP_CLOSE(done);
  }
  fdrain(pw, o, vp0 + s0);
  asm volatile("s_waitcnt lgkmcnt(0)\n\ts_barrier" ::: "memory");
#undef KT_
#undef DMA_K
#undef DMA_V
#undef STEP_CLOSE
#undef STEP_ROT
  l_tot = l + __shfl_xor(l, 32, 64);
}

__device__ __forceinline__ float score_bound(const P& p, const h8 (&qf)[4], int b, int slot) {
  float ss = 0.f;
#pragma unroll
  for (int d0 = 0; d0 < 4; ++d0)
#pragma unroll
    for (int j = 0; j < 8; ++j) { const float v = (float)qf[d0][j]; ss += v * v; }
  ss += __shfl_xor(ss, 32, 64);
  const unsigned* kn = p.kn2() + ((size_t)b * 60 + slot) * 2;
  const float kmax = sqrtf(__uint_as_float(kn[0]) + __uint_as_float(kn[1])) * 1.002f;
  return C2 * sqrtf(ss) * kmax * 1.001f;
}

__device__ __forceinline__ void put_q(LAS unsigned char* lds, const h8 (&qf)[4], int wid, int lane) {
  LAS unsigned char* qp = lds + AT_Q + wid * 4096 + lane * 16;
#pragma unroll
  for (int d0 = 0; d0 < 4; ++d0) *(LAS h8*)(qp + d0 * 1024) = qf[d0];
}

__device__ __forceinline__ void moba_unit(const P& p, LAS unsigned char* lds, int b, int h, int own) {
  const int tid = otid(), lane = tid & 63, r32 = lane & 31, hi = lane >> 5;
  const int wid = __builtin_amdgcn_readfirstlane(tid >> 6);
  const int q0 = own * 256;
  const size_t bh = (size_t)b * 8 + h;
  LAS float* km = (LAS float*)(lds + AT_KM);
  for (int e = tid; e < own * 64; e += 512) {
    const int n = e >> 6, d = e & 63;
    const float* kp = p.kmp() + ((bh * 16 + n) * 2) * 64 + d;
    km[e] = (kp[0] + kp[64]) * (1.f / 256.f);
  }
  h8 qf[4];
  const __half* qrow = hmp(p, SL_QA + h, b, q0 + wid * 32 + r32);
#pragma unroll
  for (int d0 = 0; d0 < 4; ++d0) qf[d0] = *reinterpret_cast<const h8*>(qrow + d0 * 16 + hi * 8);
  __syncthreads();
  float g0 = -3e38f, g1 = -3e38f, g2 = -3e38f; int i0 = -1, i1 = -1, i2 = -1;
  for (int n = 0; n < own; ++n) {
    float s = 0.f;
#pragma unroll
    for (int d0 = 0; d0 < 4; ++d0)
#pragma unroll
      for (int j = 0; j < 8; ++j) s += (float)qf[d0][j] * km[n * 64 + d0 * 16 + hi * 8 + j];
    s += __shfl_xor(s, 32, 64);
    if (s > g0) { g2 = g1; i2 = i1; g1 = g0; i1 = i0; g0 = s; i0 = n; }
    else if (s > g1) { g2 = g1; i2 = i1; g1 = s; i1 = n; }
    else if (s > g2) { g2 = s; i2 = n; }
  }
  unsigned long long rowmask = 1ull << own;
  if (i0 >= 0) rowmask |= 1ull << i0;
  if (i1 >= 0) rowmask |= 1ull << i1;
  if (i2 >= 0) rowmask |= 1ull << i2;
  const float slope = exp2f(-(float)(h + 1));
  const float slope2 = slope * LOG2E;
  f32x16 bfix;
  {
    const float sb = slope * 8.f;
    const int qrel = wid * 32 + r32;
#pragma unroll
    for (int r = 0; r < 16; ++r) bfix[r] = sb * (float)((r & 3) + 8 * (r >> 2) + 4 * hi - qrel);
  }
  f32x16 o[2]; float l_tot;
  const float ubc = score_bound(p, qf, b, SL_KA + h);
  put_q(lds, qf, wid, lane);
  flash_pipe<M_MOBA>(lds, hmp(p, SL_KA + h, b, 0), hmp(p, SL_VA + h, b, 0), q0, 0, 4 * own + 3, bfix, slope2, rowmask, ubc, o, l_tot);
  if (PROBE == 11 || PROBE == 13) flash_pipe<M_MOBA>(lds, hmp(p, SL_KA + h, b, 0), hmp(p, SL_VA + h, b, 0), q0, 0, 4 * own + 3, bfix, slope2, rowmask, ubc, o, l_tot);
  LAS float* wsf = (LAS float*)(lds + AT_WS) + wid * 64;
  scale_rows(o, 1.f / fmaxf(l_tot, 1e-30f), wsf, r32, hi);
  LAS _Float16* stg = (LAS _Float16*)(lds + AT_OST + wid * 4096);
#pragma unroll
  for (int r = 0; r < 16; ++r) {
    const int orow = crow(r, hi);
    stg[orow * 64 + r32] = (_Float16)o[0][r];
    stg[orow * 64 + 32 + r32] = (_Float16)o[1][r];
  }
  const int t3 = otid(), lane3 = t3 & 63, wid3 = t3 >> 6;
#pragma unroll
  for (int i = 0; i < 4; ++i) {
    const int row = i * 8 + (lane3 >> 3), ch = lane3 & 7;
    const h8 v = *(const LAS h8*)(stg + row * 64 + ch * 8);
    const int t = q0 + wid3 * 32 + row;
    const h8 z = *reinterpret_cast<const h8*>(hmp(p, SL_ZA + h, b, t) + ch * 8);
    h8 ov;
#pragma unroll
    for (int j = 0; j < 8; ++j) ov[j] = (_Float16)((float)v[j] * silu((float)z[j]));
    *reinterpret_cast<h8*>(p.cat() + ((size_t)b * S_ + t) * DM + h * 64 + ch * 8) = ov;
  }
  __syncthreads();
}

__device__ __forceinline__ void nsa_unit(const P& p, LAS unsigned char* lds, int b, int h, int qblk) {
  const int tid = otid(), lane = tid & 63, r32 = lane & 31, hi = lane >> 5;
  const int wid = __builtin_amdgcn_readfirstlane(tid >> 6);
  const int q0 = qblk * 256, g = h >> 2;
  const int tq = q0 + wid * 32 + r32;
  h8 qf[4];
  const __half* qrow = hmp(p, SL_QB + h, b, tq);
#pragma unroll
  for (int d0 = 0; d0 < 4; ++d0) qf[d0] = *reinterpret_cast<const h8*>(qrow + d0 * 16 + hi * 8);
  const unsigned long long rowmask = p.sel()[((size_t)b * 2 + g) * S_ + tq];
  const float slope = exp2f(-(float)(h + 1));
  const float slope2 = slope * LOG2E;
  f32x16 bfix;
  {
    const float sb = slope * 8.f;
    const int qrel = wid * 32 + r32;
#pragma unroll
    for (int r = 0; r < 16; ++r) bfix[r] = sb * (float)((r & 3) + 8 * (r >> 2) + 4 * hi - qrel);
  }
  LAS float* wsf = (LAS float*)(lds + AT_WS) + wid * 64;
  f32x16 o[2]; float l_tot;
  LAS float* st32 = (LAS float*)(lds + AT_OST + wid * 8192);
  const float ubc_s = score_bound(p, qf, b, SL_KV6 + 4 + g), ubc_w = score_bound(p, qf, b, SL_KV6 + 8 + g);
  put_q(lds, qf, wid, lane);
  flash_pipe<M_SLC>(lds, hmp(p, SL_KV6 + 4 + g, b, 0), hmp(p, SL_KV6 + 6 + g, b, 0), q0, 0, 4 * qblk + 3, bfix, slope2, rowmask, ubc_s, o, l_tot);
  if (PROBE == 11 || PROBE == 13) flash_pipe<M_SLC>(lds, hmp(p, SL_KV6 + 4 + g, b, 0), hmp(p, SL_KV6 + 6 + g, b, 0), q0, 0, 4 * qblk + 3, bfix, slope2, rowmask, ubc_s, o, l_tot);
  {
    const int t2 = otid(), tq2 = q0 + (t2 >> 6) * 32 + (t2 & 31);
    const float g1 = p.gate()[((size_t)b * S_ + tq2) * 24 + h * 3 + 1];
    scale_rows(o, g1 / fmaxf(l_tot, 1e-30f), wsf, r32, hi);
  }
#pragma unroll
  for (int r = 0; r < 16; ++r) { const int orow = crow(r, hi); st32[orow * 64 + r32] = o[0][r]; st32[orow * 64 + 32 + r32] = o[1][r]; }
  const int wlo = qblk >= 2 ? 4 * qblk - 8 : 0;
  flash_pipe<M_WIN>(lds, hmp(p, SL_KV6 + 8 + g, b, 0), hmp(p, SL_KV6 + 10 + g, b, 0), q0, wlo, 4 * qblk + 3, bfix, slope2, 0ull, ubc_w, o, l_tot);
  if (PROBE == 11 || PROBE == 13) flash_pipe<M_WIN>(lds, hmp(p, SL_KV6 + 8 + g, b, 0), hmp(p, SL_KV6 + 10 + g, b, 0), q0, wlo, 4 * qblk + 3, bfix, slope2, 0ull, ubc_w, o, l_tot);
  {
    const int t2 = otid(), tq2 = q0 + (t2 >> 6) * 32 + (t2 & 31);
    const float g2 = p.gate()[((size_t)b * S_ + tq2) * 24 + h * 3 + 2];
    scale_rows(o, g2 / fmaxf(l_tot, 1e-30f), wsf, r32, hi);
  }
  LAS _Float16* stg = (LAS _Float16*)(lds + AT_OST + wid * 8192);
  {
    float tmp0[16], tmp1[16];
#pragma unroll
    for (int r = 0; r < 16; ++r) { const int orow = crow(r, hi); tmp0[r] = st32[orow * 64 + r32] + o[0][r]; tmp1[r] = st32[orow * 64 + 32 + r32] + o[1][r]; }
    __builtin_amdgcn_wave_barrier();
#pragma unroll
    for (int r = 0; r < 16; ++r) { const int orow = crow(r, hi); stg[orow * 64 + r32] = (_Float16)tmp0[r]; stg[orow * 64 + 32 + r32] = (_Float16)tmp1[r]; }
  }
  const int t3 = otid(), lane3 = t3 & 63, wid3 = t3 >> 6;
#pragma unroll
  for (int i = 0; i < 4; ++i) {
    const int row = i * 8 + (lane3 >> 3), ch = lane3 & 7;
    const h8 v = *(const LAS h8*)(stg + row * 64 + ch * 8);
    const int t = q0 + wid3 * 32 + row;
    const h8 z = *reinterpret_cast<const h8*>(hmp(p, SL_ZB + h, b, t) + ch * 8);
    const float g0 = p.gate()[((size_t)b * S_ + t) * 24 + h * 3];
    const h8 oc = *reinterpret_cast<const h8*>(p.ocmph() + (((size_t)b * 8 + h) * S_ + t) * 64 + ch * 8);
    h8 ov;
#pragma unroll
    for (int j = 0; j < 8; ++j) ov[j] = (_Float16)(((float)v[j] + g0 * (float)oc[j]) * silu((float)z[j]));
    *reinterpret_cast<h8*>(p.cat() + ((size_t)b * S_ + t) * DM + 512 + h * 64 + ch * 8) = ov;
  }
  __syncthreads();
}


constexpr int CM_HID = 0;
constexpr int CM_X = 9216;
__device__ __forceinline__ void cm_unit(const P& p, LAS unsigned char* lds, int which, int b, int g, int mt) {
  const int tid = otid(), lane = tid & 63, r = lane & 15, q = lane >> 4;
  const int wid = __builtin_amdgcn_readfirstlane(tid >> 6);
  const int c0 = mt * 32;
  const __half* xs = hmp(p, SL_KV6 + 2 * which + g, b, 0) + (size_t)c0 * 1024;
  for (int pc = wid; pc < 66; pc += 8) glds16(xs + (size_t)pc * 512 + lane * 8, lds + CM_X + pc * 1040);
  const __half* bp = p.w1t() + ((size_t)which * 128 + wid * 16 + r) * 2048 + q * 8;
  const __half* pp = p.peh() + which * 2048 + q * 8;
  asm volatile("s_waitcnt vmcnt(0)" ::: "memory");
  __syncthreads();
  f32x4 acc0 = {0.f, 0.f, 0.f, 0.f}, acc1 = {0.f, 0.f, 0.f, 0.f};
  const LAS unsigned char* a0l = lds + CM_X + (2 * r) * 1040 + q * 16;
  const LAS unsigned char* a1l = lds + CM_X + (2 * (16 + r)) * 1040 + q * 16;
#pragma unroll 8
  for (int s = 0; s < 64; ++s) {
    const int off = (s >> 4) * 1040 + ((s >> 1) & 7) * 128 + (s & 1) * 64;
    const h8 pe = *reinterpret_cast<const h8*>(pp + s * 32);
    const h8 a0 = *(const LAS h8*)(a0l + off) + pe;
    const h8 a1 = *(const LAS h8*)(a1l + off) + pe;
    const h8 bf = *reinterpret_cast<const h8*>(bp + s * 32);
    acc0 = __builtin_amdgcn_mfma_f32_16x16x32_f16(a0, bf, acc0, 0, 0, 0);
    acc1 = __builtin_amdgcn_mfma_f32_16x16x32_f16(a1, bf, acc1, 0, 0, 0);
  }
  LAS _Float16* hid = (LAS _Float16*)(lds + CM_HID);
#pragma unroll
  for (int reg = 0; reg < 4; ++reg) {
    hid[(4 * q + reg) * 136 + wid * 16 + r] = (_Float16)silu(acc0[reg]);
    hid[(16 + 4 * q + reg) * 136 + wid * 16 + r] = (_Float16)silu(acc1[reg]);
  }
  __syncthreads();
  {
    const int mi = wid >> 2, ni = wid & 3;
    const __half* w2p = p.w2t() + ((size_t)which * 64 + ni * 16 + r) * 128 + q * 8;
    f32x4 acc = {0.f, 0.f, 0.f, 0.f};
#pragma unroll
    for (int s = 0; s < 4; ++s) {
      const h8 a = *(const LAS h8*)(hid + (mi * 16 + r) * 136 + s * 32 + q * 8);
      const h8 bf = *reinterpret_cast<const h8*>(w2p + s * 32);
      acc = __builtin_amdgcn_mfma_f32_16x16x32_f16(a, bf, acc, 0, 0, 0);
    }
    __half* dst = (which ? p.vch() : p.kch()) + ((size_t)b * 2 + g) * 256 * 64;
#pragma unroll
    for (int reg = 0; reg < 4; ++reg) {
      const int c = c0 + mi * 16 + 4 * q + reg;
      dst[(size_t)c * 64 + ni * 16 + r] = __float2half(c < 255 ? acc[reg] : 0.f);
    }
  }
  __syncthreads();
}

constexpr int CS_K = 0, CS_V = 32768, CS_SLAB = 65536, CS_SLAB_BYTES = 8 * 32 * 65 * 4, CS_WS = CS_SLAB + CS_SLAB_BYTES, CS_LDS = CS_WS + 2048;
__device__ __forceinline__ void cs_super(const P& p, LAS unsigned char* lds, int b, int g, int j) {
  const int tid = otid(), lane = tid & 63, r32 = lane & 31, hi = lane >> 5;
  const int wid = __builtin_amdgcn_readfirstlane(tid >> 6);
  const int hh = wid & 3, qi = wid >> 2, h = g * 4 + hh;
  const size_t bg = (size_t)b * 2 + g;
  {
    const __half* ksrc = p.kch() + bg * 256 * 64 + (size_t)lane * 64 + wid * 8;
    const __half* vsrc = p.vch() + bg * 256 * 64 + (size_t)(16 * (wid & 3) + (lane >> 2)) * 64 + (wid >> 2) * 32 + (lane & 3) * 8;
    for (int kt = 0; kt < 4; ++kt) {
      glds16(ksrc + (size_t)kt * 4096, lds + CS_K + kt * 8192 + wid * 1024);
      glds16(vsrc + (size_t)kt * 4096, lds + CS_V + kt * 8192 + wid * 1024);
    }
  }
  asm volatile("s_waitcnt vmcnt(0)" ::: "memory");
  __syncthreads();
  for (int oi = 0; oi < 4; ++oi) {
  const int own = oi == 0 ? j : oi == 1 ? 31 - j : oi == 2 ? 32 + j : 63 - j;
  const int q0 = own * 64;
  const int ntile = (4 * own + 66) >> 6;
  const int tq = q0 + qi * 32 + r32;
  const int ncv = tq >= 31 ? ((tq - 31) >> 4) + 1 : 0;
  h8 qf[4];
  const __half* qrow = hmp(p, SL_QB + h, b, tq);
#pragma unroll
  for (int d0 = 0; d0 < 4; ++d0) qf[d0] = *reinterpret_cast<const h8*>(qrow + d0 * 16 + hi * 8);
  const LAS unsigned char* kp0 = lds + CS_K + hi * 1024 + r32 * 16;
  const LAS unsigned char* vp0 = lds + CS_V + ((lane >> 4) & 1) * 32 + (lane & 3) * 8 + (4 * hi + ((lane & 15) >> 2)) * 64;
  const f32x16 zero16 = {0.f, 0.f, 0.f, 0.f, 0.f, 0.f, 0.f, 0.f, 0.f, 0.f, 0.f, 0.f, 0.f, 0.f, 0.f, 0.f};
  float m = -1e30f, l = 0.f;
  for (int kt = 0; kt < ntile; ++kt) {
    const LAS unsigned char* kp = kp0 + kt * 8192;
    f32x16 p0 = zero16, p1 = zero16;
#pragma unroll
    for (int d0 = 0; d0 < 4; ++d0) {
      const h8 k0f = *(const LAS h8*)(kp + d0 * 2048), k1f = *(const LAS h8*)(kp + d0 * 2048 + 512);
      p0 = __builtin_amdgcn_mfma_f32_32x32x16_f16(k0f, qf[d0], p0, 0, 0, 0);
      p1 = __builtin_amdgcn_mfma_f32_32x32x16_f16(k1f, qf[d0], p1, 0, 0, 0);
    }
    const int rel = ncv - 1 - 64 * kt - 4 * hi;
    float mx = -1e30f;
#pragma unroll
    for (int r = 0; r < 16; ++r) {
      const int e0 = (r & 3) + 8 * (r >> 2);
      p0[r] = e0 <= rel ? p0[r] : -1e30f; p1[r] = e0 + 32 <= rel ? p1[r] : -1e30f;
      mx = fmaxf(mx, fmaxf(p0[r], p1[r]));
    }
    mx = fmaxf(mx, __shfl_xor(mx, 32, 64));
    const float mn = fmaxf(m, mx * C2);
    float ls = 0.f;
#pragma unroll
    for (int r = 0; r < 16; ++r) ls += __builtin_amdgcn_exp2f(__builtin_fmaf(p0[r], C2, -mn)) + __builtin_amdgcn_exp2f(__builtin_fmaf(p1[r], C2, -mn));
    l = l * __builtin_amdgcn_exp2f(m - mn) + ls;
    m = mn;
  }
  float l_tot = l + __shfl_xor(l, 32, 64);
  const float inv = ncv > 0 ? 1.f / fmaxf(l_tot, 1e-30f) : 0.f;
  const float nm = ncv > 0 ? -m : -INFINITY;
  f32x16 o[2]; o[0] = zero16; o[1] = zero16;
  LAS float* slab = (LAS float*)(lds + CS_SLAB) + ((qi * 4 + hh) * 32 + r32) * 65;
  float carry = 0.f;
  for (int kt = 0; kt < ntile; ++kt) {
    const LAS unsigned char* kp = kp0 + kt * 8192;
    const LAS unsigned char* vp = vp0 + kt * 8192;
    f32x16 p0 = zero16, p1 = zero16;
#pragma unroll
    for (int d0 = 0; d0 < 4; ++d0) {
      const h8 k0f = *(const LAS h8*)(kp + d0 * 2048), k1f = *(const LAS h8*)(kp + d0 * 2048 + 512);
      p0 = __builtin_amdgcn_mfma_f32_32x32x16_f16(k0f, qf[d0], p0, 0, 0, 0);
      p1 = __builtin_amdgcn_mfma_f32_32x32x16_f16(k1f, qf[d0], p1, 0, 0, 0);
    }
    const int rel = ncv - 1 - 64 * kt - 4 * hi;
#pragma unroll
    for (int r = 0; r < 16; ++r) {
      const int e0 = (r & 3) + 8 * (r >> 2);
      const float a0 = e0 <= rel ? p0[r] : -1e30f, a1 = e0 + 32 <= rel ? p1[r] : -1e30f;
      p0[r] = __builtin_amdgcn_exp2f(__builtin_fmaf(a0, C2, nm)) * inv;
      p1[r] = __builtin_amdgcn_exp2f(__builtin_fmaf(a1, C2, nm)) * inv;
    }
#pragma unroll
    for (int n = 0; n < 2; ++n) {
#pragma unroll
      for (int rg = 0; rg < 4; ++rg) {
        const float t3 = n == 0 ? p0[4 * rg + 3] : p1[4 * rg + 3];
        const float gs = n == 0 ? (p0[4 * rg] + p0[4 * rg + 1]) + (p0[4 * rg + 2] + t3) : (p1[4 * rg] + p1[4 * rg + 1]) + (p1[4 * rg + 2] + t3);
        const float tp = __shfl_xor(t3, 32, 64);
        slab[2 * (8 * kt + 4 * n + rg) + hi] = gs + (hi ? tp : carry);
        carry = tp;
      }
    }
    h8 pa[4];
#pragma unroll
    for (int j = 0; j < 8; ++j) { pa[0][j] = (_Float16)p0[j]; pa[1][j] = (_Float16)p0[8 + j]; pa[2][j] = (_Float16)p1[j]; pa[3][j] = (_Float16)p1[8 + j]; }
#pragma unroll
    for (int s = 0; s < 4; ++s) {
#pragma unroll
      for (int dh = 0; dh < 2; ++dh) {
        const h4 lo = vtr(vp + dh * 4096 + s * 1024), hv = vtr(vp + dh * 4096 + s * 1024 + 512);
        const h8 vf = __builtin_shufflevector(lo, hv, 0, 1, 2, 3, 4, 5, 6, 7);
        o[dh] = __builtin_amdgcn_mfma_f32_32x32x16_f16(pa[s], vf, o[dh], 0, 0, 0);
      }
    }
  }
  __syncthreads();
  if (own < 16) {
    if (tid < 64) p.sel()[bg * S_ + q0 + tid] = (2ull << own) - 1ull;
  } else {
    const LAS float* sl = (const LAS float*)(lds + CS_SLAB);
    const int jj = lane;
    const bool cand = (jj >= 1) && (jj <= own - 2);
    const unsigned long long forced = 1ull | (1ull << own) | (1ull << (own - 1));
    for (int i = 0; i < 8; ++i) {
      const int qq = wid * 8 + i, q2 = qq >> 5, rr = qq & 31;
      float v = 0.f;
#pragma unroll
      for (int x = 0; x < 4; ++x) v += sl[((q2 * 4 + x) * 32 + rr) * 65 + jj];
      const unsigned key = cand ? (__float_as_uint(v) + 1u) : 0u;
      unsigned th = 0u;
#pragma unroll
      for (int bit = 30; bit >= 0; --bit) {
        const unsigned c = th | (1u << bit);
        const int cnt = __popcll(__ballot(key >= c));
        th = cnt >= 13 ? c : th;
      }
      const unsigned long long gt = __ballot(key > th), eq = __ballot(key == th);
      const int need = 13 - __popcll(gt);
      unsigned long long t = eq;
      for (int k = 0; k < need; ++k) t &= t - 1ull;
      const unsigned long long msk = gt | (eq ^ t) | forced;
      if (lane == 0) p.sel()[bg * S_ + q0 + qq] = msk;
    }
  }
  __syncthreads();
  {
    LAS _Float16* stg = (LAS _Float16*)(lds + CS_SLAB + wid * 4096);
#pragma unroll
    for (int r = 0; r < 16; ++r) {
      const int orow = crow(r, hi);
      stg[orow * 64 + r32] = (_Float16)o[0][r];
      stg[orow * 64 + 32 + r32] = (_Float16)o[1][r];
    }
#pragma unroll
    for (int i = 0; i < 4; ++i) {
      const int row = i * 8 + (lane >> 3), ch = lane & 7;
      const h8 v = *(const LAS h8*)(stg + row * 64 + ch * 8);
      const int t = q0 + qi * 32 + row;
      *reinterpret_cast<h8*>(p.ocmph() + (((size_t)b * 8 + h) * S_ + t) * 64 + ch * 8) = v;
    }
  }
  __syncthreads();
  }
}

#define XB_TMO      128
#define XB_XCNT(j)  (256  + 64 * (j))
#define XB_XSUB(j)  (1280 + 64 * (j))
#define XB_XGEN(j)  (2304 + 64 * (j))
#define XB_TOP      3328
#define XB_TOPGEN   3392
#define XCD_BAR_WORDS 3456
#define XB_SPIN_CAP (1u << 18)
__device__ __forceinline__ unsigned xb_ld(unsigned* p) { return __hip_atomic_load(p, __ATOMIC_RELAXED, __HIP_MEMORY_SCOPE_AGENT); }
__device__ __forceinline__ unsigned xb_add(unsigned* p, unsigned v) { return __hip_atomic_fetch_add(p, v, __ATOMIC_RELAXED, __HIP_MEMORY_SCOPE_AGENT); }
__device__ __forceinline__ unsigned xb_xcc_id() { return (unsigned)__builtin_amdgcn_s_getreg((3 << 11) | 20) & 0xFu; }
#define XB_SPIN(cond, bar) do { unsigned _sp = 0; while (cond) { __builtin_amdgcn_s_sleep(1); \
    if ((++_sp & 255u) == 0u) { if (xb_ld(&(bar)[XB_TMO])) break; if (_sp > XB_SPIN_CAP) { atomicAdd(&(bar)[XB_TMO], 1u); break; } } } } while (0)
struct XcdBarrier { unsigned* bar; unsigned x; volatile LAS unsigned* st; };
__device__ __forceinline__ XcdBarrier xcd_barrier_post(unsigned* bar, volatile LAS unsigned* st) {
  XcdBarrier b; b.bar = bar; b.x = xb_xcc_id(); b.st = st;
  if (threadIdx.x == 0) (void)xb_add(&bar[XB_XCNT(b.x)], 1u);
  return b;
}
__device__ __forceinline__ void xcd_barrier_complete(unsigned* bar, unsigned x, unsigned& nloc, unsigned& nx) {
  const unsigned G = gridDim.x * gridDim.y * gridDim.z;
  unsigned sum, cnt, mine, sp = 0u;
  for (;;) {
    sum = 0u; cnt = 0u; mine = 0u;
#pragma unroll
    for (unsigned j = 0; j < 16; ++j) { const unsigned c = xb_ld(&bar[XB_XCNT(j)]); sum += c; cnt += (c > 0u) ? 1u : 0u; mine = (j == x) ? c : mine; }
    if (sum == G) break;
    __builtin_amdgcn_s_sleep(1);
    if ((++sp & 255u) == 0u) { if (xb_ld(&bar[XB_TMO])) break; if (sp > XB_SPIN_CAP) { atomicAdd(&bar[XB_TMO], 1u); break; } }
  }
  nloc = mine > 0u ? mine : 1u; nx = cnt > 0u ? cnt : 1u;
}
__device__ __forceinline__ void xcd_barrier(const XcdBarrier& b) {
  asm volatile("s_waitcnt vmcnt(0)" ::: "memory");
  __syncthreads();
  if (threadIdx.x == 0) {
    unsigned* bar = b.bar;
    __builtin_amdgcn_s_waitcnt(0);
    unsigned nloc = b.st[0], nx = b.st[1];
    if (nloc == 0u) { xcd_barrier_complete(bar, b.x, nloc, nx); b.st[0] = nloc; b.st[1] = nx; }
    const unsigned old = xb_add(&bar[XB_XSUB(b.x)], 1u);
    const unsigned gen = old / nloc;
    if (old + 1u == (gen + 1u) * nloc) {
      __builtin_amdgcn_fence(__ATOMIC_RELEASE, "agent");
      asm volatile("s_waitcnt vmcnt(0)" ::: "memory");
      const unsigned og = xb_add(&bar[XB_TOP], 1u);
      const unsigned tg = og / nx;
      if (og + 1u == (tg + 1u) * nx) xb_add(&bar[XB_TOPGEN], 1u);
      else XB_SPIN(xb_ld(&bar[XB_TOPGEN]) == tg, bar);
      __builtin_amdgcn_fence(__ATOMIC_ACQUIRE, "agent");
      xb_add(&bar[XB_XGEN(b.x)], 1u);
      asm volatile("s_waitcnt vmcnt(0)" ::: "memory");
    } else {
      XB_SPIN(xb_ld(&bar[XB_XGEN(b.x)]) == gen, bar);
      __builtin_amdgcn_fence(__ATOMIC_ACQUIRE, "agent");
      asm volatile("s_waitcnt vmcnt(0)" ::: "memory");
    }
  }
  __syncthreads();
}

__device__ __forceinline__ int cap_tiles(int h) { return h == 0 ? 6 : h == 1 ? 7 : h == 2 ? 10 : h == 3 ? 15 : h == 4 ? 26 : h == 5 ? 48 : 64; }
__device__ __forceinline__ int unit_cost(int mode, int pi) {
  const int h = pi >> 4, blk = pi & 15, cap = cap_tiles(h);
  const int full = 4 * (blk + 1);
  if (mode == 0) return min(full, cap);
  return min(full, cap) + min(min(full, 12), cap) + 2;
}
__device__ __forceinline__ void build_order(LAS unsigned char* lds, int mode) {
  LAS short* ord = (LAS short*)(lds + AT_ORD);
  const int i = threadIdx.x;
  if (i < 128) {
    const int ci = unit_cost(mode, i);
    int rank = 0;
    for (int j = 0; j < 128; ++j) { const int cj = unit_cost(mode, j); rank += (cj > ci) || (cj == ci && j < i); }
    ord[rank] = (short)i;
  }
  __syncthreads();
}
__device__ __forceinline__ int queue_next(unsigned* ctr, LAS unsigned char* lds) {
  LAS int* slot = (LAS int*)(lds + AT_QS);
  if (threadIdx.x == 0) *slot = (int)atomicAdd(ctr, 1u);
  __syncthreads();
  const int v = *slot;
  __syncthreads();
  return v;
}
constexpr int XB_ST_OFF = (CS_LDS > STAGE_BYTES ? CS_LDS : STAGE_BYTES) > AT_LDS ? (CS_LDS > STAGE_BYTES ? CS_LDS : STAGE_BYTES) : AT_LDS;
constexpr int MEGA_LDS = XB_ST_OFF + 16;

__global__ __launch_bounds__(512, 2) void mega(P p) {
  extern __shared__ __attribute__((aligned(16))) unsigned char shm[];
  LAS unsigned char* lds = (LAS unsigned char*)shm;
  const int bid = blockIdx.x, nblk = gridDim.x;
  if (threadIdx.x < 4) ((LAS unsigned*)(lds + XB_ST_OFF))[threadIdx.x] = 0u;
  __syncthreads();
  const XcdBarrier xb = xcd_barrier_post(p.xbar(), (volatile LAS unsigned*)(lds + XB_ST_OFF));
  for (int rep = 0; rep < (PROBE == 10 ? 2 : 1); ++rep) phase_prep(p, lds, bid, nblk);
  xcd_barrier(xb);
  if (PROBE == 9) { for (int i = 0; i < 6; ++i) xcd_barrier(xb); }
  {
    StaticOrder S; S.init(T_, NP - 256, nblk, bid, PROBE == 1 ? 2 : PROBE == 21 ? 3 : 1);
    EpiProj E{p.hm(), p.rstd(), p.kmp(), p.kn2(), 0};
    gemm_phase<EpiProj>(lds, p.xh(), p.wt(), T_, NP - 256, DM, S, E);
  }
  xcd_barrier(xb);
  if (nblk >= 256) {
    if (bid < 128) {
      StaticOrder S; S.init(T_, 256, 128, bid, 1);
      EpiProj E{p.hm(), p.rstd(), p.kmp(), p.kn2(), 14};
      gemm_phase<EpiProj>(lds, p.xh(), p.wt() + (size_t)14 * 256 * DM, T_, 256, DM, S, E);
    } else if (bid < 256) {
      for (int u = (bid - 128) * 2; u < (bid - 128) * 2 + 2; ++u) cm_unit(p, lds, u >> 7, (u >> 4) & 7, (u >> 3) & 1, u & 7);
    }
  } else {
    { StaticOrder S; S.init(T_, 256, nblk, bid, 1);
      EpiProj E{p.hm(), p.rstd(), p.kmp(), p.kn2(), 14};
      gemm_phase<EpiProj>(lds, p.xh(), p.wt() + (size_t)14 * 256 * DM, T_, 256, DM, S, E); }
    for (int u = bid; u < 2 * 8 * 2 * 8; u += nblk) cm_unit(p, lds, u >> 7, (u >> 4) & 7, (u >> 3) & 1, u & 7);
  }
  for (int rep = 0; rep < (PROBE == 3 ? 2 : PROBE == 23 ? 3 : 1); ++rep) {
    build_order(lds, 0);
    for (;;) {
      const int u = queue_next(p.qctr() + 0 + 2 * rep, lds);
      if (u >= 8 * 8 * 16) break;
      const int pi = ((const LAS short*)(lds + AT_ORD))[u >> 3];
      moba_unit(p, lds, u & 7, pi >> 4, pi & 15);
    }
  }
  xcd_barrier(xb);
  for (int rep = 0; rep < (PROBE == 4 ? 2 : 1); ++rep)
    for (int su = bid; su < 256; su += nblk) cs_super(p, lds, (su & 15) >> 1, su & 1, su >> 4);
  xcd_barrier(xb);
  for (int rep = 0; rep < (PROBE == 5 ? 2 : PROBE == 25 ? 3 : 1); ++rep) {
    build_order(lds, 1);
    for (;;) {
      const int u = queue_next(p.qctr() + 1 + 2 * rep, lds);
      if (u >= 8 * 8 * 16) break;
      const int pi = ((const LAS short*)(lds + AT_ORD))[u >> 3];
      nsa_unit(p, lds, u & 7, pi >> 4, pi & 15);
    }
  }
  xcd_barrier(xb);
  {
    StaticOrder S; S.init(T_, DM, nblk, bid, PROBE == 6 ? 2 : 1);
    EpiY E{p.hm(), p.ssq()};
    gemm_phase<EpiY>(lds, p.cat(), p.wot(), T_, DM, DM, S, E);
  }
  xcd_barrier(xb);
  for (int rep = 0; rep < (PROBE == 7 ? 2 : 1); ++rep) phase_post(p, bid, nblk);
}

}


extern "C" void kernel_launch(void* const* d_in, const int* in_sizes, int n_in, void* d_out, int out_size, void* d_ws,
                              size_t ws_size, hipStream_t stream) {
  P p{};
  p.x = (const float*)d_in[0]; p.g_pre = (const float*)d_in[1]; p.g_post = (const float*)d_in[2];
  p.w_in = (const float*)d_in[3]; p.pe_k = (const float*)d_in[4]; p.pe_v = (const float*)d_in[5];
  p.wk1 = (const float*)d_in[6]; p.wk2 = (const float*)d_in[7]; p.wv1 = (const float*)d_in[8]; p.wv2 = (const float*)d_in[9];
  p.w_out = (const float*)d_in[10]; p.out = (float*)d_out;
  p.ws = (char*)d_ws;
  if (ws_size < WS_END) { fprintf(stderr, "workspace too small\n"); return; }

  static int grid_blocks = 0;
  if (!grid_blocks) {
    int dev = 0, cus = 0, per_cu = 0;
    (void)hipGetDevice(&dev);
    (void)hipDeviceGetAttribute(&cus, hipDeviceAttributeMultiprocessorCount, dev);
    (void)hipFuncSetAttribute((const void*)mega, hipFuncAttributeMaxDynamicSharedMemorySize, MEGA_LDS);
    (void)hipOccupancyMaxActiveBlocksPerMultiprocessor(&per_cu, (const void*)mega, 512, MEGA_LDS);
    if (per_cu < 1) per_cu = 1;
    if (per_cu > 1) per_cu = 1;
    grid_blocks = cus * per_cu;
  }
  (void)hipMemsetAsync((char*)d_ws + OFF_XBAR, 0, (size_t)3456 * 4, stream);
  hipLaunchKernelGGL(mega, dim3(grid_blocks), dim3(512), MEGA_LDS, stream, p);
  hipError_t e = hipPeekAtLastError();
  if (e != hipSuccess) fprintf(stderr, "launch failed: %s (grid %d)\n", hipGetErrorString(e), grid_blocks);
}
```

```cpp
#include <hip/hip_runtime.h>
#include <hip/hip_fp16.h>
#include <hip/hip_cooperative_groups.h>
#include <cstdio>
#include <stdint.h>

#define PROBE 0
namespace {

#define LAS __attribute__((address_space(3)))
typedef _Float16 h8 __attribute__((ext_vector_type(8)));
typedef _Float16 h4 __attribute__((ext_vector_type(4)));
typedef float f32x4 __attribute__((ext_vector_type(4)));
typedef float f32x16 __attribute__((ext_vector_type(16)));
typedef unsigned u32x4 __attribute__((ext_vector_type(4)));

__device__ __forceinline__ int otid() { int t = threadIdx.x; asm volatile("" : "+v"(t)); return t; }

constexpr int B_ = 8, S_ = 4096, DM = 1024, DIN = 3864, T_ = B_ * S_;
constexpr int NP = 3840;
constexpr float EPS = 1e-6f;
constexpr int SL_QA = 0, SL_KA = 8, SL_VA = 16, SL_ZA = 24, SL_QB = 32, SL_KV6 = 40, SL_ZB = 52;

constexpr size_t al256(size_t x) { return (x + 255) & ~(size_t)255; }
constexpr size_t OFF_XH = 0;
constexpr size_t OFF_WT = OFF_XH + al256((size_t)T_ * 1024 * 2);
constexpr size_t OFF_WOT = OFF_WT + al256((size_t)NP * 1024 * 2);
constexpr size_t OFF_RSTD = OFF_WOT + al256((size_t)1024 * 1024 * 2);
constexpr size_t OFF_GATE = OFF_RSTD + al256((size_t)T_ * 4);
constexpr size_t OFF_KMP = OFF_GATE + al256((size_t)T_ * 24 * 4);
constexpr size_t OFF_KN2 = OFF_KMP + al256((size_t)8 * 8 * 16 * 2 * 64 * 4);
constexpr size_t OFF_QCTR = OFF_KN2 + al256((size_t)8 * 60 * 2 * 4);
constexpr size_t OFF_XBAR = OFF_QCTR + 256;
constexpr size_t OFF_SSQ = OFF_XBAR + al256((size_t)3456 * 4);
constexpr size_t OFF_PCNT = OFF_SSQ + al256((size_t)T_ * 4);
constexpr size_t OFF_SSQ2 = OFF_PCNT + al256(256 * 4);
constexpr size_t OFF_PCNT2 = OFF_SSQ2 + al256((size_t)T_ * 4);
constexpr size_t OFF_SEL = OFF_PCNT2 + al256(256 * 4);
constexpr size_t OFF_KCH = OFF_SEL + al256((size_t)8 * 2 * 4096 * 8);
constexpr size_t OFF_VCH = OFF_KCH + al256((size_t)8 * 2 * 256 * 64 * 2);
constexpr size_t OFF_W1T = OFF_VCH + al256((size_t)8 * 2 * 256 * 64 * 2);
constexpr size_t OFF_W2T = OFF_W1T + al256((size_t)2 * 128 * 2048 * 2);
constexpr size_t OFF_PEH = OFF_W2T + al256((size_t)2 * 64 * 128 * 2);
constexpr size_t OFF_OCMPH = OFF_PEH + al256((size_t)2 * 2048 * 2);
constexpr size_t OFF_HM = OFF_OCMPH + al256((size_t)T_ * 512 * 2);
constexpr size_t OFF_CAT = OFF_HM + al256((size_t)60 * T_ * 64 * 2);
constexpr size_t WS_END = OFF_CAT + al256((size_t)T_ * 1024 * 2);

struct P {
  const float* x; const float* g_pre; const float* g_post; const float* w_in;
  const float* pe_k; const float* pe_v; const float* wk1; const float* wk2; const float* wv1; const float* wv2;
  const float* w_out; float* out;
  char* ws;
  __device__ __forceinline__ __half* xh() const { return (__half*)(ws + OFF_XH); }
  __device__ __forceinline__ __half* cat() const { return (__half*)(ws + OFF_CAT); }
  __device__ __forceinline__ __half* wt() const { return (__half*)(ws + OFF_WT); }
  __device__ __forceinline__ __half* wot() const { return (__half*)(ws + OFF_WOT); }
  __device__ __forceinline__ float* rstd() const { return (float*)(ws + OFF_RSTD); }
  __device__ __forceinline__ float* gate() const { return (float*)(ws + OFF_GATE); }
  __device__ __forceinline__ float* kmp() const { return (float*)(ws + OFF_KMP); }
  __device__ __forceinline__ unsigned* kn2() const { return (unsigned*)(ws + OFF_KN2); }
  __device__ __forceinline__ unsigned* qctr() const { return (unsigned*)(ws + OFF_QCTR); }
  __device__ __forceinline__ unsigned* xbar() const { return (unsigned*)(ws + OFF_XBAR); }
  __device__ __forceinline__ float* ssq() const { return (float*)(ws + OFF_SSQ); }
  __device__ __forceinline__ unsigned* pcnt() const { return (unsigned*)(ws + OFF_PCNT); }
  __device__ __forceinline__ unsigned long long* sel() const { return (unsigned long long*)(ws + OFF_SEL); }
  __device__ __forceinline__ __half* kch() const { return (__half*)(ws + OFF_KCH); }
  __device__ __forceinline__ __half* vch() const { return (__half*)(ws + OFF_VCH); }
  __device__ __forceinline__ __half* w1t() const { return (__half*)(ws + OFF_W1T); }
  __device__ __forceinline__ __half* w2t() const { return (__half*)(ws + OFF_W2T); }
  __device__ __forceinline__ __half* peh() const { return (__half*)(ws + OFF_PEH); }
  __device__ __forceinline__ __half* ocmph() const { return (__half*)(ws + OFF_OCMPH); }
  __device__ __forceinline__ __half* hm() const { return (__half*)(ws + OFF_HM); }
};

__device__ __forceinline__ const __half* hmp(const P& p, int slot, int b, int t) {
  return p.hm() + (((size_t)slot * T_) + (size_t)b * S_ + t) * 64;
}

__device__ __forceinline__ float wave_sum(float v) {
#pragma unroll
  for (int o = 32; o > 0; o >>= 1) v += __shfl_xor(v, o, 64);
  return v;
}
__device__ __forceinline__ float silu(float v) { return v * __builtin_amdgcn_rcpf(1.f + __builtin_amdgcn_exp2f(-1.4426950408889634f * v)); }

constexpr int PREP_WG_OFF = 0;
constexpr int PREP_TILE_OFF = 65536;
constexpr int PREP_LDS = 65536 + 64 * 65 * 4;

__device__ __forceinline__ void tr_tile(const float* src, int ldS, int k0, int n0s, __half* dst, int ldD, int n0d,
                                        const float* scale, LAS float* tile, int tid) {
  {
    const int i = tid >> 4, jj = (tid & 15) * 4;
#pragma unroll
    for (int h = 0; h < 2; ++h) {
      const int k = i + 32 * h;
      float4 v = *reinterpret_cast<const float4*>(src + (size_t)(k0 + k) * ldS + n0s + jj);
      const float sc = scale ? scale[k0 + k] : 1.f;
      tile[k * 65 + jj + 0] = v.x * sc; tile[k * 65 + jj + 1] = v.y * sc; tile[k * 65 + jj + 2] = v.z * sc; tile[k * 65 + jj + 3] = v.w * sc;
    }
  }
  __syncthreads();
  {
    const int n = tid >> 3, kc = (tid & 7) * 8;
    h8 o;
#pragma unroll
    for (int u = 0; u < 8; ++u) o[u] = (_Float16)tile[(kc + u) * 65 + n];
    *reinterpret_cast<h8*>(dst + (size_t)(n0d + n) * ldD + k0 + kc) = o;
  }
  __syncthreads();
}

__device__ __forceinline__ void prep_gate_image(const P& p, LAS unsigned char* lds) {
  const int tid = otid();
  LAS _Float16* wgl = (LAS _Float16*)(lds + PREP_WG_OFF);
#pragma unroll
  for (int rr = 0; rr < 2; ++rr) {
    const int k = tid + rr * 512;
    const f32x4* wrow = reinterpret_cast<const f32x4*>(p.w_in + (size_t)k * DIN + 3328);
    f32x4 w[6];
#pragma unroll
    for (int i = 0; i < 6; ++i) w[i] = wrow[i];
    const float gk = p.g_pre[k];
    const int s = k >> 5, q = (k >> 3) & 3, j = k & 7;
    LAS _Float16* dst = wgl + ((s * 4 + q) * 32) * 8 + j;
#pragma unroll
    for (int n = 0; n < 24; ++n) dst[n * 8] = (_Float16)(w[n >> 2][n & 3] * gk);
#pragma unroll
    for (int n = 24; n < 32; ++n) dst[n * 8] = (_Float16)0.f;
  }
  __syncthreads();
}
__device__ __forceinline__ void prep_xrows(const P& p, LAS unsigned char* lds, int row0, int lane) {
  const int r = lane & 15, q = lane >> 4;
  const float* xr = p.x + (size_t)(row0 + r) * DM + q * 8;
  __half* xo = p.xh() + (size_t)(row0 + r) * DM + q * 8;
  f32x4 acc0 = {0.f, 0.f, 0.f, 0.f}, acc1 = {0.f, 0.f, 0.f, 0.f};
  float ss = 0.f;
#pragma unroll 4
  for (int s = 0; s < 32; ++s) {
    const f32x4 v0 = __builtin_nontemporal_load(reinterpret_cast<const f32x4*>(xr + s * 32));
    const f32x4 v1 = __builtin_nontemporal_load(reinterpret_cast<const f32x4*>(xr + s * 32 + 4));
    ss += v0.x * v0.x + v0.y * v0.y + v0.z * v0.z + v0.w * v0.w + v1.x * v1.x + v1.y * v1.y + v1.z * v1.z + v1.w * v1.w;
    h8 a;
    a[0] = (_Float16)v0.x; a[1] = (_Float16)v0.y; a[2] = (_Float16)v0.z; a[3] = (_Float16)v0.w;
    a[4] = (_Float16)v1.x; a[5] = (_Float16)v1.y; a[6] = (_Float16)v1.z; a[7] = (_Float16)v1.w;
    *reinterpret_cast<h8*>(xo + s * 32) = a;
    const h8 b0 = *(const LAS h8*)(lds + PREP_WG_OFF + ((s * 4 + q) * 32 + r) * 16);
    const h8 b1 = *(const LAS h8*)(lds + PREP_WG_OFF + ((s * 4 + q) * 32 + 16 + r) * 16);
    acc0 = __builtin_amdgcn_mfma_f32_16x16x32_f16(a, b0, acc0, 0, 0, 0);
    acc1 = __builtin_amdgcn_mfma_f32_16x16x32_f16(a, b1, acc1, 0, 0, 0);
  }
  ss += __shfl_xor(ss, 16, 64);
  ss += __shfl_xor(ss, 32, 64);
  const float rs = rsqrtf(ss * (1.f / DM) + EPS);
  if (q == 0) p.rstd()[row0 + r] = rs;
#pragma unroll
  for (int reg = 0; reg < 4; ++reg) {
    const int row = q * 4 + reg;
    const float rr = __shfl(rs, row, 64);
    float* gp = p.gate() + (size_t)(row0 + row) * 24;
    gp[r] = 1.f / (1.f + __expf(-acc0[reg] * rr));
    if (r < 8) gp[16 + r] = 1.f / (1.f + __expf(-acc1[reg] * rr));
  }
}
__device__ __forceinline__ void prep_weights(const P& p, LAS unsigned char* lds, int bid, int nblk) {
  const int tid = otid();
  LAS float* tile = (LAS float*)(lds + PREP_TILE_OFF);
  constexpr int N_WIN = 16 * 60, N_WOUT = 16 * 16;
  constexpr int N_W1 = 2 * 64, N_W2 = 2 * 2;
  for (int it = bid; it < N_WIN + N_WOUT + N_W1 + N_W2; it += nblk) {
    if (it < N_WIN) {
      const int kb = it / 60, nb = it - kb * 60;
      const int n0d = nb * 64, n0s = n0d < 3328 ? n0d : n0d + 24;
      tr_tile(p.w_in, DIN, kb * 64, n0s, p.wt(), DM, n0d, p.g_pre, tile, tid);
    } else if (it < N_WIN + N_WOUT) {
      const int r = it - N_WIN, kb = r >> 4, nb = r & 15;
      tr_tile(p.w_out, DM, kb * 64, nb * 64, p.wot(), DM, nb * 64, nullptr, tile, tid);
    } else if (it < N_WIN + N_WOUT + N_W1) {
      const int r = it - N_WIN - N_WOUT, which = r >> 6, kb = (r & 63) >> 1, nb = r & 1;
      tr_tile(which ? p.wv1 : p.wk1, 128, kb * 64, nb * 64, p.w1t() + (size_t)which * 128 * 2048, 2048, nb * 64, nullptr, tile, tid);
    } else {
      const int r = it - N_WIN - N_WOUT - N_W1, which = r >> 1, kb = r & 1;
      tr_tile(which ? p.wv2 : p.wk2, 64, kb * 64, 0, p.w2t() + (size_t)which * 64 * 128, 128, 0, nullptr, tile, tid);
    }
  }
  for (int e = bid * 512 + tid; e < 8 * 60 * 2; e += nblk * 512) p.kn2()[e] = 0u;
  if (bid == 0 && tid < 8) p.qctr()[tid] = 0u;
  for (int e = bid * 512 + tid; e < T_; e += nblk * 512) p.ssq()[e] = 0.f;
  if (bid == 1 && tid < 256) p.pcnt()[tid] = 0u;
  if (PROBE == 6) { for (int e = bid * 512 + tid; e < T_; e += nblk * 512) ((float*)(p.ws + OFF_SSQ2))[e] = 0.f; if (bid == 3 && tid < 256) ((unsigned*)(p.ws + OFF_PCNT2))[tid] = 0u; }
  for (int e = bid * 512 + tid; e < 2 * 2048; e += nblk * 512) p.peh()[e] = __float2half(e < 2048 ? p.pe_k[e] : p.pe_v[e - 2048]);
}
__device__ __forceinline__ void phase_prep(const P& p, LAS unsigned char* lds, int bid, int nblk) {
  prep_gate_image(p, lds);
  const int tid = otid(), lane = tid & 63, wid = tid >> 6;
  for (int u = bid; u < T_ / 128; u += nblk) prep_xrows(p, lds, u * 128 + wid * 16, lane);
  __syncthreads();
  prep_weights(p, lds, bid, nblk);
}

constexpr int BM = 256, BK = 64, HALF = 128, HTB = HALF * BK * 2, STAGE_BYTES = 8 * HTB, NXCD = 8, WGM = 8;

__device__ __forceinline__ int lds_byte(int r, int c) { const int st = (r >> 4) * 2 + (c >> 5), rr = r & 15, cc = c & 31, ob = rr * 64 + cc * 2; return st * 1024 + (ob ^ (((ob >> 9) & 1) << 5)); }
__device__ __forceinline__ void stage_rc(int b, int& R, int& C) { const int st = b / 1024, sb = b % 1024, swz = sb ^ (((sb >> 9) & 1) << 5); R = (st >> 1) * 16 + swz / 64; C = (st & 1) * 32 + (swz % 64) / 2; }
__device__ __forceinline__ int perm32(int rho) { const int n = rho >> 4, i = rho & 15; return 8 * (i >> 2) + 4 * n + (i & 3); }

struct Unit { int pm, pn; };
struct StaticOrder {
  int nM, nN, nwg, G, c, rep;
  __device__ void init(int M, int N, int G_, int c_, int rep_ = 1) { nM = M / BM; nN = N / BM; nwg = nM * nN; G = G_; c = c_; rep = rep_; }
  __device__ bool next(int i, Unit& u) const {
    const long L = (long)i * G + c; if (L >= (long)nwg * rep) return false;
    int wgid = (int)(L % nwg); { const int q = nwg / NXCD, r = nwg % NXCD, xcd = wgid % NXCD, off = wgid / NXCD; wgid = (xcd < r ? xcd * (q + 1) : r * (q + 1) + (xcd - r) * q) + off; }
    const int nig = WGM * nN, gid = wgid / nig, fm = gid * WGM, gsz = (nM - fm) < WGM ? (nM - fm) : WGM;
    u.pm = fm + ((wgid % nig) % gsz); u.pn = (wgid % nig) / gsz; return true;
  }
};

struct EpiProj {
  static constexpr bool PERM = true;
  __half* hm; const float* rstd; float* kmp; unsigned* kn2; int pn_off;
  __device__ __forceinline__ void operator()(const f32x4 (&acc)[2][2][4][2], const Unit& u0, int wr, int wc, int fr, int fq) const {
    Unit u; u.pm = u0.pm; u.pn = u0.pn + pn_off;
    const int row0 = u.pm * BM + wr * 64 + fr;
    const int colb = u.pn * BM + wc * 32 + 8 * fq;
    const bool isK = (u.pn == 2) || (u.pn == 3);
    const bool hasK = isK || (u.pn == 11) || (u.pn == 12);
    float cs[2][8];
    float nmax[2] = {0.f, 0.f};
#pragma unroll
    for (int bj = 0; bj < 2; ++bj)
#pragma unroll
      for (int j = 0; j < 8; ++j) cs[bj][j] = 0.f;
    float rsv[2][4];
#pragma unroll
    for (int ai = 0; ai < 2; ++ai)
#pragma unroll
      for (int m = 0; m < 4; ++m) rsv[ai][m] = rstd[row0 + ai * HALF + m * 16];
    asm volatile("" : "+v"(rsv[0][0]), "+v"(rsv[0][1]), "+v"(rsv[0][2]), "+v"(rsv[0][3]), "+v"(rsv[1][0]), "+v"(rsv[1][1]), "+v"(rsv[1][2]), "+v"(rsv[1][3]));
#pragma unroll
    for (int ai = 0; ai < 2; ++ai)
#pragma unroll
      for (int m = 0; m < 4; ++m) {
        const int row = row0 + ai * HALF + m * 16;
        const float rs = rsv[ai][m];
#pragma unroll
        for (int bj = 0; bj < 2; ++bj) {
          const int c = colb + bj * HALF;
          const f32x4 v0 = acc[ai][bj][m][0] * rs, v1 = acc[ai][bj][m][1] * rs;
          h8 o;
          o[0] = (_Float16)v0[0]; o[1] = (_Float16)v0[1]; o[2] = (_Float16)v0[2]; o[3] = (_Float16)v0[3];
          o[4] = (_Float16)v1[0]; o[5] = (_Float16)v1[1]; o[6] = (_Float16)v1[2]; o[7] = (_Float16)v1[3];
          *reinterpret_cast<h8*>(hm + ((size_t)(c >> 6) * T_ + row) * 64 + (c & 63)) = o;
          if (hasK) {
            float ss = (v0[0] * v0[0] + v0[1] * v0[1]) + (v0[2] * v0[2] + v0[3] * v0[3]) + (v1[0] * v1[0] + v1[1] * v1[1]) + (v1[2] * v1[2] + v1[3] * v1[3]);
            ss += __shfl_xor(ss, 16, 64); ss += __shfl_xor(ss, 32, 64);
            nmax[bj] = fmaxf(nmax[bj], ss);
          }
          if (isK) {
#pragma unroll
            for (int j = 0; j < 4; ++j) { cs[bj][j] += v0[j]; cs[bj][4 + j] += v1[j]; }
          }
        }
      }
    if (hasK)
#pragma unroll
    for (int bj = 0; bj < 2; ++bj) {
      float v = nmax[bj];
      v = fmaxf(v, __shfl_xor(v, 1, 64)); v = fmaxf(v, __shfl_xor(v, 2, 64)); v = fmaxf(v, __shfl_xor(v, 4, 64)); v = fmaxf(v, __shfl_xor(v, 8, 64));
      if ((fr | fq) == 0) {
        const int c = u.pn * BM + wc * 32 + bj * HALF;
        atomicMax(kn2 + ((size_t)(u.pm >> 4) * 60 + (c >> 6)) * 2 + (wc & 1), __float_as_uint(v));
      }
    }
    if (isK) {
#pragma unroll
      for (int bj = 0; bj < 2; ++bj)
#pragma unroll
        for (int j = 0; j < 8; ++j) {
          float v = cs[bj][j];
          v += __shfl_xor(v, 1, 64); v += __shfl_xor(v, 2, 64); v += __shfl_xor(v, 4, 64); v += __shfl_xor(v, 8, 64);
          cs[bj][j] = v;
        }
      if (fr == 0) {
        const int b = u.pm >> 4, blk = u.pm & 15;
#pragma unroll
        for (int bj = 0; bj < 2; ++bj) {
          const int c = colb + bj * HALF, h = (c >> 6) - SL_KA, d0 = c & 63;
          float* dst = kmp + ((((size_t)b * 8 + h) * 16 + blk) * 2 + wr) * 64 + d0;
          *reinterpret_cast<f32x4*>(dst) = (f32x4){cs[bj][0], cs[bj][1], cs[bj][2], cs[bj][3]};
          *reinterpret_cast<f32x4*>(dst + 4) = (f32x4){cs[bj][4], cs[bj][5], cs[bj][6], cs[bj][7]};
        }
      }
    }
  }
};
struct EpiY {
  static constexpr bool PERM = true;
  __half* y; float* ssq;
  __device__ __forceinline__ void operator()(const f32x4 (&acc)[2][2][4][2], const Unit& u, int wr, int wc, int fr, int fq) const {
    const int row0 = u.pm * BM + wr * 64 + fr;
    const int colb = u.pn * BM + wc * 32 + 8 * fq;
#pragma unroll
    for (int ai = 0; ai < 2; ++ai)
#pragma unroll
      for (int m = 0; m < 4; ++m) {
        const int row = row0 + ai * HALF + m * 16;
        float s = 0.f;
#pragma unroll
        for (int bj = 0; bj < 2; ++bj) {
          const f32x4 v0 = acc[ai][bj][m][0], v1 = acc[ai][bj][m][1];
          s += (v0[0] * v0[0] + v0[1] * v0[1]) + (v0[2] * v0[2] + v0[3] * v0[3]) + (v1[0] * v1[0] + v1[1] * v1[1]) + (v1[2] * v1[2] + v1[3] * v1[3]);
          h8 o;
          o[0] = (_Float16)(v0[0] * 64.f); o[1] = (_Float16)(v0[1] * 64.f); o[2] = (_Float16)(v0[2] * 64.f); o[3] = (_Float16)(v0[3] * 64.f);
          o[4] = (_Float16)(v1[0] * 64.f); o[5] = (_Float16)(v1[1] * 64.f); o[6] = (_Float16)(v1[2] * 64.f); o[7] = (_Float16)(v1[3] * 64.f);
          *reinterpret_cast<h8*>(y + (size_t)row * DM + colb + bj * HALF) = o;
        }
        s += __shfl_xor(s, 16, 64); s += __shfl_xor(s, 32, 64);
        if (fq == 0) atomicAdd(ssq + row, s);
      }
  }
};

__device__ __forceinline__ void phase_post(const P& p, int bid, int nblk) {
  const int tid = otid(), lane = tid & 63, wid = tid >> 6;
  const __half* y = p.hm();
  f32x4 gv[2][2];
#pragma unroll
  for (int j = 0; j < 2; ++j) {
    gv[j][0] = *reinterpret_cast<const f32x4*>(p.g_post + j * 512 + lane * 8);
    gv[j][1] = *reinterpret_cast<const f32x4*>(p.g_post + j * 512 + lane * 8 + 4);
  }
  const int stride = nblk * 8;
  for (int t = bid * 8 + wid; t < T_; t += 2 * stride) {
    const int t1 = t + stride;
    const bool has1 = t1 < T_;
    const float tot0 = __hip_atomic_load(p.ssq() + t, __ATOMIC_RELAXED, __HIP_MEMORY_SCOPE_AGENT);
    const float tot1 = has1 ? __hip_atomic_load(p.ssq() + t1, __ATOMIC_RELAXED, __HIP_MEMORY_SCOPE_AGENT) : 1.f;
    h8 xv[2][2], yv[2][2];
#pragma unroll
    for (int j = 0; j < 2; ++j) {
      const size_t off0 = (size_t)t * DM + j * 512 + lane * 8, off1 = (size_t)(has1 ? t1 : t) * DM + j * 512 + lane * 8;
      xv[0][j] = __builtin_nontemporal_load(reinterpret_cast<const h8*>(p.xh() + off0));
      yv[0][j] = __builtin_nontemporal_load(reinterpret_cast<const h8*>(y + off0));
      xv[1][j] = __builtin_nontemporal_load(reinterpret_cast<const h8*>(p.xh() + off1));
      yv[1][j] = __builtin_nontemporal_load(reinterpret_cast<const h8*>(y + off1));
    }
    const float r0 = rsqrtf(tot0 * (1.f / DM) + EPS) * (1.f / 64.f), r1 = rsqrtf(tot1 * (1.f / DM) + EPS) * (1.f / 64.f);
#pragma unroll
    for (int i = 0; i < 2; ++i) {
      if (i == 1 && !has1) break;
      const float r = i ? r1 : r0;
      const int tt = i ? t1 : t;
#pragma unroll
      for (int j = 0; j < 2; ++j) {
        const size_t off = (size_t)tt * DM + j * 512 + lane * 8;
        f32x4 o0, o1;
#pragma unroll
        for (int k = 0; k < 4; ++k) { o0[k] = (float)xv[i][j][k] + (float)yv[i][j][k] * r * gv[j][0][k]; o1[k] = (float)xv[i][j][4 + k] + (float)yv[i][j][4 + k] * r * gv[j][1][k]; }
        __builtin_nontemporal_store(o0, reinterpret_cast<f32x4*>(p.out + off));
        __builtin_nontemporal_store(o1, reinterpret_cast<f32x4*>(p.out + off + 4));
      }
    }
  }
}

struct P1Order {
  StaticOrder so; int i0, n, xpm0, xstride, xn;
  __device__ bool next(int i, Unit& u) const {
    if (i < n && so.next(i + i0, u)) return true;
    const int k = i - n;
    if (k >= 0 && k < xn) { u.pm = xpm0 + k * xstride; u.pn = 14; return true; }
    return false;
  }
};
template <class Epi, class Ord>
__device__ __forceinline__ void gemm_phase(LAS unsigned char* lds, const __half* gA, const __half* gBt, int M, int N, int K, const Ord& S, const Epi& E) {
  const int tid = otid(), wid = __builtin_amdgcn_readfirstlane(tid >> 6), lane = tid & 63, wr = wid >> 2, wc = wid & 3, fr = lane & 15, fq = lane >> 4;
  const int nt = K / BK;
  unsigned voffA[2], voffB[2];
#pragma unroll
  for (int i = 0; i < 2; ++i) { int R, C; stage_rc(tid * 16 + i * 8192, R, C); const int Rb = Epi::PERM ? ((R & ~31) + perm32(R & 31)) : R;
    voffA[i] = (unsigned)(R * K + C) * 2u; voffB[i] = (unsigned)(Rb * K + C) * 2u; }
  const size_t kstep = (size_t)(BK * 2);
  const size_t hstep = (size_t)HALF * K * 2;
  const size_t tstep = 2 * hstep;
  const unsigned ldsw = (unsigned)wid * 1024u;
  const int aoff = lds_byte(wr * 64 + fr, fq * 8), boff = lds_byte(wc * 32 + fr, fq * 8);
#define PG8_SA(b, h) (((b) * 2 + (h)) * HTB)
#define PG8_SB(b, h) ((4 + (b) * 2 + (h)) * HTB)
#define PG8_STAGE(bufoff, gbase, voff) do { _Pragma("unroll") for (int _i = 0; _i < 2; ++_i) \
    __builtin_amdgcn_global_load_lds((const unsigned*)((const char*)(gbase) + (voff)[_i]), (LAS unsigned*)(lds + (bufoff) + ldsw + _i * 8192), 16, 0, 0); } while (0)
#define PG8_LDA(dst, b, h) do { _Pragma("unroll") for (int m = 0; m < 4; ++m) _Pragma("unroll") for (int k = 0; k < 2; ++k) dst[m][k] = *(const LAS h8*)(lds + PG8_SA(b, h) + aoff + m * 2048 + k * 1024); } while (0)
#define PG8_LDB(dst, b, h) do { _Pragma("unroll") for (int n = 0; n < 2; ++n) _Pragma("unroll") for (int k = 0; k < 2; ++k) dst[n][k] = *(const LAS h8*)(lds + PG8_SB(b, h) + boff + n * 2048 + k * 1024); } while (0)
#define PG8_MMA(ai, bj, At, Bt) do { __builtin_amdgcn_s_setprio(1); _Pragma("unroll") for (int m = 0; m < 4; ++m) _Pragma("unroll") for (int n = 0; n < 2; ++n) _Pragma("unroll") for (int k = 0; k < 2; ++k) \
    acc[ai][bj][m][n] = __builtin_amdgcn_mfma_f32_16x16x32_f16(Bt[n][k], At[m][k], acc[ai][bj][m][n], 0, 0, 0); __builtin_amdgcn_s_setprio(0); } while (0)
#define PG8_WAIT_V(n) asm volatile("s_waitcnt vmcnt(" #n ")" ::: "memory")
#define PG8_WAIT_L(n) asm volatile("s_waitcnt lgkmcnt(" #n ")" ::: "memory")
#define PG8_BAR __builtin_amdgcn_s_barrier()
#define PG8_SCHED __builtin_amdgcn_sched_barrier(0)
  Unit cur, nxt; int ui = 0;
  if (!S.next(0, cur)) return;
  f32x4 acc[2][2][4][2];
#pragma unroll
  for (int a = 0; a < 2; ++a)
#pragma unroll
    for (int b = 0; b < 2; ++b)
#pragma unroll
      for (int m = 0; m < 4; ++m)
#pragma unroll
        for (int n = 0; n < 2; ++n) acc[a][b][m][n] = (f32x4){0.f, 0.f, 0.f, 0.f};
  h8 At[4][2], B0[2][2], B1[2][2];
  const char* cA = (const char*)gA + (size_t)cur.pm * tstep; const char* cB = (const char*)gBt + (size_t)cur.pn * tstep;
  PG8_STAGE(PG8_SB(0, 0), cB, voffB); PG8_STAGE(PG8_SA(0, 0), cA, voffA); PG8_STAGE(PG8_SB(0, 1), cB + hstep, voffB); PG8_STAGE(PG8_SA(0, 1), cA + hstep, voffA);
  if (wr == 1) PG8_BAR;
  PG8_WAIT_V(4); PG8_BAR;
  PG8_STAGE(PG8_SB(1, 0), cB + kstep, voffB); PG8_STAGE(PG8_SA(1, 0), cA + kstep, voffA); PG8_STAGE(PG8_SB(1, 1), cB + hstep + kstep, voffB);
  PG8_WAIT_V(6); PG8_BAR;
  for (;;) {
    const bool has_next = S.next(ui + 1, nxt);
    const char* nA = has_next ? (const char*)gA + (size_t)nxt.pm * tstep : cA; const char* nB = has_next ? (const char*)gBt + (size_t)nxt.pn * tstep : cB;
    for (int t = 0; t < nt; t += 2) {
      const bool last = (t == nt - 2);
      const char* a1 = cA + (size_t)(t + 1) * kstep;
      const char* a2 = last ? nA : cA + (size_t)(t + 2) * kstep; const char* b2 = last ? nB : cB + (size_t)(t + 2) * kstep;
      const char* a3 = a2 + kstep; const char* b3 = b2 + kstep;
      PG8_LDB(B0, 0, 0); PG8_SCHED; PG8_LDA(At, 0, 0); PG8_STAGE(PG8_SA(1, 1), a1 + hstep, voffA);
      PG8_WAIT_L(8); PG8_BAR; PG8_WAIT_L(0); PG8_MMA(0, 0, At, B0); PG8_BAR; PG8_SCHED;
      PG8_LDB(B1, 0, 1); PG8_STAGE(PG8_SB(0, 0), b2, voffB);
      PG8_BAR; PG8_WAIT_L(0); PG8_MMA(0, 1, At, B1); PG8_BAR;
      PG8_LDA(At, 0, 1); PG8_STAGE(PG8_SA(0, 0), a2, voffA);
      PG8_BAR; PG8_WAIT_L(0); PG8_MMA(1, 0, At, B0); PG8_BAR; PG8_SCHED;
      PG8_STAGE(PG8_SB(0, 1), b2 + hstep, voffB);
      PG8_WAIT_V(6); PG8_BAR; PG8_MMA(1, 1, At, B1); PG8_BAR;
      PG8_LDB(B0, 1, 0); PG8_SCHED; PG8_LDA(At, 1, 0); PG8_STAGE(PG8_SA(0, 1), a2 + hstep, voffA);
      PG8_WAIT_L(8); PG8_BAR; PG8_WAIT_L(0); PG8_MMA(0, 0, At, B0); PG8_BAR; PG8_SCHED;
      PG8_LDB(B1, 1, 1); PG8_STAGE(PG8_SB(1, 0), b3, voffB);
      PG8_BAR; PG8_WAIT_L(0); PG8_MMA(0, 1, At, B1); PG8_BAR;
      PG8_LDA(At, 1, 1); PG8_STAGE(PG8_SA(1, 0), a3, voffA);
      PG8_BAR; PG8_WAIT_L(0); PG8_MMA(1, 0, At, B0); PG8_BAR; PG8_SCHED;
      PG8_STAGE(PG8_SB(1, 1), b3 + hstep, voffB);
      PG8_WAIT_V(6); PG8_BAR; PG8_MMA(1, 1, At, B1); PG8_BAR;
    }
    E(acc, cur, wr, wc, fr, fq);
    if (!has_next) break;
#pragma unroll
    for (int a = 0; a < 2; ++a)
#pragma unroll
      for (int b = 0; b < 2; ++b)
#pragma unroll
        for (int m = 0; m < 4; ++m)
#pragma unroll
          for (int n = 0; n < 2; ++n) acc[a][b][m][n] = (f32x4){0.f, 0.f, 0.f, 0.f};
    cur = nxt; cA = nA; cB = nB; ++ui;
  }
  PG8_WAIT_V(0);
  if (wr == 0) PG8_BAR;
  PG8_BAR;
#undef PG8_SA
#undef PG8_SB
#undef PG8_STAGE
#undef PG8_LDA
#undef PG8_LDB
#undef PG8_MMA
#undef PG8_WAIT_V
#undef PG8_WAIT_L
#undef PG8_BAR
#undef PG8_SCHED
}

constexpr int AT_K = 0, AT_V = 24576, AT_WS = 49152, AT_KM = 51200, AT_OST = 55296, AT_FLG = AT_OST + 8 * 8192, AT_ORD = AT_FLG + 64, AT_QS = AT_ORD + 256, AT_Q = AT_QS + 64, AT_LDS = AT_Q + 8 * 4096;
constexpr float PRUNE = (PROBE == 12 || PROBE == 13) ? 1e30f : 40.f;
constexpr float LOG2E = 1.4426950408889634f;
constexpr float C2 = 0.125f * LOG2E;
constexpr float THR = (PROBE == 30) ? 0.f : 8.f;
enum { M_MOBA = 0, M_SLC = 1, M_WIN = 2 };
typedef short v4i16_t __attribute__((ext_vector_type(4)));

__device__ __forceinline__ int crow(int r, int hi) { return (r & 3) + 8 * (r >> 2) + 4 * hi; }
__device__ __forceinline__ void glds16(const void* g, LAS unsigned char* l) {
  __builtin_amdgcn_global_load_lds((const unsigned*)g, (LAS unsigned*)l, 16, 0, 0);
}
__device__ __forceinline__ h4 vtr(const LAS unsigned char* p) {
  return __builtin_bit_cast(h4, __builtin_amdgcn_ds_read_tr16_b64_v4i16((LAS v4i16_t*)p));
}
__device__ __forceinline__ void scale_rows(f32x16 (&o)[2], float f, LAS float* wsf, int r32, int hi) {
  if (hi == 0) wsf[r32] = f;
#pragma unroll
  for (int r = 0; r < 16; ++r) { const float a = wsf[crow(r, hi)]; o[0][r] *= a; o[1][r] *= a; }
}

#define SBAR() __builtin_amdgcn_sched_barrier(0)
#define PINV(x) asm volatile("" : "+v"(x))
#define MFMA32(a, b, c) __builtin_amdgcn_mfma_f32_32x32x16_f16((a), (b), (c), 0, 0, 0)
__device__ __forceinline__ h8 kfrag(const LAS unsigned char* kp, int f) { return *(const LAS h8*)(kp + (f >> 1) * 2048 + (f & 1) * 512); }
__device__ __forceinline__ h8 vfrag(const LAS unsigned char* vp, int f) {
  const LAS unsigned char* a = vp + (f & 1) * 4096 + (f >> 1) * 1024;
  const h4 lo = vtr(a), hv = vtr(a + 512);
  return __builtin_shufflevector(lo, hv, 0, 1, 2, 3, 4, 5, 6, 7);
}

__device__ __forceinline__ void glds16_asm(const void* g, unsigned lds_base) {
  unsigned sv;
  asm volatile("s_mov_b32 %0, m0\n\ts_mov_b32 m0, %2\n\ts_nop 0\n\tglobal_load_lds_dwordx4 %1, off\n\ts_mov_b32 m0, %0" : "=&s"(sv) : "v"(g), "s"(lds_base) : "memory");
}
#define WAIT_BAR(N) asm volatile("s_waitcnt vmcnt(" #N ") lgkmcnt(0)\n\ts_barrier" ::: "memory")

template <int MODE, bool HASPREV>
__device__ __forceinline__ void fstep(h8 (&pw)[4], f32x16 (&o)[2], const f32x16& bfix, const h8 (&qf)[4],
                                      h8 (&kf)[8], float& m, float& l, const LAS unsigned char* kpn,
                                      const LAS unsigned char* vpp, LAS float* wsf, LAS int* flgw, int kt, int q0, int tq, int tq_min, int tq_max,
                                      int hi, int r32, int lane, float slope2, unsigned long long rowmask, float ubc) {
  f32x16 C0, C1;
  h8 vf[8];
#pragma unroll
  for (int i = 0; i < 8; ++i) {
    if (HASPREV) vf[i] = vfrag(vpp, i);
    const int d0 = i >> 1;
    if (i & 1) C1 = MFMA32(kf[i], qf[d0], d0 == 0 ? bfix : C1);
    else       C0 = MFMA32(kf[i], qf[d0], d0 == 0 ? bfix : C0);
    SBAR();
  }
  const int k0 = kt * 64;
  const float bnd = ubc - slope2 * (float)max(tq - k0 - 63, 0);
  bool need = (k0 <= tq) && (bnd >= m - PRUNE);
  if (MODE == M_MOBA) need = need && (((unsigned)rowmask >> (kt >> 2)) & 1u);
  if (MODE == M_SLC) need = need && ((rowmask >> kt) & 1ull);
  if (MODE == M_WIN) need = need && (k0 + 63 >= tq - 511);
  const bool edge = (k0 + 63 > tq_min) || (MODE == M_WIN && k0 < tq_max - 511);
  if (edge) {
    const int rel = tq - k0 - 4 * hi;
#pragma unroll
    for (int r = 0; r < 16; ++r) {
      const int e0 = (r & 3) + 8 * (r >> 2), e1 = e0 + 32;
      bool ok0 = e0 <= rel, ok1 = e1 <= rel;
      if (MODE == M_WIN) { ok0 = ok0 && (e0 >= rel - 511); ok1 = ok1 && (e1 >= rel - 511); }
      C0[r] = ok0 ? C0[r] : -1e30f; C1[r] = ok1 ? C1[r] : -1e30f;
    }
  }
  const float off1 = 32.f * slope2;
  const float base_t = slope2 * (float)(k0 - q0);
  bool resc = false;
  if (__any(need && (bnd > m + THR))) {
    float mx0 = C0[0], mx1 = C1[0];
#pragma unroll
    for (int r = 1; r < 16; ++r) { mx0 = fmaxf(mx0, C0[r]); mx1 = fmaxf(mx1, C1[r]); }
    float mxs = fmaxf(mx0 * C2, __builtin_fmaf(mx1, C2, off1));
    { const auto rr = __builtin_amdgcn_permlane32_swap(__float_as_uint(mxs), __float_as_uint(mxs), false, false);
      mxs = fmaxf(__uint_as_float(rr[0]), __uint_as_float(rr[1])); }
    const float mt2 = need ? (mxs + base_t) : -1e30f;
    resc = __any(mt2 - m > THR);
    if (resc) {
      const float mn = fmaxf(m, mt2);
      const float alpha = __builtin_amdgcn_exp2f(m - mn);
      l *= alpha; m = mn;
      if (hi == 0) wsf[r32] = alpha;
    }
  }
  const float nm0 = need ? (base_t - m) : -INFINITY;
  const float nm1 = nm0 + off1;
  {
    const bool live_next = (ubc - slope2 * (float)max(tq - k0 + 1, 0)) >= m - PRUNE;
    const int a = __any(live_next) ? 1 : 0;
    if (lane == 0) *flgw = a;
  }
  SBAR();
  float sacc = 0.f;
  h8 pn[4];
#pragma unroll
  for (int i = 0; i < 8; ++i) {
    kf[i] = kfrag(kpn, i);
    if (HASPREV) {
      if (i & 1) o[1] = MFMA32(pw[i >> 1], vf[i], o[1]);
      else       o[0] = MFMA32(pw[i >> 1], vf[i], o[0]);
    }
    float e[4];
#pragma unroll
    for (int j = 0; j < 4; ++j)
      e[j] = (i < 4) ? __builtin_amdgcn_exp2f(__builtin_fmaf(C0[4 * i + j], C2, nm0)) : __builtin_amdgcn_exp2f(__builtin_fmaf(C1[4 * (i - 4) + j], C2, nm1));
    sacc += (e[0] + e[1]) + (e[2] + e[3]);
    pn[i >> 1][(i & 1) * 4 + 0] = (_Float16)e[0]; pn[i >> 1][(i & 1) * 4 + 1] = (_Float16)e[1];
    pn[i >> 1][(i & 1) * 4 + 2] = (_Float16)e[2]; pn[i >> 1][(i & 1) * 4 + 3] = (_Float16)e[3];
    PINV(sacc); PINV(pn[i >> 1]);
    SBAR();
  }
  l += sacc;
#pragma unroll
  for (int s = 0; s < 4; ++s) pw[s] = pn[s];
  if (HASPREV && resc) {
#pragma unroll
    for (int r = 0; r < 16; ++r) { const float a = wsf[crow(r, hi)]; o[0][r] *= a; o[1][r] *= a; }
  }
}

__device__ __forceinline__ void fdrain(const h8 (&pw)[4], f32x16 (&o)[2], const LAS unsigned char* vp) {
#pragma unroll
  for (int f = 0; f < 8; ++f) {
    const h8 v = vfrag(vp, f);
    if (f & 1) o[1] = MFMA32(pw[f >> 1], v, o[1]); else o[0] = MFMA32(pw[f >> 1], v, o[0]);
  }
}

template <int MODE>
__device__ __forceinline__ void flash_pipe(LAS unsigned char* lds, const __half* Kg, const __half* Vg, int q0, int kt_lo, int kt_hi,
                                           const f32x16& bfix, float slope2, unsigned long long rowmask, float ubc,
                                           f32x16 (&o)[2], float& l_tot) {
  const int tid = otid(), lane = tid & 63, r32 = lane & 31, hi = lane >> 5;
  const int wid = __builtin_amdgcn_readfirstlane(tid >> 6);
  const int tq = q0 + wid * 32 + r32, tq_min = q0 + wid * 32, tq_max = tq_min + 31;
  LAS float* wsf = (LAS float*)(lds + AT_WS) + wid * 64;
  LAS int* flg = (LAS int*)(lds + AT_FLG);
  const __half* ksrc = Kg + (size_t)lane * 64 + wid * 8;
  const __half* vsrc = Vg + (size_t)(16 * (wid & 3) + (lane >> 2)) * 64 + (wid >> 2) * 32 + (lane & 3) * 8;
  const unsigned kdst = (unsigned)(unsigned long)(lds + AT_K) + wid * 1024;
  const unsigned vdst = (unsigned)(unsigned long)(lds + AT_V) + wid * 1024;
  const LAS unsigned char* kp0 = lds + AT_K + hi * 1024 + r32 * 16;
  const LAS unsigned char* vp0 = lds + AT_V + ((lane >> 4) & 1) * 32 + (lane & 3) * 8 + (4 * hi + ((lane & 15) >> 2)) * 64;
  const LAS unsigned char* qp = lds + AT_Q + wid * 4096 + lane * 16;
  h8 qf[4];
#pragma unroll
  for (int d0 = 0; d0 < 4; ++d0) qf[d0] = *(const LAS h8*)(qp + d0 * 1024);
#pragma unroll
  for (int r = 0; r < 16; ++r) { o[0][r] = 0.f; o[1][r] = 0.f; }
  float m = -1e30f, l = 0.f;
  h8 kf[8], pw[4];
#define KT_(t) max(kt_hi - (t), kt_lo)
#define DMA_K(t, slot) glds16_asm(ksrc + (size_t)KT_(t) * 4096, (unsigned)__builtin_amdgcn_readfirstlane(kdst + (slot)))
#define DMA_V(t, slot) glds16_asm(vsrc + (size_t)KT_(t) * 4096, (unsigned)__builtin_amdgcn_readfirstlane(vdst + (slot)))
  asm volatile("s_waitcnt vmcnt(0)" ::: "memory");
  DMA_K(0, 0); DMA_K(1, 8192); DMA_K(2, 16384); DMA_V(0, 0);
  WAIT_BAR(2);
#pragma unroll
  for (int i = 0; i < 8; ++i) kf[i] = kfrag(kp0, i);
  WAIT_BAR(2);
  int t = 0, kt = kt_hi;
  int s0 = 0, s1 = 8192, s2 = 16384;
#define STEP_CLOSE(done) do { WAIT_BAR(2);     \
    { const LAS int* f_ = flg + (kt & 1) * 8; const int any_live = f_[0] | f_[1] | f_[2] | f_[3] | f_[4] | f_[5] | f_[6] | f_[7]; done = (!any_live) || (kt == kt_lo); } } while (0)
#define STEP_ROT() do { const int t_ = s0; s0 = s1; s1 = s2; s2 = t_; ++t; --kt; } while (0)
  bool done;
  DMA_K(3, s0); DMA_V(1, s1);
  fstep<MODE, false>(pw, o, bfix, qf, kf, m, l, kp0 + s1, vp0, wsf, flg + (kt & 1) * 8 + wid, kt, q0, tq, tq_min, tq_max, hi, r32, lane, slope2, rowmask, ubc);
  STEP_CLOSE(done);
  while (!done) {
    STEP_ROT();
    DMA_K(t + 3, s0); DMA_V(t + 1, s1);
    fstep<MODE, true>(pw, o, bfix, qf, kf, m, l, kp0 + s1, vp0 + s2  , wsf, flg + (kt & 1) * 8 + wid, kt, q0, tq, tq_min, tq_max, hi, r32, lane, slope2, rowmask, ubc);
    STEP_CLOSE(done);
  }
  fdrain(pw, o, vp0 + s0);
  asm volatile("s_waitcnt lgkmcnt(0)\n\ts_barrier" ::: "memory");
#undef KT_
#undef DMA_K
#undef DMA_V
#undef STEP_CLOSE
#undef STEP_ROT
  l_tot = l + __shfl_xor(l, 32, 64);
}

__device__ __forceinline__ float score_bound(const P& p, const h8 (&qf)[4], int b, int slot) {
  float ss = 0.f;
#pragma unroll
  for (int d0 = 0; d0 < 4; ++d0)
#pragma unroll
    for (int j = 0; j < 8; ++j) { const float v = (float)qf[d0][j]; ss += v * v; }
  ss += __shfl_xor(ss, 32, 64);
  const unsigned* kn = p.kn2() + ((size_t)b * 60 + slot) * 2;
  const float kmax = sqrtf(__uint_as_float(kn[0]) + __uint_as_float(kn[1])) * 1.002f;
  return C2 * sqrtf(ss) * kmax * 1.001f;
}

__device__ __forceinline__ void put_q(LAS unsigned char* lds, const h8 (&qf)[4], int wid, int lane) {
  LAS unsigned char* qp = lds + AT_Q + wid * 4096 + lane * 16;
#pragma unroll
  for (int d0 = 0; d0 < 4; ++d0) *(LAS h8*)(qp + d0 * 1024) = qf[d0];
}

__device__ __forceinline__ void moba_unit(const P& p, LAS unsigned char* lds, int b, int h, int own) {
  const int tid = otid(), lane = tid & 63, r32 = lane & 31, hi = lane >> 5;
  const int wid = __builtin_amdgcn_readfirstlane(tid >> 6);
  const int q0 = own * 256;
  const size_t bh = (size_t)b * 8 + h;
  LAS float* km = (LAS float*)(lds + AT_KM);
  for (int e = tid; e < own * 64; e += 512) {
    const int n = e >> 6, d = e & 63;
    const float* kp = p.kmp() + ((bh * 16 + n) * 2) * 64 + d;
    km[e] = (kp[0] + kp[64]) * (1.f / 256.f);
  }
  h8 qf[4];
  const __half* qrow = hmp(p, SL_QA + h, b, q0 + wid * 32 + r32);
#pragma unroll
  for (int d0 = 0; d0 < 4; ++d0) qf[d0] = *reinterpret_cast<const h8*>(qrow + d0 * 16 + hi * 8);
  __syncthreads();
  float g0 = -3e38f, g1 = -3e38f, g2 = -3e38f; int i0 = -1, i1 = -1, i2 = -1;
  for (int n = 0; n < own; ++n) {
    float s = 0.f;
#pragma unroll
    for (int d0 = 0; d0 < 4; ++d0)
#pragma unroll
      for (int j = 0; j < 8; ++j) s += (float)qf[d0][j] * km[n * 64 + d0 * 16 + hi * 8 + j];
    s += __shfl_xor(s, 32, 64);
    if (s > g0) { g2 = g1; i2 = i1; g1 = g0; i1 = i0; g0 = s; i0 = n; }
    else if (s > g1) { g2 = g1; i2 = i1; g1 = s; i1 = n; }
    else if (s > g2) { g2 = s; i2 = n; }
  }
  unsigned long long rowmask = 1ull << own;
  if (i0 >= 0) rowmask |= 1ull << i0;
  if (i1 >= 0) rowmask |= 1ull << i1;
  if (i2 >= 0) rowmask |= 1ull << i2;
  const float slope = exp2f(-(float)(h + 1));
  const float slope2 = slope * LOG2E;
  f32x16 bfix;
  {
    const float sb = slope * 8.f;
    const int qrel = wid * 32 + r32;
#pragma unroll
    for (int r = 0; r < 16; ++r) bfix[r] = sb * (float)((r & 3) + 8 * (r >> 2) + 4 * hi - qrel);
  }
  f32x16 o[2]; float l_tot;
  const float ubc = score_bound(p, qf, b, SL_KA + h);
  put_q(lds, qf, wid, lane);
  flash_pipe<M_MOBA>(lds, hmp(p, SL_KA + h, b, 0), hmp(p, SL_VA + h, b, 0), q0, 0, 4 * own + 3, bfix, slope2, rowmask, ubc, o, l_tot);
  if (PROBE == 11 || PROBE == 13) flash_pipe<M_MOBA>(lds, hmp(p, SL_KA + h, b, 0), hmp(p, SL_VA + h, b, 0), q0, 0, 4 * own + 3, bfix, slope2, rowmask, ubc, o, l_tot);
  const int t3 = otid(), lane3 = t3 & 63, wid3 = t3 >> 6;
  h8 zv[4];
#pragma unroll
  for (int i = 0; i < 4; ++i) zv[i] = *reinterpret_cast<const h8*>(hmp(p, SL_ZA + h, b, q0 + wid3 * 32 + i * 8 + (lane3 >> 3)) + (lane3 & 7) * 8);
  LAS float* wsf = (LAS float*)(lds + AT_WS) + wid * 64;
  scale_rows(o, 1.f / fmaxf(l_tot, 1e-30f), wsf, r32, hi);
  LAS _Float16* stg = (LAS _Float16*)(lds + AT_OST + wid * 4096);
#pragma unroll
  for (int r = 0; r < 16; ++r) {
    const int orow = crow(r, hi);
    stg[orow * 64 + r32] = (_Float16)o[0][r];
    stg[orow * 64 + 32 + r32] = (_Float16)o[1][r];
  }
#pragma unroll
  for (int i = 0; i < 4; ++i) {
    const int row = i * 8 + (lane3 >> 3), ch = lane3 & 7;
    const h8 v = *(const LAS h8*)(stg + row * 64 + ch * 8);
    const int t = q0 + wid3 * 32 + row;
    const h8 z = zv[i];
    h8 ov;
#pragma unroll
    for (int j = 0; j < 8; ++j) ov[j] = (_Float16)((float)v[j] * silu((float)z[j]));
    *reinterpret_cast<h8*>(p.cat() + ((size_t)b * S_ + t) * DM + h * 64 + ch * 8) = ov;
  }
  __syncthreads();
}

__device__ __forceinline__ void nsa_unit(const P& p, LAS unsigned char* lds, int b, int h, int qblk) {
  const int tid = otid(), lane = tid & 63, r32 = lane & 31, hi = lane >> 5;
  const int wid = __builtin_amdgcn_readfirstlane(tid >> 6);
  const int q0 = qblk * 256, g = h >> 2;
  const int tq = q0 + wid * 32 + r32;
  h8 qf[4];
  const __half* qrow = hmp(p, SL_QB + h, b, tq);
#pragma unroll
  for (int d0 = 0; d0 < 4; ++d0) qf[d0] = *reinterpret_cast<const h8*>(qrow + d0 * 16 + hi * 8);
  const unsigned long long rowmask = p.sel()[((size_t)b * 2 + g) * S_ + tq];
  LAS float* gl = (LAS float*)(lds + AT_KM);
  if (tid < 256) {
    const float* gp = p.gate() + ((size_t)b * S_ + q0 + tid) * 24 + h * 3;
    const float a0 = gp[0], a1 = gp[1], a2 = gp[2];
    *(LAS f32x4*)(gl + tid * 4) = (f32x4){a0, a1, a2, 0.f};
  }
  const float slope = exp2f(-(float)(h + 1));
  const float slope2 = slope * LOG2E;
  f32x16 bfix;
  {
    const float sb = slope * 8.f;
    const int qrel = wid * 32 + r32;
#pragma unroll
    for (int r = 0; r < 16; ++r) bfix[r] = sb * (float)((r & 3) + 8 * (r >> 2) + 4 * hi - qrel);
  }
  LAS float* wsf = (LAS float*)(lds + AT_WS) + wid * 64;
  f32x16 o[2]; float l_tot;
  LAS float* st32 = (LAS float*)(lds + AT_OST + wid * 8192);
  const float ubc_s = score_bound(p, qf, b, SL_KV6 + 4 + g), ubc_w = score_bound(p, qf, b, SL_KV6 + 8 + g);
  put_q(lds, qf, wid, lane);
  flash_pipe<M_SLC>(lds, hmp(p, SL_KV6 + 4 + g, b, 0), hmp(p, SL_KV6 + 6 + g, b, 0), q0, 0, 4 * qblk + 3, bfix, slope2, rowmask, ubc_s, o, l_tot);
  if (PROBE == 11 || PROBE == 13) flash_pipe<M_SLC>(lds, hmp(p, SL_KV6 + 4 + g, b, 0), hmp(p, SL_KV6 + 6 + g, b, 0), q0, 0, 4 * qblk + 3, bfix, slope2, rowmask, ubc_s, o, l_tot);
  {
    const int t2 = otid();
    const float g1 = gl[((t2 >> 6) * 32 + (t2 & 31)) * 4 + 1];
    scale_rows(o, g1 / fmaxf(l_tot, 1e-30f), wsf, r32, hi);
  }
#pragma unroll
  for (int r = 0; r < 16; ++r) { const int orow = crow(r, hi); st32[orow * 64 + r32] = o[0][r]; st32[orow * 64 + 32 + r32] = o[1][r]; }
  const int wlo = qblk >= 2 ? 4 * qblk - 8 : 0;
  flash_pipe<M_WIN>(lds, hmp(p, SL_KV6 + 8 + g, b, 0), hmp(p, SL_KV6 + 10 + g, b, 0), q0, wlo, 4 * qblk + 3, bfix, slope2, 0ull, ubc_w, o, l_tot);
  if (PROBE == 11 || PROBE == 13) flash_pipe<M_WIN>(lds, hmp(p, SL_KV6 + 8 + g, b, 0), hmp(p, SL_KV6 + 10 + g, b, 0), q0, wlo, 4 * qblk + 3, bfix, slope2, 0ull, ubc_w, o, l_tot);
  const int t3 = otid(), lane3 = t3 & 63, wid3 = t3 >> 6;
  h8 zv[4], ocv[4];
#pragma unroll
  for (int i = 0; i < 4; ++i) {
    const int t = q0 + wid3 * 32 + i * 8 + (lane3 >> 3);
    zv[i] = *reinterpret_cast<const h8*>(hmp(p, SL_ZB + h, b, t) + (lane3 & 7) * 8);
    ocv[i] = *reinterpret_cast<const h8*>(p.ocmph() + (((size_t)b * 8 + h) * S_ + t) * 64 + (lane3 & 7) * 8);
  }
  {
    const float g2 = gl[(wid3 * 32 + (lane3 & 31)) * 4 + 2];
    scale_rows(o, g2 / fmaxf(l_tot, 1e-30f), wsf, r32, hi);
  }
  LAS _Float16* stg = (LAS _Float16*)(lds + AT_OST + wid * 8192);
  {
    float tmp0[16], tmp1[16];
#pragma unroll
    for (int r = 0; r < 16; ++r) { const int orow = crow(r, hi); tmp0[r] = st32[orow * 64 + r32] + o[0][r]; tmp1[r] = st32[orow * 64 + 32 + r32] + o[1][r]; }
    __builtin_amdgcn_wave_barrier();
#pragma unroll
    for (int r = 0; r < 16; ++r) { const int orow = crow(r, hi); stg[orow * 64 + r32] = (_Float16)tmp0[r]; stg[orow * 64 + 32 + r32] = (_Float16)tmp1[r]; }
  }
#pragma unroll
  for (int i = 0; i < 4; ++i) {
    const int row = i * 8 + (lane3 >> 3), ch = lane3 & 7;
    const h8 v = *(const LAS h8*)(stg + row * 64 + ch * 8);
    const int t = q0 + wid3 * 32 + row;
    const h8 z = zv[i];
    const float g0 = gl[(wid3 * 32 + row) * 4];
    const h8 oc = ocv[i];
    h8 ov;
#pragma unroll
    for (int j = 0; j < 8; ++j) ov[j] = (_Float16)(((float)v[j] + g0 * (float)oc[j]) * silu((float)z[j]));
    *reinterpret_cast<h8*>(p.cat() + ((size_t)b * S_ + t) * DM + 512 + h * 64 + ch * 8) = ov;
  }
  __syncthreads();
}


constexpr int CM_HID = 0;
constexpr int CM_X = 9216;
__device__ __forceinline__ void cm_unit(const P& p, LAS unsigned char* lds, int which, int b, int g, int mt) {
  const int tid = otid(), lane = tid & 63, r = lane & 15, q = lane >> 4;
  const int wid = __builtin_amdgcn_readfirstlane(tid >> 6);
  const int c0 = mt * 32;
  const __half* xs = hmp(p, SL_KV6 + 2 * which + g, b, 0) + (size_t)c0 * 1024;
  for (int pc = wid; pc < 66; pc += 8) glds16(xs + (size_t)pc * 512 + lane * 8, lds + CM_X + pc * 1040);
  const __half* bp = p.w1t() + ((size_t)which * 128 + wid * 16 + r) * 2048 + q * 8;
  const __half* pp = p.peh() + which * 2048 + q * 8;
  asm volatile("s_waitcnt vmcnt(0)" ::: "memory");
  __syncthreads();
  f32x4 acc0 = {0.f, 0.f, 0.f, 0.f}, acc1 = {0.f, 0.f, 0.f, 0.f};
  const LAS unsigned char* a0l = lds + CM_X + (2 * r) * 1040 + q * 16;
  const LAS unsigned char* a1l = lds + CM_X + (2 * (16 + r)) * 1040 + q * 16;
#pragma unroll 8
  for (int s = 0; s < 64; ++s) {
    const int off = (s >> 4) * 1040 + ((s >> 1) & 7) * 128 + (s & 1) * 64;
    const h8 pe = *reinterpret_cast<const h8*>(pp + s * 32);
    const h8 a0 = *(const LAS h8*)(a0l + off) + pe;
    const h8 a1 = *(const LAS h8*)(a1l + off) + pe;
    const h8 bf = *reinterpret_cast<const h8*>(bp + s * 32);
    acc0 = __builtin_amdgcn_mfma_f32_16x16x32_f16(a0, bf, acc0, 0, 0, 0);
    acc1 = __builtin_amdgcn_mfma_f32_16x16x32_f16(a1, bf, acc1, 0, 0, 0);
  }
  LAS _Float16* hid = (LAS _Float16*)(lds + CM_HID);
#pragma unroll
  for (int reg = 0; reg < 4; ++reg) {
    hid[(4 * q + reg) * 136 + wid * 16 + r] = (_Float16)silu(acc0[reg]);
    hid[(16 + 4 * q + reg) * 136 + wid * 16 + r] = (_Float16)silu(acc1[reg]);
  }
  __syncthreads();
  {
    const int mi = wid >> 2, ni = wid & 3;
    const __half* w2p = p.w2t() + ((size_t)which * 64 + ni * 16 + r) * 128 + q * 8;
    f32x4 acc = {0.f, 0.f, 0.f, 0.f};
#pragma unroll
    for (int s = 0; s < 4; ++s) {
      const h8 a = *(const LAS h8*)(hid + (mi * 16 + r) * 136 + s * 32 + q * 8);
      const h8 bf = *reinterpret_cast<const h8*>(w2p + s * 32);
      acc = __builtin_amdgcn_mfma_f32_16x16x32_f16(a, bf, acc, 0, 0, 0);
    }
    __half* dst = (which ? p.vch() : p.kch()) + ((size_t)b * 2 + g) * 256 * 64;
#pragma unroll
    for (int reg = 0; reg < 4; ++reg) {
      const int c = c0 + mi * 16 + 4 * q + reg;
      dst[(size_t)c * 64 + ni * 16 + r] = __float2half(c < 255 ? acc[reg] : 0.f);
    }
  }
  __syncthreads();
}

constexpr int CS_K = 0, CS_V = 32768, CS_SLAB = 65536, CS_SLAB_BYTES = 8 * 32 * 65 * 4, CS_WS = CS_SLAB + CS_SLAB_BYTES, CS_LDS = CS_WS + 2048;
__device__ __forceinline__ void cs_super(const P& p, LAS unsigned char* lds, int b, int g, int j) {
  const int tid = otid(), lane = tid & 63, r32 = lane & 31, hi = lane >> 5;
  const int wid = __builtin_amdgcn_readfirstlane(tid >> 6);
  const int hh = wid & 3, qi = wid >> 2, h = g * 4 + hh;
  const size_t bg = (size_t)b * 2 + g;
  {
    const __half* ksrc = p.kch() + bg * 256 * 64 + (size_t)lane * 64 + wid * 8;
    const __half* vsrc = p.vch() + bg * 256 * 64 + (size_t)(16 * (wid & 3) + (lane >> 2)) * 64 + (wid >> 2) * 32 + (lane & 3) * 8;
    for (int kt = 0; kt < 4; ++kt) {
      glds16(ksrc + (size_t)kt * 4096, lds + CS_K + kt * 8192 + wid * 1024);
      glds16(vsrc + (size_t)kt * 4096, lds + CS_V + kt * 8192 + wid * 1024);
    }
  }
  asm volatile("s_waitcnt vmcnt(0)" ::: "memory");
  __syncthreads();
  for (int oi = 0; oi < 4; ++oi) {
  const int own = oi == 0 ? j : oi == 1 ? 31 - j : oi == 2 ? 32 + j : 63 - j;
  const int q0 = own * 64;
  const int ntile = (4 * own + 66) >> 6;
  const int tq = q0 + qi * 32 + r32;
  const int ncv = tq >= 31 ? ((tq - 31) >> 4) + 1 : 0;
  h8 qf[4];
  const __half* qrow = hmp(p, SL_QB + h, b, tq);
#pragma unroll
  for (int d0 = 0; d0 < 4; ++d0) qf[d0] = *reinterpret_cast<const h8*>(qrow + d0 * 16 + hi * 8);
  const LAS unsigned char* kp0 = lds + CS_K + hi * 1024 + r32 * 16;
  const LAS unsigned char* vp0 = lds + CS_V + ((lane >> 4) & 1) * 32 + (lane & 3) * 8 + (4 * hi + ((lane & 15) >> 2)) * 64;
  const f32x16 zero16 = {0.f, 0.f, 0.f, 0.f, 0.f, 0.f, 0.f, 0.f, 0.f, 0.f, 0.f, 0.f, 0.f, 0.f, 0.f, 0.f};
  float m = -1e30f, l = 0.f;
  for (int kt = 0; kt < ntile; ++kt) {
    const LAS unsigned char* kp = kp0 + kt * 8192;
    f32x16 p0 = zero16, p1 = zero16;
#pragma unroll
    for (int d0 = 0; d0 < 4; ++d0) {
      const h8 k0f = *(const LAS h8*)(kp + d0 * 2048), k1f = *(const LAS h8*)(kp + d0 * 2048 + 512);
      p0 = __builtin_amdgcn_mfma_f32_32x32x16_f16(k0f, qf[d0], p0, 0, 0, 0);
      p1 = __builtin_amdgcn_mfma_f32_32x32x16_f16(k1f, qf[d0], p1, 0, 0, 0);
    }
    const int rel = ncv - 1 - 64 * kt - 4 * hi;
    float mx = -1e30f;
#pragma unroll
    for (int r = 0; r < 16; ++r) {
      const int e0 = (r & 3) + 8 * (r >> 2);
      p0[r] = e0 <= rel ? p0[r] : -1e30f; p1[r] = e0 + 32 <= rel ? p1[r] : -1e30f;
      mx = fmaxf(mx, fmaxf(p0[r], p1[r]));
    }
    mx = fmaxf(mx, __shfl_xor(mx, 32, 64));
    const float mn = fmaxf(m, mx * C2);
    float ls = 0.f;
#pragma unroll
    for (int r = 0; r < 16; ++r) ls += __builtin_amdgcn_exp2f(__builtin_fmaf(p0[r], C2, -mn)) + __builtin_amdgcn_exp2f(__builtin_fmaf(p1[r], C2, -mn));
    l = l * __builtin_amdgcn_exp2f(m - mn) + ls;
    m = mn;
  }
  float l_tot = l + __shfl_xor(l, 32, 64);
  const float inv = ncv > 0 ? 1.f / fmaxf(l_tot, 1e-30f) : 0.f;
  const float nm = ncv > 0 ? -m : -INFINITY;
  f32x16 o[2]; o[0] = zero16; o[1] = zero16;
  LAS float* slab = (LAS float*)(lds + CS_SLAB) + ((qi * 4 + hh) * 32 + r32) * 65;
  float carry = 0.f;
  for (int kt = 0; kt < ntile; ++kt) {
    const LAS unsigned char* kp = kp0 + kt * 8192;
    const LAS unsigned char* vp = vp0 + kt * 8192;
    f32x16 p0 = zero16, p1 = zero16;
#pragma unroll
    for (int d0 = 0; d0 < 4; ++d0) {
      const h8 k0f = *(const LAS h8*)(kp + d0 * 2048), k1f = *(const LAS h8*)(kp + d0 * 2048 + 512);
      p0 = __builtin_amdgcn_mfma_f32_32x32x16_f16(k0f, qf[d0], p0, 0, 0, 0);
      p1 = __builtin_amdgcn_mfma_f32_32x32x16_f16(k1f, qf[d0], p1, 0, 0, 0);
    }
    const int rel = ncv - 1 - 64 * kt - 4 * hi;
#pragma unroll
    for (int r = 0; r < 16; ++r) {
      const int e0 = (r & 3) + 8 * (r >> 2);
      const float a0 = e0 <= rel ? p0[r] : -1e30f, a1 = e0 + 32 <= rel ? p1[r] : -1e30f;
      p0[r] = __builtin_amdgcn_exp2f(__builtin_fmaf(a0, C2, nm)) * inv;
      p1[r] = __builtin_amdgcn_exp2f(__builtin_fmaf(a1, C2, nm)) * inv;
    }
#pragma unroll
    for (int n = 0; n < 2; ++n) {
#pragma unroll
      for (int rg = 0; rg < 4; ++rg) {
        const float t3 = n == 0 ? p0[4 * rg + 3] : p1[4 * rg + 3];
        const float gs = n == 0 ? (p0[4 * rg] + p0[4 * rg + 1]) + (p0[4 * rg + 2] + t3) : (p1[4 * rg] + p1[4 * rg + 1]) + (p1[4 * rg + 2] + t3);
        const float tp = __shfl_xor(t3, 32, 64);
        slab[2 * (8 * kt + 4 * n + rg) + hi] = gs + (hi ? tp : carry);
        carry = tp;
      }
    }
    h8 pa[4];
#pragma unroll
    for (int j = 0; j < 8; ++j) { pa[0][j] = (_Float16)p0[j]; pa[1][j] = (_Float16)p0[8 + j]; pa[2][j] = (_Float16)p1[j]; pa[3][j] = (_Float16)p1[8 + j]; }
#pragma unroll
    for (int s = 0; s < 4; ++s) {
#pragma unroll
      for (int dh = 0; dh < 2; ++dh) {
        const h4 lo = vtr(vp + dh * 4096 + s * 1024), hv = vtr(vp + dh * 4096 + s * 1024 + 512);
        const h8 vf = __builtin_shufflevector(lo, hv, 0, 1, 2, 3, 4, 5, 6, 7);
        o[dh] = __builtin_amdgcn_mfma_f32_32x32x16_f16(pa[s], vf, o[dh], 0, 0, 0);
      }
    }
  }
  __syncthreads();
  if (own < 16) {
    if (tid < 64) p.sel()[bg * S_ + q0 + tid] = (2ull << own) - 1ull;
  } else {
    const LAS float* sl = (const LAS float*)(lds + CS_SLAB);
    const int jj = lane;
    const bool cand = (jj >= 1) && (jj <= own - 2);
    const unsigned long long forced = 1ull | (1ull << own) | (1ull << (own - 1));
    for (int i = 0; i < 8; ++i) {
      const int qq = wid * 8 + i, q2 = qq >> 5, rr = qq & 31;
      float v = 0.f;
#pragma unroll
      for (int x = 0; x < 4; ++x) v += sl[((q2 * 4 + x) * 32 + rr) * 65 + jj];
      const unsigned key = cand ? (__float_as_uint(v) + 1u) : 0u;
      unsigned th = 0u;
#pragma unroll
      for (int bit = 30; bit >= 0; --bit) {
        const unsigned c = th | (1u << bit);
        const int cnt = __popcll(__ballot(key >= c));
        th = cnt >= 13 ? c : th;
      }
      const unsigned long long gt = __ballot(key > th), eq = __ballot(key == th);
      const int need = 13 - __popcll(gt);
      unsigned long long t = eq;
      for (int k = 0; k < need; ++k) t &= t - 1ull;
      const unsigned long long msk = gt | (eq ^ t) | forced;
      if (lane == 0) p.sel()[bg * S_ + q0 + qq] = msk;
    }
  }
  __syncthreads();
  {
    LAS _Float16* stg = (LAS _Float16*)(lds + CS_SLAB + wid * 4096);
#pragma unroll
    for (int r = 0; r < 16; ++r) {
      const int orow = crow(r, hi);
      stg[orow * 64 + r32] = (_Float16)o[0][r];
      stg[orow * 64 + 32 + r32] = (_Float16)o[1][r];
    }
#pragma unroll
    for (int i = 0; i < 4; ++i) {
      const int row = i * 8 + (lane >> 3), ch = lane & 7;
      const h8 v = *(const LAS h8*)(stg + row * 64 + ch * 8);
      const int t = q0 + qi * 32 + row;
      *reinterpret_cast<h8*>(p.ocmph() + (((size_t)b * 8 + h) * S_ + t) * 64 + ch * 8) = v;
    }
  }
  __syncthreads();
  }
}

#define XB_TMO      128
#define XB_XCNT(j)  (256  + 64 * (j))
#define XB_XSUB(j)  (1280 + 64 * (j))
#define XB_XGEN(j)  (2304 + 64 * (j))
#define XB_TOP      3328
#define XB_TOPGEN   3392
#define XCD_BAR_WORDS 3456
#define XB_SPIN_CAP (1u << 18)
__device__ __forceinline__ unsigned xb_ld(unsigned* p) { return __hip_atomic_load(p, __ATOMIC_RELAXED, __HIP_MEMORY_SCOPE_AGENT); }
__device__ __forceinline__ unsigned xb_add(unsigned* p, unsigned v) { return __hip_atomic_fetch_add(p, v, __ATOMIC_RELAXED, __HIP_MEMORY_SCOPE_AGENT); }
__device__ __forceinline__ unsigned xb_xcc_id() { return (unsigned)__builtin_amdgcn_s_getreg((3 << 11) | 20) & 0xFu; }
#define XB_SPIN(cond, bar) do { unsigned _sp = 0; while (cond) { __builtin_amdgcn_s_sleep(1); \
    if ((++_sp & 255u) == 0u) { if (xb_ld(&(bar)[XB_TMO])) break; if (_sp > XB_SPIN_CAP) { atomicAdd(&(bar)[XB_TMO], 1u); break; } } } } while (0)
struct XcdBarrier { unsigned* bar; unsigned x; volatile LAS unsigned* st; };
__device__ __forceinline__ XcdBarrier xcd_barrier_post(unsigned* bar, volatile LAS unsigned* st) {
  XcdBarrier b; b.bar = bar; b.x = xb_xcc_id(); b.st = st;
  if (threadIdx.x == 0) (void)xb_add(&bar[XB_XCNT(b.x)], 1u);
  return b;
}
__device__ __forceinline__ void xcd_barrier_complete(unsigned* bar, unsigned x, unsigned& nloc, unsigned& nx) {
  const unsigned G = gridDim.x * gridDim.y * gridDim.z;
  unsigned sum, cnt, mine, sp = 0u;
  for (;;) {
    sum = 0u; cnt = 0u; mine = 0u;
#pragma unroll
    for (unsigned j = 0; j < 16; ++j) { const unsigned c = xb_ld(&bar[XB_XCNT(j)]); sum += c; cnt += (c > 0u) ? 1u : 0u; mine = (j == x) ? c : mine; }
    if (sum == G) break;
    __builtin_amdgcn_s_sleep(1);
    if ((++sp & 255u) == 0u) { if (xb_ld(&bar[XB_TMO])) break; if (sp > XB_SPIN_CAP) { atomicAdd(&bar[XB_TMO], 1u); break; } }
  }
  nloc = mine > 0u ? mine : 1u; nx = cnt > 0u ? cnt : 1u;
}
__device__ __forceinline__ void xcd_barrier(const XcdBarrier& b) {
  asm volatile("s_waitcnt vmcnt(0)" ::: "memory");
  __syncthreads();
  if (threadIdx.x == 0) {
    unsigned* bar = b.bar;
    __builtin_amdgcn_s_waitcnt(0);
    unsigned nloc = b.st[0], nx = b.st[1];
    if (nloc == 0u) { xcd_barrier_complete(bar, b.x, nloc, nx); b.st[0] = nloc; b.st[1] = nx; }
    const unsigned old = xb_add(&bar[XB_XSUB(b.x)], 1u);
    const unsigned gen = old / nloc;
    if (old + 1u == (gen + 1u) * nloc) {
      __builtin_amdgcn_fence(__ATOMIC_RELEASE, "agent");
      asm volatile("s_waitcnt vmcnt(0)" ::: "memory");
      const unsigned og = xb_add(&bar[XB_TOP], 1u);
      const unsigned tg = og / nx;
      if (og + 1u == (tg + 1u) * nx) xb_add(&bar[XB_TOPGEN], 1u);
      else XB_SPIN(xb_ld(&bar[XB_TOPGEN]) == tg, bar);
      __builtin_amdgcn_fence(__ATOMIC_ACQUIRE, "agent");
      xb_add(&bar[XB_XGEN(b.x)], 1u);
      asm volatile("s_waitcnt vmcnt(0)" ::: "memory");
    } else {
      XB_SPIN(xb_ld(&bar[XB_XGEN(b.x)]) == gen, bar);
      __builtin_amdgcn_fence(__ATOMIC_ACQUIRE, "agent");
      asm volatile("s_waitcnt vmcnt(0)" ::: "memory");
    }
  }
  __syncthreads();
}

__device__ __forceinline__ int cap_tiles(int h) { return h == 0 ? 6 : h == 1 ? 7 : h == 2 ? 10 : h == 3 ? 15 : h == 4 ? 26 : h == 5 ? 48 : 64; }
__device__ __forceinline__ int unit_cost(int mode, int pi) {
  const int h = pi >> 4, blk = pi & 15, cap = cap_tiles(h);
  const int full = 4 * (blk + 1);
  if (mode == 0) return min(full, cap);
  return min(full, cap) + min(min(full, 12), cap) + 2;
}
__device__ __forceinline__ void build_order(LAS unsigned char* lds, int mode) {
  LAS short* ord = (LAS short*)(lds + AT_ORD);
  const int i = threadIdx.x;
  if (i < 128) {
    const int ci = unit_cost(mode, i);
    int rank = 0;
    for (int j = 0; j < 128; ++j) { const int cj = unit_cost(mode, j); rank += (cj > ci) || (cj == ci && j < i); }
    ord[rank] = (short)i;
  }
  __syncthreads();
}
__device__ __forceinline__ int queue_next(unsigned* ctr, LAS unsigned char* lds) {
  LAS int* slot = (LAS int*)(lds + AT_QS);
  if (threadIdx.x == 0) *slot = (int)atomicAdd(ctr, 1u);
  __syncthreads();
  const int v = *slot;
  __syncthreads();
  return v;
}
constexpr int XB_ST_OFF = (CS_LDS > STAGE_BYTES ? CS_LDS : STAGE_BYTES) > AT_LDS ? (CS_LDS > STAGE_BYTES ? CS_LDS : STAGE_BYTES) : AT_LDS;
constexpr int MEGA_LDS = XB_ST_OFF + 16;

__global__ __launch_bounds__(512, 2) void mega(P p) {
  extern __shared__ __attribute__((aligned(16))) unsigned char shm[];
  LAS unsigned char* lds = (LAS unsigned char*)shm;
  const int bid = blockIdx.x, nblk = gridDim.x;
  if (threadIdx.x < 4) ((LAS unsigned*)(lds + XB_ST_OFF))[threadIdx.x] = 0u;
  __syncthreads();
  const XcdBarrier xb = xcd_barrier_post(p.xbar(), (volatile LAS unsigned*)(lds + XB_ST_OFF));
  const bool flow = (nblk == 256);
  const int myb = bid & 7, myj = bid >> 3;
  if (flow) {
    const int tid = otid(), lane = tid & 63, wid = __builtin_amdgcn_readfirstlane(tid >> 6);
    prep_gate_image(p, lds);
    prep_weights(p, lds, bid, nblk);
    prep_xrows(p, lds, myb * S_ + 128 * myj + wid * 16, lane);
  } else {
    phase_prep(p, lds, bid, nblk);
  }
  xcd_barrier(xb);
  {
    P1Order S; S.so.init(T_, NP - 256, nblk, bid, 1);
    S.i0 = 0; S.n = bid < 1792 ? (1792 - bid + nblk - 1) / nblk : 0; S.xpm0 = 0; S.xstride = 0; S.xn = 0;
    EpiProj E{p.hm(), p.rstd(), p.kmp(), p.kn2(), 0};
    gemm_phase<EpiProj, P1Order>(lds, p.xh(), p.wt(), T_, NP, DM, S, E);
  }
  xcd_barrier(xb);
  if (flow) {
    if (bid < 128) {
      P1Order S; S.so.init(T_, NP - 256, nblk, bid, 1); S.i0 = 0; S.n = 0; S.xpm0 = myb * 16 + myj; S.xstride = 0; S.xn = 1;
      EpiProj E{p.hm(), p.rstd(), p.kmp(), p.kn2(), 0};
      gemm_phase<EpiProj, P1Order>(lds, p.xh(), p.wt(), T_, NP, DM, S, E);
    } else {
      for (int u = (bid - 128) * 2; u < (bid - 128) * 2 + 2; ++u) cm_unit(p, lds, u >> 7, (u >> 4) & 7, (u >> 3) & 1, u & 7);
    }
  } else {
    { P1Order S; S.so.init(T_, NP - 256, nblk, bid, 1); S.i0 = 0; S.n = 0; S.xpm0 = bid; S.xstride = nblk; S.xn = bid < 128 ? (128 - bid + nblk - 1) / nblk : 0;
      EpiProj E{p.hm(), p.rstd(), p.kmp(), p.kn2(), 0};
      gemm_phase<EpiProj, P1Order>(lds, p.xh(), p.wt(), T_, NP, DM, S, E); }
    for (int u = bid; u < 2 * 8 * 2 * 8; u += nblk) cm_unit(p, lds, u >> 7, (u >> 4) & 7, (u >> 3) & 1, u & 7);
  }
  for (int rep = 0; rep < (PROBE == 3 ? 2 : PROBE == 23 ? 3 : 1); ++rep) {
    build_order(lds, 0);
    for (;;) {
      const int u = queue_next(p.qctr() + 0 + 2 * rep, lds);
      if (u >= 8 * 8 * 16) break;
      const int pi = ((const LAS short*)(lds + AT_ORD))[u >> 3];
      moba_unit(p, lds, u & 7, pi >> 4, pi & 15);
    }
  }
  xcd_barrier(xb);
  for (int rep = 0; rep < (PROBE == 4 ? 2 : 1); ++rep)
    for (int su = bid; su < 256; su += nblk) cs_super(p, lds, (su & 15) >> 1, su & 1, su >> 4);
  xcd_barrier(xb);
  for (int rep = 0; rep < (PROBE == 5 ? 2 : PROBE == 25 ? 3 : 1); ++rep) {
    build_order(lds, 1);
    for (;;) {
      const int u = queue_next(p.qctr() + 1 + 2 * rep, lds);
      if (u >= 8 * 8 * 16) break;
      const int pi = ((const LAS short*)(lds + AT_ORD))[u >> 3];
      nsa_unit(p, lds, u & 7, pi >> 4, pi & 15);
    }
  }
  xcd_barrier(xb);
  {
    StaticOrder S; S.init(T_, DM, nblk, bid, PROBE == 6 ? 2 : 1);
    EpiY E{p.hm(), p.ssq()};
    gemm_phase<EpiY, StaticOrder>(lds, p.cat(), p.wot(), T_, DM, DM, S, E);
  }
  xcd_barrier(xb);
  for (int rep = 0; rep < (PROBE == 7 ? 2 : 1); ++rep) phase_post(p, bid, nblk);
}

}


extern "C" void kernel_launch(void* const* d_in, const int* in_sizes, int n_in, void* d_out, int out_size, void* d_ws,
                              size_t ws_size, hipStream_t stream) {
  P p{};
  p.x = (const float*)d_in[0]; p.g_pre = (const float*)d_in[1]; p.g_post = (const float*)d_in[2];
  p.w_in = (const float*)d_in[3]; p.pe_k = (const float*)d_in[4]; p.pe_v = (const float*)d_in[5];
  p.wk1 = (const float*)d_in[6]; p.wk2 = (const float*)d_in[7]; p.wv1 = (const float*)d_in[8]; p.wv2 = (const float*)d_in[9];
  p.w_out = (const float*)d_in[10]; p.out = (float*)d_out;
  p.ws = (char*)d_ws;
  if (ws_size < WS_END) { fprintf(stderr, "workspace too small\n"); return; }

  static int grid_blocks = 0;
  if (!grid_blocks) {
    int dev = 0, cus = 0, per_cu = 0;
    (void)hipGetDevice(&dev);
    (void)hipDeviceGetAttribute(&cus, hipDeviceAttributeMultiprocessorCount, dev);
    (void)hipFuncSetAttribute((const void*)mega, hipFuncAttributeMaxDynamicSharedMemorySize, MEGA_LDS);
    (void)hipOccupancyMaxActiveBlocksPerMultiprocessor(&per_cu, (const void*)mega, 512, MEGA_LDS);
    if (per_cu < 1) per_cu = 1;
    if (per_cu > 1) per_cu = 1;
    grid_blocks = cus * per_cu;
  }
  (void)hipMemsetAsync((char*)d_ws + OFF_XBAR, 0, (size_t)3456 * 4, stream);
  hipLaunchKernelGGL(mega, dim3(grid_blocks), dim3(512), MEGA_LDS, stream, p);
  hipError_t e = hipPeekAtLastError();
  if (e != hipSuccess) fprintf(stderr, "launch failed: %s (grid %d)\n", hipGetErrorString(e), grid_blocks);
}
```
